# Optimizing an MI355X kernel written in HIP

```python
import jax, jax.numpy as jnp
from jax import lax
import numpy as np

D_MODEL = 4096
BATCH = 1
SEQ = 8192
DEPTH = 1

N_MEM = 256
MEM_HEADS = 4
MEM_WIDTH = D_MODEL // 4
MEM_HEAD_DIM = MEM_WIDTH // MEM_HEADS
SB_HEAD_DIM = 128
SB_WIDTH = 3 * D_MODEL // 8
SB_HEADS = SB_WIDTH // SB_HEAD_DIM
SB_BLOCK = 128
RW_HEAD_DIM = 64
RW_WIDTH = 3 * D_MODEL // 8
RW_HEADS = RW_WIDTH // RW_HEAD_DIM
RW_DECAY_LORA = 128
RW_ICLR_LORA = 128
RW_GATE_LORA = 480
RW_SEG = 3 * RW_WIDTH + RW_DECAY_LORA + RW_ICLR_LORA + RW_GATE_LORA
RW_SPLITS = [RW_WIDTH, 2 * RW_WIDTH, 3 * RW_WIDTH,
             3 * RW_WIDTH + RW_DECAY_LORA,
             3 * RW_WIDTH + RW_DECAY_LORA + RW_ICLR_LORA]
RW_GN_EPS = 64e-5
N_BRANCHES = 3
IN_SPLITS = [SB_WIDTH, 2 * SB_WIDTH, 3 * SB_WIDTH,
             3 * SB_WIDTH + RW_SEG,
             3 * SB_WIDTH + RW_SEG + MEM_WIDTH]
IN_COLS = 3 * SB_WIDTH + RW_SEG + MEM_WIDTH + N_BRANCHES * D_MODEL
D_FF = -(-8 * D_MODEL // (3 * 256)) * 256
RMS_EPS = 1e-6

kernel_name = "hybrid_stickbreak_rwkv7_memxattn_gated"


def rms_norm(x, g, eps=RMS_EPS):
    xf = x.astype(jnp.float32)
    y = xf * lax.rsqrt(jnp.mean(xf * xf, axis=-1, keepdims=True) + eps)
    return (y * g.astype(jnp.float32)).astype(x.dtype)


def token_shift(c, mix):
    prev = jnp.pad(c, ((0, 0), (1, 0), (0, 0)))[:, :-1]
    return c + (prev - c) * mix


def stick_breaking_attention(q, k, v):
    B, T, H, hd = q.shape
    nb = T // SB_BLOCK
    scale = hd ** -0.5
    qb = jnp.moveaxis(q.reshape(B, nb, SB_BLOCK, H, hd), 1, 0)
    kf = k.astype(jnp.float32)
    vf = v.astype(jnp.float32)
    key_pos = jnp.arange(T)

    def block(args):
        q_blk, i = args
        z = jnp.einsum('bqhd,bkhd->bhqk', q_blk.astype(jnp.float32), kf) * scale
        q_pos = i * SB_BLOCK + jnp.arange(SB_BLOCK)
        causal = key_pos[None, :] < q_pos[:, None]
        sp = jnp.where(causal, jax.nn.softplus(z), 0.0)
        tail = lax.cumsum(sp, axis=3, reverse=True)
        weights = jnp.exp(jnp.where(causal, z - tail, -jnp.inf))
        return jnp.einsum('bhqk,bkhd->bqhd', weights, vf)

    ob = lax.map(block, (qb, jnp.arange(nb)))
    return jnp.moveaxis(ob, 0, 1).reshape(B, T, H, hd).astype(q.dtype)


def rwkv7_time_mix(seg, mix, w0, w_up, a0, a_up, g_up, k_k, k_a, r_k, ln_g, ln_b):
    dt = seg.dtype
    seg = token_shift(seg, mix).astype(jnp.float32)
    r, k, v, wd, ad, gd = jnp.split(seg, RW_SPLITS, axis=-1)
    B, T, _ = r.shape
    f32 = lambda t: t.astype(jnp.float32)
    w_log = -jax.nn.softplus(-(f32(w0) + jnp.tanh(wd) @ f32(w_up))) - 0.5
    decay = jnp.exp(-jnp.exp(w_log))
    a = jax.nn.sigmoid(f32(a0) + ad @ f32(a_up))
    g = jax.nn.sigmoid(gd) @ f32(g_up)
    heads = lambda t: t.reshape(B, T, RW_HEADS, RW_HEAD_DIM)
    kk = heads(k * f32(k_k))
    kk = kk / jnp.maximum(jnp.sqrt(jnp.sum(kk * kk, axis=-1, keepdims=True)), 1e-12)
    k = k * (1.0 + (a - 1.0) * f32(k_a))
    r, k, v, a, decay = heads(r), heads(k), heads(v), heads(a), heads(decay)

    def step(S, inp):
        r_t, w_t, k_t, v_t, kk_t, a_t = inp
        sa = jnp.einsum('bhvk,bhk->bhv', S, -kk_t)
        S = (S * w_t[:, :, None, :]
             + jnp.einsum('bhv,bhk->bhvk', sa, kk_t * a_t)
             + jnp.einsum('bhv,bhk->bhvk', v_t, k_t))
        y_t = jnp.einsum('bhvk,bhk->bhv', S, r_t)
        return S, y_t

    tm = lambda t: jnp.moveaxis(t, 1, 0)
    S0 = jnp.zeros((B, RW_HEADS, RW_HEAD_DIM, RW_HEAD_DIM), jnp.float32)
    _, y = lax.scan(step, S0, (tm(r), tm(decay), tm(k), tm(v), tm(kk), tm(a)))
    y = jnp.moveaxis(y, 0, 1)
    mu = jnp.mean(y, axis=-1, keepdims=True)
    var = jnp.mean(jnp.square(y - mu), axis=-1, keepdims=True)
    y = ((y - mu) * lax.rsqrt(var + RW_GN_EPS)).reshape(B, T, RW_WIDTH) * f32(ln_g) + f32(ln_b)
    bonus = jnp.sum(r * k * f32(r_k), axis=-1, keepdims=True) * v
    y = y + bonus.reshape(B, T, RW_WIDTH)
    return (y * g).astype(dt)


def memory_cross_attention(q, mem_n, w_kv, q_g, k_g):
    B, T, _ = q.shape
    M = mem_n.shape[1]
    mk, mv = jnp.split(mem_n @ w_kv, 2, axis=-1)
    q = rms_norm(q.reshape(B, T, MEM_HEADS, MEM_HEAD_DIM), q_g)
    mk = rms_norm(mk.reshape(B, M, MEM_HEADS, MEM_HEAD_DIM), k_g)
    mv = mv.reshape(B, M, MEM_HEADS, MEM_HEAD_DIM)
    s = jnp.einsum('bthd,bmhd->bhtm', q.astype(jnp.float32), mk.astype(jnp.float32)) * MEM_HEAD_DIM ** -0.5
    p = jax.nn.softmax(s, axis=-1)
    o = jnp.einsum('bhtm,bmhd->bthd', p, mv.astype(jnp.float32))
    return o.reshape(B, T, MEM_WIDTH).astype(q.dtype)


def setup_inputs(seed: int = 0) -> dict:
    key = jax.random.key(seed)
    ks = iter(jax.random.split(key, 32))
    L = DEPTH
    f = jnp.float32

    def nrm(shape, fan_in):
        return jax.random.normal(next(ks), shape, f) * fan_in ** -0.5

    def gain(shape):
        return 1.0 + 0.02 * jax.random.normal(next(ks), shape, f)

    def small(shape, s):
        return s * jax.random.normal(next(ks), shape, f)

    return {
        "x": jax.random.normal(next(ks), (BATCH, SEQ, D_MODEL), f),
        "mem": jax.random.normal(next(ks), (BATCH, N_MEM, D_MODEL), f),
        "attn_norm_g": gain((L, D_MODEL)),
        "mem_norm_g": gain((L, D_MODEL)),
        "w_in": nrm((L, D_MODEL, IN_COLS), D_MODEL),
        "sb_q_norm_g": gain((L, SB_HEAD_DIM)),
        "sb_k_norm_g": gain((L, SB_HEAD_DIM)),
        "rw_mix": jax.random.uniform(next(ks), (L, RW_SEG), f),
        "rw_w0": jax.random.uniform(next(ks), (L, RW_WIDTH), f, minval=-6.0, maxval=-1.0),
        "rw_w_up": nrm((L, RW_DECAY_LORA, RW_WIDTH), RW_DECAY_LORA),
        "rw_a0": small((L, RW_WIDTH), 0.1),
        "rw_a_up": nrm((L, RW_ICLR_LORA, RW_WIDTH), RW_ICLR_LORA),
        "rw_g_up": nrm((L, RW_GATE_LORA, RW_WIDTH), RW_GATE_LORA),
        "rw_k_k": 0.85 + small((L, RW_WIDTH), 0.02),
        "rw_k_a": gain((L, RW_WIDTH)),
        "rw_r_k": small((L, RW_HEADS, RW_HEAD_DIM), 0.1),
        "rw_ln_g": gain((L, RW_WIDTH)),
        "rw_ln_b": small((L, RW_WIDTH), 0.02),
        "mem_w_kv": nrm((L, D_MODEL, 2 * MEM_WIDTH), D_MODEL),
        "mem_q_norm_g": gain((L, MEM_HEAD_DIM)),
        "mem_k_norm_g": gain((L, MEM_HEAD_DIM)),
        "w_sb_o": nrm((L, SB_WIDTH, D_MODEL), SB_WIDTH),
        "w_rw_o": nrm((L, RW_WIDTH, D_MODEL), RW_WIDTH),
        "w_mem_o": nrm((L, MEM_WIDTH, D_MODEL), MEM_WIDTH),
        "w_out": nrm((L, D_MODEL, D_MODEL), D_MODEL),
        "ffn_norm_g": gain((L, D_MODEL)),
        "w_gate": nrm((L, D_MODEL, D_FF), D_MODEL),
        "w_up": nrm((L, D_MODEL, D_FF), D_MODEL),
        "w_down": nrm((L, D_FF, D_MODEL), D_FF),
    }


def reference(x, mem, attn_norm_g, mem_norm_g, w_in, sb_q_norm_g, sb_k_norm_g,
              rw_mix, rw_w0, rw_w_up, rw_a0, rw_a_up, rw_g_up, rw_k_k, rw_k_a,
              rw_r_k, rw_ln_g, rw_ln_b, mem_w_kv, mem_q_norm_g, mem_k_norm_g,
              w_sb_o, w_rw_o, w_mem_o, w_out, ffn_norm_g, w_gate, w_up, w_down):
    B, T, _ = x.shape
    h = x
    for l in range(DEPTH):
        xn = rms_norm(h, attn_norm_g[l])
        p = xn @ w_in[l]
        sb_q, sb_k, sb_v, rw_seg, mem_q, gates = jnp.split(p, IN_SPLITS, axis=-1)

        sb_heads = lambda t: t.reshape(B, T, SB_HEADS, SB_HEAD_DIM)
        q = rms_norm(sb_heads(sb_q), sb_q_norm_g[l])
        k = rms_norm(sb_heads(sb_k), sb_k_norm_g[l])
        o_sb = stick_breaking_attention(q, k, sb_heads(sb_v)).reshape(B, T, SB_WIDTH)
        u_sb = o_sb @ w_sb_o[l]

        o_rw = rwkv7_time_mix(rw_seg, rw_mix[l], rw_w0[l], rw_w_up[l], rw_a0[l], rw_a_up[l],
                              rw_g_up[l], rw_k_k[l], rw_k_a[l], rw_r_k[l], rw_ln_g[l], rw_ln_b[l])
        u_rw = o_rw @ w_rw_o[l]

        mem_n = rms_norm(mem, mem_norm_g[l])
        o_mem = memory_cross_attention(mem_q, mem_n, mem_w_kv[l], mem_q_norm_g[l], mem_k_norm_g[l])
        u_mem = o_mem @ w_mem_o[l]

        g_sb, g_rw, g_mem = jnp.split(jax.nn.sigmoid(gates), N_BRANCHES, axis=-1)
        merged = g_sb * u_sb + g_rw * u_rw + g_mem * u_mem
        h = h + merged @ w_out[l]

        hn = rms_norm(h, ffn_norm_g[l])
        h = h + (jax.nn.silu(hn @ w_gate[l]) * (hn @ w_up[l])) @ w_down[l]
    return h
```

```cpp
#include <hip/hip_runtime.h>
#include <cstdio>
#include <cstdint>

#ifndef MK_PER_PHASE
#define MK_PER_PHASE 0
#endif

constexpr int T = 8192, D = 4096, NMEM = 256;
constexpr int SBW = 1536, RWW = 1536, MEMW = 1024, RWSEG = 5344, DFF = 11008;
constexpr int NIN_ORIG = 23264, NINP = 23296;
constexpr int PQ = 0, PK = 1536, PV = 3072, PRW = 4608, PMQ = 9984, PG = 11008;
constexpr float RMS_EPS = 1e-6f, GN_EPS = 64e-5f;

constexpr size_t MiB = 1u << 20;
constexpr size_t WS_CTL = 0, CTL_ZERO_BYTES = 256 * 1024;
constexpr size_t WS_WIN_T = 1 * MiB;
constexpr size_t WS_WCAT_T = WS_WIN_T + 182 * MiB;
constexpr size_t WS_WOUT_T = WS_WCAT_T + 32 * MiB;
constexpr size_t WS_WKV_T = WS_WOUT_T + 32 * MiB;
constexpr size_t WS_LBWA = WS_WKV_T + 16 * MiB;
constexpr size_t WS_LBG = WS_LBWA + 2 * MiB;
constexpr size_t WS_XN = WS_LBG + 2 * MiB;
constexpr size_t WS_MEMN = WS_XN + 64 * MiB;
constexpr size_t WS_P = WS_MEMN + 2 * MiB;
constexpr size_t WS_R = WS_P + 364 * MiB;
constexpr size_t RSZ = 48 * MiB;
constexpr size_t WS_G = WS_R + 6 * RSZ;
constexpr size_t WS_Y = WS_G + 24 * MiB;
constexpr size_t WS_OCAT = WS_Y + 48 * MiB;
constexpr size_t WS_LATE = WS_OCAT + 64 * MiB;
constexpr size_t WS_QN = WS_LATE;
constexpr size_t WS_KN = WS_QN + 24 * MiB;
constexpr size_t WS_VT = WS_KN + 24 * MiB;
constexpr size_t WS_MQN = WS_VT + 24 * MiB;
constexpr size_t WS_MKRAW = WS_MQN + 16 * MiB;
constexpr size_t WS_MKN = WS_MKRAW + 1 * MiB;
constexpr size_t WS_MVT = WS_MKN + 1 * MiB;
constexpr size_t WS_SM = WS_MVT + 2 * MiB;
constexpr size_t WS_PM = WS_SM + 32 * MiB;
constexpr size_t WS_LA1 = WS_PM + 16 * MiB;
constexpr size_t WS_LA2 = WS_LA1 + 4 * MiB;
constexpr size_t WS_EARLY_END = WS_LA2 + 8 * MiB;
constexpr size_t WS_PHIT = WS_EARLY_END;
constexpr size_t WS_PCT = WS_PHIT + 48 * MiB;
constexpr size_t WS_SLOCT = WS_PCT + 48 * MiB;
constexpr size_t WS_BONUS = WS_SLOCT + 48 * MiB;
constexpr size_t WS_RWKV_END = WS_BONUS + 1 * MiB;
constexpr size_t WS_WGU_T = WS_WIN_T;
constexpr size_t WS_WD_T = WS_R + 2 * RSZ;
constexpr size_t WS_END = WS_RWKV_END;
constexpr size_t WS_MERGED = WS_R;
constexpr size_t WS_H1 = WS_LATE;
constexpr size_t WS_ACT = WS_P;
static_assert(WS_H1 + 128 * MiB <= WS_EARLY_END && WS_WD_T + 86 * MiB <= WS_R + 4 * RSZ, "H1 / W_down copy homes");
static_assert(WS_END <= 1454ull * MiB, "workspace map exceeds the guaranteed 4x largest tensor");

constexpr int CW_TMO = 0, CW_CODE = 1, CW_BAR = 4096, CW_Q1 = 32768, CW_Q2 = 32768 + 64;

constexpr int RING_BYTES = 131072, LDSCTL_OFF = 159744, MISC_OFF = LDSCTL_OFF + 320, LDS_BYTES = 163840;
constexpr int NWAVES = 8;

#define GAS __attribute__((address_space(1)))
#define LAS __attribute__((address_space(3)))
typedef unsigned short bf16;
typedef unsigned v4u __attribute__((ext_vector_type(4)));
typedef unsigned v2u __attribute__((ext_vector_type(2)));
typedef float f32x4 __attribute__((ext_vector_type(4)));
typedef float f32x2 __attribute__((ext_vector_type(2)));
typedef float f32x16 __attribute__((ext_vector_type(16)));
typedef short bf16x8 __attribute__((ext_vector_type(8)));
typedef short s16x4 __attribute__((ext_vector_type(4)));
typedef GAS unsigned gu32;

typedef __bf16 hwbf16x2 __attribute__((ext_vector_type(2)));
__device__ __forceinline__ unsigned pk2(float lo, float hi) { const f32x2 v = {lo, hi}; return __builtin_bit_cast(unsigned, __builtin_convertvector(v, hwbf16x2)); }
__device__ __forceinline__ unsigned f2bf(float f) { return pk2(f, 0.f) & 0xffffu; }
__device__ __forceinline__ float bflo(unsigned w) { return __builtin_bit_cast(float, w << 16); }
__device__ __forceinline__ float bfhi(unsigned w) { return __builtin_bit_cast(float, w & 0xffff0000u); }
__device__ __forceinline__ float fexp(float x) { return __builtin_amdgcn_exp2f(x * 1.44269504088896f); }
__device__ __forceinline__ float flog(float x) { return __builtin_amdgcn_logf(x) * 0.693147180559945f; }
__device__ __forceinline__ float frcp(float x) { return __builtin_amdgcn_rcpf(x); }
__device__ __forceinline__ float sigmoidf_(float x) { return frcp(1.0f + fexp(-x)); }
__device__ __forceinline__ float softplusf_(float x) { return fmaxf(x, 0.f) + flog(1.0f + fexp(-fabsf(x))); }
__device__ __forceinline__ float wave_sum(float v) {
#pragma unroll
    for (int o = 1; o < 64; o <<= 1) v += __shfl_xor(v, o);
    return v;
}
__device__ __forceinline__ float dpp_f(float x, const int ctrl_sel) {
    return x;
}
#define DPP_ADD(x, ctrl) ((x) + __builtin_bit_cast(float, __builtin_amdgcn_update_dpp(0, __builtin_bit_cast(int, (x)), (ctrl), 0xF, 0xF, true)))
#define DPP_MAX(x, ctrl) fmaxf((x), __builtin_bit_cast(float, __builtin_amdgcn_update_dpp(0, __builtin_bit_cast(int, (x)), (ctrl), 0xF, 0xF, true)))
__device__ __forceinline__ float quad_bcast(float x, int g) {
    const int xi = __builtin_bit_cast(int, x);
    switch (g) {
        case 0: return __builtin_bit_cast(float, __builtin_amdgcn_update_dpp(0, xi, 0x00, 0xF, 0xF, true));
        case 1: return __builtin_bit_cast(float, __builtin_amdgcn_update_dpp(0, xi, 0x55, 0xF, 0xF, true));
        case 2: return __builtin_bit_cast(float, __builtin_amdgcn_update_dpp(0, xi, 0xAA, 0xF, 0xF, true));
        default: return __builtin_bit_cast(float, __builtin_amdgcn_update_dpp(0, xi, 0xFF, 0xF, 0xF, true));
    }
}
__device__ __forceinline__ float red16_sum(float x) {
    x = DPP_ADD(x, 0xB1); x = DPP_ADD(x, 0x4E); x = DPP_ADD(x, 0x141); x = DPP_ADD(x, 0x140); return x;
}
__device__ __forceinline__ float red16_max(float x) {
    x = DPP_MAX(x, 0xB1); x = DPP_MAX(x, 0x4E); x = DPP_MAX(x, 0x141); x = DPP_MAX(x, 0x140); return x;
}

namespace pg8 {
#define PG8_LAS __attribute__((address_space(3)))
typedef unsigned short bf16_t;
typedef unsigned u32x4 __attribute__((ext_vector_type(4)));
constexpr int BM = 256, BK = 64, HALF = 128, HTB = HALF * BK * 2, STAGE_BYTES = 8 * HTB, NXCD = 8, WGM = 4;

__host__ __device__ __forceinline__ int lds_byte(int r, int c) { const int st = (r >> 4) * 2 + (c >> 5), rr = r & 15, cc = c & 31, ob = rr * 64 + cc * 2; return st * 1024 + (ob ^ (((ob >> 9) & 1) << 5)); }
__host__ __device__ __forceinline__ void stage_rc(int b, int& R, int& C) { const int st = b / 1024, sb = b % 1024, swz = sb ^ (((sb >> 9) & 1) << 5); R = (st >> 1) * 16 + swz / 64; C = (st & 1) * 32 + (swz % 64) / 2; }
__host__ __device__ __forceinline__ int perm32(int rho) { const int n = rho >> 4, i = rho & 15; return 8 * (i >> 2) + 4 * n + (i & 3); }

struct Unit { const char* A; const char* B; int nt, pm, pn, kind; };

struct TileOrder {
    int nM, nN, nwg;
    __device__ __forceinline__ void init(int nM_, int nN_) { nM = nM_; nN = nN_; nwg = nM_ * nN_; }
    __device__ __forceinline__ void map(int L, int& pm, int& pn) const {
        int wgid = L; { const int q = nwg / NXCD, r = nwg % NXCD, xcd = wgid % NXCD, off = wgid / NXCD; wgid = (xcd < r ? xcd * (q + 1) : r * (q + 1) + (xcd - r) * q) + off; }
        const int nig = WGM * nN, gid = wgid / nig, fm = gid * WGM, gsz = (nM - fm) < WGM ? (nM - fm) : WGM;
        pm = fm + ((wgid % nig) % gsz); pn = (wgid % nig) / gsz;
    }
};

__device__ __forceinline__ unsigned cvt_pk_bf16(float lo, float hi) { unsigned r; asm volatile("v_cvt_pk_bf16_f32 %0, %1, %2" : "=v"(r) : "v"(lo), "v"(hi)); return r; }

template <class Epi, class Sched>
__device__ __forceinline__ void gemm_phase(PG8_LAS unsigned char* lds, const int lda, const int ldb, const Sched& S, const Epi& E) {
    const int tid = threadIdx.x, wid = __builtin_amdgcn_readfirstlane(tid >> 6), lane = tid & 63, wr = wid >> 2, wc = wid & 3, fr = lane & 15, fq = lane >> 4;
    unsigned voffA[2], voffB[2];
#pragma unroll
    for (int i = 0; i < 2; ++i) { int R, C; stage_rc(tid * 16 + i * 8192, R, C); const int Rb = Epi::PERM ? ((R & ~31) + perm32(R & 31)) : R;
        voffA[i] = (unsigned)(R * lda + C) * 2u; voffB[i] = (unsigned)(Rb * ldb + C) * 2u; }
    const size_t kstep = (size_t)(BK * 2);
    const size_t hstepA = (size_t)HALF * lda * 2, hstepB = (size_t)HALF * ldb * 2;
    const unsigned ldsw = (unsigned)wid * 1024u;
    const int aoff = lds_byte(wr * 64 + fr, fq * 8), boff = lds_byte(wc * 32 + fr, fq * 8);
#define PG8_SA(b, h) (((b) * 2 + (h)) * HTB)
#define PG8_SB(b, h) ((4 + (b) * 2 + (h)) * HTB)
#define PG8_STAGE(bufoff, gbase, voff) do { _Pragma("unroll") for (int _i = 0; _i < 2; ++_i) \
        __builtin_amdgcn_global_load_lds((const unsigned*)((const char*)(gbase) + (voff)[_i]), (PG8_LAS unsigned*)(lds + (bufoff) + ldsw + _i * 8192), 16, 0, 0); } while (0)
#define PG8_LDA(dst, b, h) do { _Pragma("unroll") for (int m = 0; m < 4; ++m) _Pragma("unroll") for (int k = 0; k < 2; ++k) dst[m][k] = *(const PG8_LAS bf16x8*)(lds + PG8_SA(b, h) + aoff + m * 2048 + k * 1024); } while (0)
#define PG8_LDB(dst, b, h) do { _Pragma("unroll") for (int n = 0; n < 2; ++n) _Pragma("unroll") for (int k = 0; k < 2; ++k) dst[n][k] = *(const PG8_LAS bf16x8*)(lds + PG8_SB(b, h) + boff + n * 2048 + k * 1024); } while (0)
#define PG8_MMA(ai, bj, At, Bt) do { __builtin_amdgcn_s_setprio(1); _Pragma("unroll") for (int m = 0; m < 4; ++m) _Pragma("unroll") for (int n = 0; n < 2; ++n) _Pragma("unroll") for (int k = 0; k < 2; ++k) \
        acc[ai][bj][m][n] = __builtin_amdgcn_mfma_f32_16x16x32_bf16(Bt[n][k], At[m][k], acc[ai][bj][m][n], 0, 0, 0); __builtin_amdgcn_s_setprio(0); } while (0)
#define PG8_WAIT_V(n) asm volatile("s_waitcnt vmcnt(" #n ")" ::: "memory")
#define PG8_WAIT_L(n) asm volatile("s_waitcnt lgkmcnt(" #n ")" ::: "memory")
#define PG8_BAR __builtin_amdgcn_s_barrier()
#define PG8_SCHED __builtin_amdgcn_sched_barrier(0)
    Unit cur, nxt; int ui = 0;
    if (!S.next(0, cur)) return;
    f32x4 acc[2][2][4][2];
#pragma unroll
    for (int a = 0; a < 2; ++a)
#pragma unroll
        for (int b = 0; b < 2; ++b)
#pragma unroll
            for (int m = 0; m < 4; ++m)
#pragma unroll
                for (int n = 0; n < 2; ++n) acc[a][b][m][n] = (f32x4){0.f, 0.f, 0.f, 0.f};
    bf16x8 At[4][2], B0[2][2], B1[2][2];
    const char* cA = cur.A; const char* cB = cur.B; int nt = cur.nt;
    PG8_STAGE(PG8_SB(0, 0), cB, voffB); PG8_STAGE(PG8_SB(0, 1), cB + hstepB, voffB); PG8_STAGE(PG8_SA(0, 0), cA, voffA); PG8_STAGE(PG8_SA(0, 1), cA + hstepA, voffA);
    if (wr == 1) PG8_BAR;
    PG8_WAIT_V(2); PG8_BAR;
    PG8_STAGE(PG8_SB(1, 0), cB + kstep, voffB); PG8_STAGE(PG8_SA(1, 0), cA + kstep, voffA); PG8_STAGE(PG8_SB(1, 1), cB + hstepB + kstep, voffB);
    PG8_WAIT_V(6); PG8_BAR;
    for (;;) {
        const bool has_next = S.next(ui + 1, nxt);
        const char* nA = has_next ? nxt.A : cA; const char* nB = has_next ? nxt.B : cB;
        for (int t = 0; t < nt; t += 2) {
            const bool last = (t == nt - 2);
            const char* a1 = cA + (size_t)(t + 1) * kstep;
            const char* a2 = last ? nA : cA + (size_t)(t + 2) * kstep; const char* b2 = last ? nB : cB + (size_t)(t + 2) * kstep;
            const char* a3 = a2 + kstep; const char* b3 = b2 + kstep;
            PG8_LDB(B0, 0, 0); PG8_LDB(B1, 0, 1); PG8_SCHED; PG8_LDA(At, 0, 0); PG8_STAGE(PG8_SA(1, 1), a1 + hstepA, voffA);
            PG8_WAIT_V(8); PG8_WAIT_L(0); PG8_BAR; PG8_MMA(0, 0, At, B0); PG8_MMA(0, 1, At, B1); PG8_BAR; PG8_SCHED;
            PG8_LDA(At, 0, 1); PG8_STAGE(PG8_SB(0, 0), b2, voffB); PG8_STAGE(PG8_SB(0, 1), b2 + hstepB, voffB); PG8_STAGE(PG8_SA(0, 0), a2, voffA);
            PG8_WAIT_V(8); PG8_WAIT_L(0); PG8_BAR; PG8_MMA(1, 0, At, B0); PG8_MMA(1, 1, At, B1); PG8_BAR; PG8_SCHED;
            PG8_LDB(B0, 1, 0); PG8_LDB(B1, 1, 1); PG8_SCHED; PG8_LDA(At, 1, 0); PG8_STAGE(PG8_SA(0, 1), a2 + hstepA, voffA);
            PG8_WAIT_V(8); PG8_WAIT_L(0); PG8_BAR; PG8_MMA(0, 0, At, B0); PG8_MMA(0, 1, At, B1); PG8_BAR; PG8_SCHED;
            PG8_LDA(At, 1, 1); PG8_STAGE(PG8_SB(1, 0), b3, voffB); PG8_STAGE(PG8_SB(1, 1), b3 + hstepB, voffB); PG8_STAGE(PG8_SA(1, 0), a3, voffA);
            PG8_WAIT_V(8); PG8_WAIT_L(0); PG8_BAR; PG8_MMA(1, 0, At, B0); PG8_MMA(1, 1, At, B1); PG8_BAR; PG8_SCHED;
        }
        if (wr == 0) PG8_BAR;
        const bool keep = E(acc, cur, wr, wc, fr, fq);
        if (!has_next) break;
        if (!keep) {
#pragma unroll
            for (int a = 0; a < 2; ++a)
#pragma unroll
                for (int b = 0; b < 2; ++b)
#pragma unroll
                    for (int m = 0; m < 4; ++m)
#pragma unroll
                        for (int n = 0; n < 2; ++n) acc[a][b][m][n] = (f32x4){0.f, 0.f, 0.f, 0.f};
        }
        cur = nxt; cA = nA; cB = nB; nt = cur.nt; ++ui;
        if (wr == 1) PG8_BAR;
    }
    PG8_WAIT_V(0);
    PG8_BAR;
#undef PG8_SA
#undef PG8_SB
#undef PG8_STAGE
#undef PG8_LDA
#undef PG8_LDB
#undef PG8_MMA
#undef PG8_WAIT_V
#undef PG8_WAIT_L
#undef PG8_BAR
#undef PG8_SCHED
}

struct SchedPlain {
    TileOrder to; int G, c, nt; const char* A0; const char* B0; size_t sA, sB;
    __device__ __forceinline__ bool next(int i, Unit& u) const {
        const int L = i * G + c; if (L >= to.nwg) return false;
        int pm, pn; to.map(L, pm, pn); u.A = A0 + (size_t)pm * sA; u.B = B0 + (size_t)pn * sB; u.nt = nt; u.pm = pm; u.pn = pn; u.kind = 0; return true;
    }
};
struct SchedGemm1 {
    TileOrder to; int G, c; const char *XN, *WIN, *MEMN, *WKV;
    __device__ __forceinline__ bool next(int i, Unit& u) const {
        const int L = i * G + c; u.nt = 64;
        if (L < to.nwg) { int pm, pn; to.map(L, pm, pn); u.A = XN + (size_t)pm * 256 * 4096 * 2; u.B = WIN + (size_t)pn * 256 * 4096 * 2; u.pm = pm; u.pn = pn; u.kind = 0; return true; }
        const int e = L - to.nwg; if (e >= 8) return false;
        if (e < 4) { u.A = MEMN; u.B = WKV + (size_t)e * 256 * 4096 * 2; u.pm = 0; u.pn = e; u.kind = 1; }
        else { u.A = WKV + (size_t)(1024 + 256 * (e - 4)) * 4096 * 2; u.B = MEMN; u.pm = e - 4; u.pn = 0; u.kind = 2; }
        return true;
    }
};
struct SchedHeads {
    int G, c, nunits, nt; const char* A0; const char* B0; size_t sA, hA, hB;
    __device__ __forceinline__ bool next(int i, Unit& u) const {
        const int L = i * G + c; if (L >= nunits) return false;
        const int pm = L & 31, h = L >> 5; u.A = A0 + (size_t)pm * sA + (size_t)h * hA; u.B = B0 + (size_t)h * hB; u.nt = nt; u.pm = pm; u.pn = 0; u.kind = h; return true;
    }
};
struct SchedMerge {
    TileOrder to; int G, c; const char* OC; const char* WC;
    __device__ __forceinline__ bool next(int i, Unit& u) const {
        const int ti = i / 3, b = i - 3 * ti; const int L = ti * G + c; if (L >= to.nwg) return false;
        int pm, pn; to.map(L, pm, pn); const int koff = b * 1536;
        u.A = OC + ((size_t)pm * 256 * 4096 + koff) * 2; u.B = WC + ((size_t)pn * 256 * 4096 + koff) * 2; u.nt = (b < 2) ? 24 : 16; u.pm = pm; u.pn = pn; u.kind = b; return true;
    }
};

struct EpiGemm1 {
    static constexpr bool PERM = true;
    bf16_t *P, *MK, *MVT;
    __device__ __forceinline__ bool operator()(f32x4 (&acc)[2][2][4][2], const Unit& u, int wr, int wc, int fr, int fq) const {
        bf16_t* base; int ldc;
        if (u.kind == 0) { base = P + (size_t)u.pm * 256 * NINP + u.pn * 256; ldc = NINP; }
        else if (u.kind == 1) { base = MK + u.pn * 256; ldc = 1024; }
        else { base = MVT + (size_t)u.pm * 256 * 1024; ldc = 1024; }
        base += (size_t)(wr * 64 + fr) * ldc + wc * 32 + 8 * fq;
#pragma unroll
        for (int ai = 0; ai < 2; ++ai)
#pragma unroll
            for (int m = 0; m < 4; ++m) { bf16_t* rowp = base + (size_t)(ai * HALF + m * 16) * ldc;
#pragma unroll
                for (int bj = 0; bj < 2; ++bj) { const f32x4 v0 = acc[ai][bj][m][0], v1 = acc[ai][bj][m][1];
                    u32x4 w; w.x = cvt_pk_bf16(v0[0], v0[1]); w.y = cvt_pk_bf16(v0[2], v0[3]); w.z = cvt_pk_bf16(v1[0], v1[1]); w.w = cvt_pk_bf16(v1[2], v1[3]);
                    *(u32x4*)(rowp + bj * HALF) = w; } }
        return false;
    }
};
struct EpiBf16 {
    static constexpr bool PERM = true;
    bf16_t* O; int ldc, coff, kstride;
    __device__ __forceinline__ bool operator()(f32x4 (&acc)[2][2][4][2], const Unit& u, int wr, int wc, int fr, int fq) const {
        bf16_t* base = O + (size_t)(u.pm * 256 + wr * 64 + fr) * ldc + coff + u.kind * kstride + u.pn * 256 + wc * 32 + 8 * fq;
#pragma unroll
        for (int ai = 0; ai < 2; ++ai)
#pragma unroll
            for (int m = 0; m < 4; ++m) { bf16_t* rowp = base + (size_t)(ai * HALF + m * 16) * ldc;
#pragma unroll
                for (int bj = 0; bj < 2; ++bj) { const f32x4 v0 = acc[ai][bj][m][0], v1 = acc[ai][bj][m][1];
                    u32x4 w; w.x = cvt_pk_bf16(v0[0], v0[1]); w.y = cvt_pk_bf16(v0[2], v0[3]); w.z = cvt_pk_bf16(v1[0], v1[1]); w.w = cvt_pk_bf16(v1[2], v1[3]);
                    *(u32x4*)(rowp + bj * HALF) = w; } }
        return false;
    }
};
struct EpiScoreF32 {
    static constexpr bool PERM = false;
    float* S;
    __device__ __forceinline__ bool operator()(f32x4 (&acc)[2][2][4][2], const Unit& u, int wr, int wc, int fr, int fq) const {
        float* base = S + (size_t)(u.pm * 256 + wr * 64 + fr) * 1024 + u.kind * 256 + wc * 32 + 4 * fq;
#pragma unroll
        for (int ai = 0; ai < 2; ++ai)
#pragma unroll
            for (int m = 0; m < 4; ++m) { float* rowp = base + (size_t)(ai * HALF + m * 16) * 1024;
#pragma unroll
                for (int bj = 0; bj < 2; ++bj)
#pragma unroll
                    for (int n = 0; n < 2; ++n) *(f32x4*)(rowp + bj * HALF + n * 16) = acc[ai][bj][m][n]; }
        return false;
    }
};
struct EpiLoraWA {
    static constexpr bool PERM = false;
    const float *w0, *a0; float *RW, *RA;
    __device__ __forceinline__ bool operator()(f32x4 (&acc)[2][2][4][2], const Unit& u, int wr, int wc, int fr, int fq) const {
        const bool isw = u.pn < 6; const int cb = (isw ? u.pn : u.pn - 6) * 256 + wc * 32 + 4 * fq;
        const float* bias = (isw ? w0 : a0) + cb; float* base = (isw ? RW : RA) + (size_t)(u.pm * 256 + wr * 64 + fr) * 1536 + cb;
        f32x4 bv[2][2];
#pragma unroll
        for (int bj = 0; bj < 2; ++bj)
#pragma unroll
            for (int n = 0; n < 2; ++n) bv[bj][n] = *(const f32x4*)(bias + bj * HALF + n * 16);
#pragma unroll
        for (int ai = 0; ai < 2; ++ai)
#pragma unroll
            for (int m = 0; m < 4; ++m) { float* rowp = base + (size_t)(ai * HALF + m * 16) * 1536;
#pragma unroll
                for (int bj = 0; bj < 2; ++bj)
#pragma unroll
                    for (int n = 0; n < 2; ++n) { f32x4 x = acc[ai][bj][m][n] + bv[bj][n]; f32x4 o;
#pragma unroll
                        for (int j = 0; j < 4; ++j) { const float sg = sigmoidf_(x[j]); o[j] = isw ? fexp(-0.6065306597126334f * sg) : sg; }
                        *(f32x4*)(rowp + bj * HALF + n * 16) = o; } }
        return false;
    }
};
struct EpiMerge {
    static constexpr bool PERM = true;
    const bf16_t* P; bf16_t* MG;
    __device__ __forceinline__ bool operator()(f32x4 (&acc)[2][2][4][2], const Unit& u, int wr, int wc, int fr, int fq) const {
        const int b = u.kind; const int row0 = u.pm * 256 + wr * 64 + fr, col0 = u.pn * 256 + wc * 32 + 8 * fq;
        const bf16_t* gbase = P + (size_t)row0 * NINP + PG + 4096 * b + col0;
#pragma unroll
        for (int ai = 0; ai < 2; ++ai) {
            u32x4 g0v[4][2], g1v[4][2];
#pragma unroll
            for (int m = 0; m < 4; ++m)
#pragma unroll
                for (int bj = 0; bj < 2; ++bj) { const bf16_t* gp = gbase + (size_t)(ai * HALF + m * 16) * NINP + bj * HALF; g0v[m][bj] = *(const u32x4*)gp; g1v[m][bj] = (b < 2) ? *(const u32x4*)(gp + 4096) : g0v[m][bj]; }
#pragma unroll
            for (int m = 0; m < 4; ++m) { const size_t row = (size_t)(row0 + ai * HALF + m * 16);
#pragma unroll
                for (int bj = 0; bj < 2; ++bj) { const u32x4 g0 = g0v[m][bj];
                    float e0[8]; const unsigned gw0[4] = {g0.x, g0.y, g0.z, g0.w};
#pragma unroll
                    for (int j = 0; j < 4; ++j) { e0[2 * j] = 1.0f + fexp(-bflo(gw0[j])); e0[2 * j + 1] = 1.0f + fexp(-bfhi(gw0[j])); }
                    if (b < 2) { const u32x4 g1 = g1v[m][bj]; const unsigned gw1[4] = {g1.x, g1.y, g1.z, g1.w};
#pragma unroll
                        for (int j = 0; j < 4; ++j) { const float r0 = (1.0f + fexp(-bflo(gw1[j]))) * frcp(e0[2 * j]), r1 = (1.0f + fexp(-bfhi(gw1[j]))) * frcp(e0[2 * j + 1]);
                            acc[ai][bj][m][j >> 1][(2 * j) & 3] *= r0; acc[ai][bj][m][j >> 1][(2 * j + 1) & 3] *= r1; }
                    } else { float v[8];
#pragma unroll
                        for (int j = 0; j < 8; ++j) v[j] = acc[ai][bj][m][j >> 2][j & 3] * frcp(e0[j]);
                        u32x4 w; w.x = cvt_pk_bf16(v[0], v[1]); w.y = cvt_pk_bf16(v[2], v[3]); w.z = cvt_pk_bf16(v[4], v[5]); w.w = cvt_pk_bf16(v[6], v[7]);
                        *(u32x4*)(MG + row * 4096 + col0 + bj * HALF) = w; } } }
            asm volatile("" ::: "memory");
        }
        return b < 2;
    }
};
struct EpiResF32 {
    static constexpr bool PERM = false;
    const float* res; float* out;
    __device__ __forceinline__ bool operator()(f32x4 (&acc)[2][2][4][2], const Unit& u, int wr, int wc, int fr, int fq) const {
        const size_t off0 = (size_t)(u.pm * 256 + wr * 64 + fr) * 4096 + u.pn * 256 + wc * 32 + 4 * fq;
#pragma unroll
        for (int ai = 0; ai < 2; ++ai)
#pragma unroll
            for (int mp = 0; mp < 2; ++mp) { f32x4 rv[2][2][2];
#pragma unroll
                for (int mm = 0; mm < 2; ++mm)
#pragma unroll
                    for (int bj = 0; bj < 2; ++bj)
#pragma unroll
                        for (int n = 0; n < 2; ++n) rv[mm][bj][n] = *(const f32x4*)(res + off0 + (size_t)(ai * HALF + (2 * mp + mm) * 16) * 4096 + bj * HALF + n * 16);
#pragma unroll
                for (int mm = 0; mm < 2; ++mm) { const size_t off = off0 + (size_t)(ai * HALF + (2 * mp + mm) * 16) * 4096;
#pragma unroll
                    for (int bj = 0; bj < 2; ++bj)
#pragma unroll
                        for (int n = 0; n < 2; ++n) *(f32x4*)(out + off + bj * HALF + n * 16) = rv[mm][bj][n] + acc[ai][bj][2 * mp + mm][n]; }
                asm volatile("" ::: "memory"); }
        return false;
    }
};
struct EpiSwiGLU {
    static constexpr bool PERM = true;
    bf16_t* ACT;
    __device__ __forceinline__ bool operator()(f32x4 (&acc)[2][2][4][2], const Unit& u, int wr, int wc, int fr, int fq) const {
        bf16_t* base = ACT + (size_t)(u.pm * 256 + wr * 64 + fr) * DFF + u.pn * 128 + wc * 32 + 8 * fq;
#pragma unroll
        for (int ai = 0; ai < 2; ++ai)
#pragma unroll
            for (int m = 0; m < 4; ++m) { float v[8];
#pragma unroll
                for (int j = 0; j < 8; ++j) { const float g = acc[ai][0][m][j >> 2][j & 3], up = acc[ai][1][m][j >> 2][j & 3]; v[j] = g * sigmoidf_(g) * up; }
                u32x4 w; w.x = cvt_pk_bf16(v[0], v[1]); w.y = cvt_pk_bf16(v[2], v[3]); w.z = cvt_pk_bf16(v[4], v[5]); w.w = cvt_pk_bf16(v[6], v[7]);
                *(u32x4*)(base + (size_t)(ai * HALF + m * 16) * DFF) = w; }
        return false;
    }
};
}

#define XB_TMO      128
#define XB_XCNT(j)  (256  + 64 * (j))
#define XB_XSUB(j)  (1280 + 64 * (j))
#define XB_XGEN(j)  (2304 + 64 * (j))
#define XB_TOP      3328
#define XB_TOPGEN   3392
#define XCD_BAR_WORDS 3456
#define XB_SPIN_CAP (1u << 18)
__device__ __forceinline__ unsigned xb_ld(unsigned* p)              { return __hip_atomic_load(p, __ATOMIC_RELAXED, __HIP_MEMORY_SCOPE_AGENT); }
__device__ __forceinline__ unsigned xb_add(unsigned* p, unsigned v) { return __hip_atomic_fetch_add(p, v, __ATOMIC_RELAXED, __HIP_MEMORY_SCOPE_AGENT); }
__device__ __forceinline__ unsigned xb_xcc_id() { return (unsigned)__builtin_amdgcn_s_getreg((3 << 11) | 20) & 0xFu; }
#define XB_SPIN(cond, bar) do { unsigned _sp = 0; while (cond) { __builtin_amdgcn_s_sleep(1); \
    if ((++_sp & 255u) == 0u) { if (xb_ld(&(bar)[XB_TMO])) break; if (_sp > XB_SPIN_CAP) { atomicAdd(&(bar)[XB_TMO], 1u); break; } } } } while (0)
struct XcdBarrier { unsigned* bar; unsigned x; volatile LAS unsigned* st; };
__device__ __forceinline__ XcdBarrier xcd_barrier_post(unsigned* bar, volatile LAS unsigned* st) {
    XcdBarrier b; b.bar = bar; b.x = xb_xcc_id(); b.st = st;
    if (threadIdx.x == 0) (void)xb_add(&bar[XB_XCNT(b.x)], 1u);
    return b;
}
__device__ __forceinline__ void xcd_barrier_complete(unsigned* bar, unsigned x, unsigned& nloc, unsigned& nx) {
    const unsigned G = gridDim.x * gridDim.y * gridDim.z;
    unsigned sum, cnt, mine, sp = 0u;
    for (;;) {
        sum = 0u; cnt = 0u; mine = 0u;
#pragma unroll
        for (unsigned j = 0; j < 16; ++j) { const unsigned c = xb_ld(&bar[XB_XCNT(j)]); sum += c; cnt += (c > 0u) ? 1u : 0u; mine = (j == x) ? c : mine; }
        if (sum == G) break;
        __builtin_amdgcn_s_sleep(1);
        if ((++sp & 255u) == 0u) { if (xb_ld(&bar[XB_TMO])) break; if (sp > XB_SPIN_CAP) { atomicAdd(&bar[XB_TMO], 1u); break; } }
    }
    nloc = mine > 0u ? mine : 1u; nx = cnt > 0u ? cnt : 1u;
}
__device__ __forceinline__ void xcd_barrier(const XcdBarrier& b) {
    asm volatile("s_waitcnt vmcnt(0)" ::: "memory");
    __syncthreads();
    if (threadIdx.x == 0) {
        unsigned* bar = b.bar;
        __builtin_amdgcn_s_waitcnt(0);
        unsigned nloc = b.st[0], nx = b.st[1];
        if (nloc == 0u) { xcd_barrier_complete(bar, b.x, nloc, nx); b.st[0] = nloc; b.st[1] = nx; }
        const unsigned old = xb_add(&bar[XB_XSUB(b.x)], 1u);
        const unsigned gen = old / nloc;
        if (old + 1u == (gen + 1u) * nloc) {
            __builtin_amdgcn_fence(__ATOMIC_RELEASE, "agent");
            asm volatile("s_waitcnt vmcnt(0)" ::: "memory");
            const unsigned og = xb_add(&bar[XB_TOP], 1u);
            const unsigned tg = og / nx;
            if (og + 1u == (tg + 1u) * nx) xb_add(&bar[XB_TOPGEN], 1u);
            else XB_SPIN(xb_ld(&bar[XB_TOPGEN]) == tg, bar);
            __builtin_amdgcn_fence(__ATOMIC_ACQUIRE, "agent");
            xb_add(&bar[XB_XGEN(b.x)], 1u);
            asm volatile("s_waitcnt vmcnt(0)" ::: "memory");
        } else {
            XB_SPIN(xb_ld(&bar[XB_XGEN(b.x)]) == gen, bar);
            __builtin_amdgcn_fence(__ATOMIC_ACQUIRE, "agent");
            asm volatile("s_waitcnt vmcnt(0)" ::: "memory");
        }
    }
    __syncthreads();
}

struct Args {
    const float* in[29]; float* out; unsigned char* ws; int ph_lo, ph_hi;
};
enum { I_X = 0, I_MEM, I_ATTN_G, I_MEM_G, I_WIN, I_SBQG, I_SBKG, I_RWMIX, I_RWW0, I_RWWUP, I_RWA0, I_RWAUP, I_RWGUP, I_RWKK, I_RWKA, I_RWRK, I_RWLNG, I_RWLNB,
       I_MEMWKV, I_MEMQG, I_MEMKG, I_WSBO, I_WRWO, I_WMEMO, I_WOUT, I_FFNG, I_WGATE, I_WUP, I_WDOWN };

#define LDS_WAIT() asm volatile("s_waitcnt lgkmcnt(0)" ::: "memory")

__device__ __forceinline__ int rowmap(int mode, int n, int roff) {
    if (mode == 1) return n + (n >= 9952 ? 32 : 0);
    if (mode == 2) return (n >> 7) * 256 + (n & 127);
    if (mode == 3) return (n >> 7) * 256 + 128 + (n & 127);
    return n + roff;
}
__device__ __forceinline__ void transpose_item(const float* W, int N, bf16* WT, int ldk, int koff, int mode, int roff, LAS float* scr, int item, int lane) {
    const int nblk = N / 32, kb = item / nblk, nb = item - kb * nblk, k0 = 64 * kb, n0 = 32 * nb;
    { const int rr = lane >> 3, c4 = (lane & 7) * 4; f32x4 wv[8];
#pragma unroll
      for (int i = 0; i < 8; ++i) wv[i] = *(const GAS f32x4*)(W + (size_t)(k0 + 8 * i + rr) * N + n0 + c4);
#pragma unroll
      for (int i = 0; i < 8; ++i) { LAS float* d = scr + (8 * i + rr) * 33 + c4; d[0] = wv[i].x; d[1] = wv[i].y; d[2] = wv[i].z; d[3] = wv[i].w; } }
    LDS_WAIT(); asm volatile("" ::: "memory");
    const int c = lane & 7;
#pragma unroll
    for (int j = 0; j < 4; ++j) { const int n = (lane >> 3) + 8 * j; const LAS float* s = scr + (8 * c) * 33 + n;
        v4u o; o.x = pk2(s[0 * 33], s[1 * 33]); o.y = pk2(s[2 * 33], s[3 * 33]); o.z = pk2(s[4 * 33], s[5 * 33]); o.w = pk2(s[6 * 33], s[7 * 33]);
        *(GAS v4u*)(WT + (size_t)rowmap(mode, n0 + n, roff) * ldk + koff + k0 + 8 * c) = o; }
    LDS_WAIT(); asm volatile("" ::: "memory");
}
__device__ __forceinline__ void rms_rows4096(const float* x, const float* g, bf16* out, int first, int stride, int nrows, int lane) {
    if (first >= nrows) return;
    f32x4 v[16], nv[16];
    { const GAS f32x4* xr = (const GAS f32x4*)(x + (size_t)first * 4096) + lane;
#pragma unroll
      for (int j = 0; j < 16; ++j) v[j] = xr[64 * j]; }
    const GAS f32x4* gr = (const GAS f32x4*)g + lane;
    for (int m = first; m < nrows; m += stride) {
        const bool more = m + stride < nrows;
        if (more) { const GAS f32x4* xr = (const GAS f32x4*)(x + (size_t)(m + stride) * 4096) + lane;
#pragma unroll
            for (int j = 0; j < 16; ++j) nv[j] = xr[64 * j]; }
        float s = 0.f;
#pragma unroll
        for (int j = 0; j < 16; ++j) s += (v[j].x * v[j].x + v[j].y * v[j].y) + (v[j].z * v[j].z + v[j].w * v[j].w);
        const float rstd = 1.0f / sqrtf(wave_sum(s) * (1.f / 4096.f) + RMS_EPS);
        GAS v2u* o8 = (GAS v2u*)(out + (size_t)m * 4096) + lane;
#pragma unroll
        for (int j = 0; j < 16; ++j) { const f32x4 gv = gr[64 * j]; v2u o; o.x = pk2(v[j].x * rstd * gv.x, v[j].y * rstd * gv.y); o.y = pk2(v[j].z * rstd * gv.z, v[j].w * rstd * gv.w); o8[64 * j] = o; }
        if (more) {
#pragma unroll
            for (int j = 0; j < 16; ++j) v[j] = nv[j]; }
    }
}
#define QB 16
#define QUEUE_PULL(headword, nitems, BODY) do { for (;;) { int it_ = 0; if ((threadIdx.x & 63) == 0) it_ = (int)__hip_atomic_fetch_add((unsigned*)(headword), (unsigned)QB, __ATOMIC_RELAXED, __HIP_MEMORY_SCOPE_AGENT); \
        it_ = __builtin_amdgcn_readfirstlane(it_); if (it_ >= (nitems)) break; const int qe_ = (it_ + QB < (nitems)) ? it_ + QB : (nitems); \
        for (int qi = it_; qi < qe_; ++qi) { BODY; } } } while (0)
constexpr int NPHASES = 12;
__global__ void __launch_bounds__(NWAVES * 64, 2) hybrid_fwd(Args args) {
    extern __shared__ __attribute__((aligned(16))) unsigned char lds_raw[];
    LAS unsigned char* lds = (LAS unsigned char*)lds_raw;
    volatile LAS unsigned* MISC = (volatile LAS unsigned*)(lds + MISC_OFF);
    const int G = gridDim.x, bx = blockIdx.x, NGW = G * NWAVES;
    unsigned char* ws = args.ws;
    gu32* ctl = (gu32*)(ws + WS_CTL);
    for (int u = threadIdx.x; u < (LDS_BYTES - LDSCTL_OFF) / 4; u += NWAVES * 64) ((LAS unsigned*)(lds + LDSCTL_OFF))[u] = 0u;
#define PHASE_IDS() int tid = threadIdx.x; asm volatile("" : "+v"(tid)); const int lane = tid & 63, wave = __builtin_amdgcn_readfirstlane(tid >> 6), gw = bx * NWAVES + wave; (void)lane; (void)gw
    __syncthreads();
#if MK_PER_PHASE
    XcdBarrier bar; bar.bar = (unsigned*)(ctl + CW_BAR); bar.x = 0; bar.st = nullptr;
#define GRID_BAR() do { } while (0)
#else
    XcdBarrier bar = xcd_barrier_post((unsigned*)(ctl + CW_BAR), MISC + 8);
#define GRID_BAR() xcd_barrier(bar)
#endif
    const int lo = args.ph_lo, hi = args.ph_hi;
#define IN(k) (lo <= (k) && (k) < hi)
#define BOTH(k) (IN(k) && IN((k) + 1))

    bf16* WIN_T = (bf16*)(ws + WS_WIN_T); bf16* WCAT_T = (bf16*)(ws + WS_WCAT_T); bf16* WOUT_T = (bf16*)(ws + WS_WOUT_T); bf16* WKV_T = (bf16*)(ws + WS_WKV_T);
    bf16* LBWA = (bf16*)(ws + WS_LBWA); bf16* LBG = (bf16*)(ws + WS_LBG); bf16* XN = (bf16*)(ws + WS_XN); bf16* MEMN = (bf16*)(ws + WS_MEMN); bf16* P = (bf16*)(ws + WS_P);
    float* R_R = (float*)(ws + WS_R); float* R_W = (float*)(ws + WS_R + RSZ); float* R_KP = (float*)(ws + WS_R + 2 * RSZ); float* R_V = (float*)(ws + WS_R + 3 * RSZ);
    float* R_KK = (float*)(ws + WS_R + 4 * RSZ); float* R_NB = (float*)(ws + WS_R + 5 * RSZ);
    bf16* GB = (bf16*)(ws + WS_G); float* Y = (float*)(ws + WS_Y); bf16* OCAT = (bf16*)(ws + WS_OCAT);
    bf16* QN = (bf16*)(ws + WS_QN); bf16* KN = (bf16*)(ws + WS_KN); bf16* VT = (bf16*)(ws + WS_VT); bf16* MQN = (bf16*)(ws + WS_MQN);
    bf16* MKRAW = (bf16*)(ws + WS_MKRAW); bf16* MKN = (bf16*)(ws + WS_MKN); bf16* MVT = (bf16*)(ws + WS_MVT);
    float* SM = (float*)(ws + WS_SM); bf16* PM = (bf16*)(ws + WS_PM); bf16* LA1 = (bf16*)(ws + WS_LA1); bf16* LA2 = (bf16*)(ws + WS_LA2);
    float* S0ALL = R_R;     float* BONUS = (float*)(ws + WS_BONUS);
    float* PHIT = (float*)(ws + WS_PHIT); float* PCT = (float*)(ws + WS_PCT); float* SLOCT = (float*)(ws + WS_SLOCT);
    bf16* WGU_T = (bf16*)(ws + WS_WGU_T); bf16* WD_T = (bf16*)(ws + WS_WD_T); bf16* MERGED = (bf16*)(ws + WS_MERGED); float* H1 = (float*)(ws + WS_H1); bf16* ACT = (bf16*)(ws + WS_ACT);

#define Q1_ITEMS (24 * 128 + 24 * 128 + 16 * 128 + 64 * 128 + 172 * 128)
#define Q1_BODY { int r = qi; LAS float* scr = (LAS float*)(lds + wave * 16384); \
        if (r < 24 * 128) transpose_item(args.in[I_WSBO], 4096, WCAT_T, 4096, 0, 0, 0, scr, r, lane); \
        else if ((r -= 24 * 128) < 24 * 128) transpose_item(args.in[I_WRWO], 4096, WCAT_T, 4096, 1536, 0, 0, scr, r, lane); \
        else if ((r -= 24 * 128) < 16 * 128) transpose_item(args.in[I_WMEMO], 4096, WCAT_T, 4096, 3072, 0, 0, scr, r, lane); \
        else if ((r -= 16 * 128) < 64 * 128) transpose_item(args.in[I_WOUT], 4096, WOUT_T, 4096, 0, 0, 0, scr, r, lane); \
        else { r -= 64 * 128; transpose_item(args.in[I_WDOWN], 4096, WD_T, DFF, 0, 0, 0, scr, r, lane); } }
#define Q2_ITEMS (2 * 64 * 344)
#define Q2_BODY { int r = qi; LAS float* scr2 = (LAS float*)(lds + wave * 16384); \
        if (r < 64 * 344) transpose_item(args.in[I_WGATE], DFF, WGU_T, 4096, 0, 2, 0, scr2, r, lane); \
        else transpose_item(args.in[I_WUP], DFF, WGU_T, 4096, 0, 3, 0, scr2, r - 64 * 344, lane); }
    if (IN(0)) {
        PHASE_IDS();
        LAS float* scr = (LAS float*)(lds + wave * 16384);
        constexpr int I_IN = 64 * 727, I_KV = 64 * 64;
        constexpr int NITEMS = I_IN + I_KV;
        for (int it = gw; it < NITEMS; it += NGW) {
            int r = it;
            if (r < I_IN) { transpose_item(args.in[I_WIN], NIN_ORIG, WIN_T, 4096, 0, 1, 0, scr, r, lane); continue; } r -= I_IN;
            transpose_item(args.in[I_MEMWKV], 2048, WKV_T, 4096, 0, 0, 0, scr, r, lane);
        }
        for (int i = bx * 512 + tid; i < 32 * 4096 / 8; i += G * 512) ((GAS v4u*)(WIN_T + (size_t)9952 * 4096))[i] = (v4u){0u, 0u, 0u, 0u};
        for (int i = bx * 512 + tid; i < 3072 * 256; i += G * 512) { const int n = i >> 8, k = i & 255; float v = 0.f;
            if (n < 1536) { if (k < 128) v = args.in[I_RWWUP][(size_t)k * 1536 + n]; } else { if (k >= 128) v = args.in[I_RWAUP][(size_t)(k - 128) * 1536 + (n - 1536)]; }
            LBWA[i] = (bf16)f2bf(v); }
        for (int i = bx * 512 + tid; i < 1536 * 512; i += G * 512) { const int n = i >> 9, k = i & 511; const float v = (k < 480) ? args.in[I_RWGUP][(size_t)k * 1536 + n] : 0.f; LBG[i] = (bf16)f2bf(v); }
        rms_rows4096(args.in[I_X], args.in[I_ATTN_G], XN, gw, NGW, T, lane);
        rms_rows4096(args.in[I_MEM], args.in[I_MEM_G], MEMN, gw, NGW, NMEM, lane);
        if (BOTH(0)) GRID_BAR();
    }

    if (IN(1)) {
        PHASE_IDS();
        pg8::SchedGemm1 S; S.to.init(32, 91); S.G = G; S.c = bx; S.XN = (const char*)XN; S.WIN = (const char*)WIN_T; S.MEMN = (const char*)MEMN; S.WKV = (const char*)WKV_T;
        pg8::EpiGemm1 E{P, MKRAW, MVT};
        pg8::gemm_phase(lds, 4096, 4096, S, E);
        QUEUE_PULL(ctl + CW_Q1, Q1_ITEMS, Q1_BODY);
        if (BOTH(1)) GRID_BAR();
    }

    if (IN(2)) {
        PHASE_IDS();
        QUEUE_PULL(ctl + CW_Q1, Q1_ITEMS, Q1_BODY);
        __syncthreads();
        {
            const float qscale = 0.08838834764831845f * 1.4426950408889634f;
            for (int t = gw; t < T; t += NGW) {
                const bf16* prow = P + (size_t)t * NINP;
#pragma unroll
                for (int which = 0; which < 2; ++which) {
                    const float* gain = args.in[which ? I_SBKG : I_SBQG]; bf16* dst = (which ? KN : QN) + (size_t)t * 1536; const int cb = which ? PK : PQ;
                    const f32x4 g0 = *(const GAS f32x4*)(gain + (8 * lane & 127)), g1 = *(const GAS f32x4*)(gain + (8 * lane & 127) + 4);
#pragma unroll
                    for (int p = 0; p < 3; ++p) {
                        const v4u raw = *(const GAS v4u*)(prow + cb + 512 * p + 8 * lane);
                        float v[8] = {bflo(raw.x), bfhi(raw.x), bflo(raw.y), bfhi(raw.y), bflo(raw.z), bfhi(raw.z), bflo(raw.w), bfhi(raw.w)};
                        float ss = 0.f;
#pragma unroll
                        for (int j = 0; j < 8; ++j) ss += v[j] * v[j];
                        ss = red16_sum(ss);
                        const float rstd = (which ? 1.0f : qscale) / sqrtf(ss * (1.f / 128.f) + RMS_EPS);
                        v4u o; o.x = pk2(v[0] * rstd * g0.x, v[1] * rstd * g0.y); o.y = pk2(v[2] * rstd * g0.z, v[3] * rstd * g0.w);
                        o.z = pk2(v[4] * rstd * g1.x, v[5] * rstd * g1.y); o.w = pk2(v[6] * rstd * g1.z, v[7] * rstd * g1.w);
                        *(GAS v4u*)(dst + 512 * p + 8 * lane) = o;
                    }
                }
                {
                    const float* gain = args.in[I_MEMQG] + ((16 * lane) & 255);
                    const v4u r0 = *(const GAS v4u*)(prow + PMQ + 16 * lane), r1 = *(const GAS v4u*)(prow + PMQ + 16 * lane + 8);
                    float v[16] = {bflo(r0.x), bfhi(r0.x), bflo(r0.y), bfhi(r0.y), bflo(r0.z), bfhi(r0.z), bflo(r0.w), bfhi(r0.w), bflo(r1.x), bfhi(r1.x), bflo(r1.y), bfhi(r1.y), bflo(r1.z), bfhi(r1.z), bflo(r1.w), bfhi(r1.w)};
                    float ss = 0.f;
#pragma unroll
                    for (int j = 0; j < 16; ++j) ss += v[j] * v[j];
                    ss = red16_sum(ss);
                    const float rstd = 0.0625f / sqrtf(ss * (1.f / 256.f) + RMS_EPS);
                    unsigned o[8];
#pragma unroll
                    for (int j = 0; j < 8; ++j) o[j] = pk2(v[2 * j] * rstd * gain[2 * j], v[2 * j + 1] * rstd * gain[2 * j + 1]);
                    *(GAS v4u*)(MQN + (size_t)t * 1024 + 16 * lane) = (v4u){o[0], o[1], o[2], o[3]};
                    *(GAS v4u*)(MQN + (size_t)t * 1024 + 16 * lane + 8) = (v4u){o[4], o[5], o[6], o[7]};
                }
            }
            for (int m = gw; m < NMEM; m += NGW) {
                const float* gain = args.in[I_MEMKG] + ((16 * lane) & 255);
                const v4u r0 = *(const GAS v4u*)(MKRAW + (size_t)m * 1024 + 16 * lane), r1 = *(const GAS v4u*)(MKRAW + (size_t)m * 1024 + 16 * lane + 8);
                float v[16] = {bflo(r0.x), bfhi(r0.x), bflo(r0.y), bfhi(r0.y), bflo(r0.z), bfhi(r0.z), bflo(r0.w), bfhi(r0.w), bflo(r1.x), bfhi(r1.x), bflo(r1.y), bfhi(r1.y), bflo(r1.z), bfhi(r1.z), bflo(r1.w), bfhi(r1.w)};
                float ss = 0.f;
#pragma unroll
                for (int j = 0; j < 16; ++j) ss += v[j] * v[j];
                ss = red16_sum(ss);
                const float rstd = 1.0f / sqrtf(ss * (1.f / 256.f) + RMS_EPS);
                unsigned o[8];
#pragma unroll
                for (int j = 0; j < 8; ++j) o[j] = pk2(v[2 * j] * rstd * gain[2 * j], v[2 * j + 1] * rstd * gain[2 * j + 1]);
                *(GAS v4u*)(MKN + (size_t)m * 1024 + 16 * lane) = (v4u){o[0], o[1], o[2], o[3]};
                *(GAS v4u*)(MKN + (size_t)m * 1024 + 16 * lane + 8) = (v4u){o[4], o[5], o[6], o[7]};
            }
        }
        {
            LAS unsigned char* scr = lds + wave * 16640;
            for (int it = gw; it < 12 * 128; it += NGW) {
                const int h = it >> 7, t0 = (it & 127) * 64;
#pragma unroll
                for (int i = 0; i < 16; ++i) { const int tt = 4 * i + (lane >> 4), c = lane & 15;
                    const v4u raw = *(const GAS v4u*)(P + (size_t)(t0 + tt) * NINP + PV + 128 * h + 8 * c);
                    LAS unsigned* d = (LAS unsigned*)(scr + tt * 260 + c * 16); d[0] = raw.x; d[1] = raw.y; d[2] = raw.z; d[3] = raw.w; }
                LDS_WAIT(); asm volatile("" ::: "memory");
#pragma unroll
                for (int i = 0; i < 16; ++i) { const int d = 8 * i + (lane >> 3), tc = lane & 7;
                    unsigned short e[8];
#pragma unroll
                    for (int j = 0; j < 8; ++j) e[j] = *(const LAS unsigned short*)(scr + (8 * tc + j) * 260 + d * 2);
                    v4u o; o.x = e[0] | ((unsigned)e[1] << 16); o.y = e[2] | ((unsigned)e[3] << 16); o.z = e[4] | ((unsigned)e[5] << 16); o.w = e[6] | ((unsigned)e[7] << 16);
                    *(GAS v4u*)(VT + ((size_t)h * 128 + d) * T + t0 + 8 * tc) = o; }
                LDS_WAIT(); asm volatile("" ::: "memory");
            }
        }
        {
            const float* mix = args.in[I_RWMIX];
            for (int t = gw; t < T; t += NGW) {
                const bf16* cur = P + (size_t)t * NINP + PRW; const bf16* prv = cur - NINP;
                for (int c8 = 576 + lane; c8 < RWSEG / 8; c8 += 64) {
                    const int c0 = 8 * c8;
                    const v4u rc = *(const GAS v4u*)(cur + c0); v4u rp = (v4u){0u, 0u, 0u, 0u}; if (t > 0) rp = *(const GAS v4u*)(prv + c0);
                    const f32x4 m0 = *(const GAS f32x4*)(mix + c0), m1 = *(const GAS f32x4*)(mix + c0 + 4);
                    const float cv[8] = {bflo(rc.x), bfhi(rc.x), bflo(rc.y), bfhi(rc.y), bflo(rc.z), bfhi(rc.z), bflo(rc.w), bfhi(rc.w)};
                    const float pv[8] = {bflo(rp.x), bfhi(rp.x), bflo(rp.y), bfhi(rp.y), bflo(rp.z), bfhi(rp.z), bflo(rp.w), bfhi(rp.w)};
                    const float mv[8] = {m0.x, m0.y, m0.z, m0.w, m1.x, m1.y, m1.z, m1.w};
                    float s[8];
#pragma unroll
                    for (int j = 0; j < 8; ++j) s[j] = cv[j] + (pv[j] - cv[j]) * mv[j];
                    if (c0 < 4864) { const bool isw = c0 < 4736;
                        if (isw) {
#pragma unroll
                            for (int j = 0; j < 8; ++j) { const float e = fexp(2.f * s[j]); s[j] = 1.f - 2.f * frcp(e + 1.f); } }
                        *(GAS v4u*)(LA1 + (size_t)t * 256 + (c0 - 4608)) = (v4u){pk2(s[0], s[1]), pk2(s[2], s[3]), pk2(s[4], s[5]), pk2(s[6], s[7])}; }
                    else {
#pragma unroll
                        for (int j = 0; j < 8; ++j) s[j] = sigmoidf_(s[j]);
                        *(GAS v4u*)(LA2 + (size_t)t * 512 + (c0 - 4864)) = (v4u){pk2(s[0], s[1]), pk2(s[2], s[3]), pk2(s[4], s[5]), pk2(s[6], s[7])}; }
                }
                if (lane < 4) *(GAS v4u*)(LA2 + (size_t)t * 512 + 480 + 8 * lane) = (v4u){0u, 0u, 0u, 0u};
            }
        }
        if (BOTH(2)) GRID_BAR();
    }

    if (IN(3)) {
        PHASE_IDS();
        int nt4 = 4, nt8 = 8; asm volatile("" : "+s"(nt4), "+s"(nt8));
        { pg8::SchedPlain S; S.to.init(32, 12); S.G = G; S.c = bx; S.nt = nt4; S.A0 = (const char*)LA1; S.B0 = (const char*)LBWA; S.sA = 256 * 256 * 2; S.sB = 256 * 256 * 2;
          pg8::EpiLoraWA E{args.in[I_RWW0], args.in[I_RWA0], R_W, R_NB};
          pg8::gemm_phase(lds, 256, 256, S, E); }
        { pg8::SchedPlain S; S.to.init(32, 6); S.G = G; S.c = (bx + G - 64) % G; S.nt = nt8; S.A0 = (const char*)LA2; S.B0 = (const char*)LBG; S.sA = 256 * 512 * 2; S.sB = 256 * 512 * 2;
          pg8::EpiBf16 E{GB, 1536, 0, 0};
          pg8::gemm_phase(lds, 512, 512, S, E); }
        { pg8::SchedHeads S; S.G = G; S.c = (bx + G - 128) % G; S.nunits = 128; S.nt = nt4; S.A0 = (const char*)MQN; S.B0 = (const char*)MKN; S.sA = 256 * 1024 * 2; S.hA = 512; S.hB = 512;
          pg8::EpiScoreF32 E{SM};
          pg8::gemm_phase(lds, 1024, 1024, S, E); }
        if (BOTH(3)) GRID_BAR();
    }

    if (IN(4)) {
        PHASE_IDS();
        constexpr int RP = 260, SLOT = 64 * RP, NP = 272;
        constexpr int S_AT = 0, S_BT = SLOT, S_KT = 2 * SLOT, S_RT = 3 * SLOT, S_NABT = 4 * SLOT, S_NAK = S_NABT + 64 * NP, S_MBR = S_NAK + SLOT, S_MKR = S_MBR + SLOT, S_SEG = S_MKR + SLOT, S_GC = S_SEG + 2048;
        static_assert(S_GC + 256 <= LDSCTL_OFF, "chunk-prep LDS map");
        constexpr int HP = 144, HSL = 64 * HP, H_AT = S_NABT, H_BT = H_AT + HSL, H_KT = H_BT + HSL, H_RT = H_KT + HSL;
        static_assert(H_RT + HSL <= S_SEG, "bf16 operand copies inside the Gram output slots");
        constexpr int H_PSIT = S_GC + 256, H_QCT = H_PSIT + HSL;
        static_assert(H_QCT + HSL <= LDSCTL_OFF, "chunk-prep LDS map (bf16 step-F operands)");
        const int l31 = lane & 31, lh = lane >> 5;
        float nwv[8], nkrv[8], nav[8], nrv[8], nvv[8];
        unsigned short pr_[9], pk_[9], pv_[9];
#define S1_FETCH(it_) do { const int t0_ = ((it_) & 127) * 64 + 8 * wave, hc_ = ((it_) >> 7) * 64 + lane; const size_t gb_ = (size_t)t0_ * 1536 + hc_; \
            _Pragma("unroll") for (int i = 0; i < 8; ++i) { const size_t o_ = gb_ + (size_t)i * 1536; nwv[i] = R_W[o_]; nav[i] = R_NB[o_]; } \
            const bf16* pb_ = P + (size_t)t0_ * NINP + PRW + hc_; \
            _Pragma("unroll") for (int i = 0; i < 9; ++i) { const bool ok_ = (t0_ + i) > 0; const bf16* pp_ = pb_ + (ptrdiff_t)(i - 1) * NINP; \
                pr_[i] = ok_ ? pp_[0] : (unsigned short)0; pk_[i] = ok_ ? pp_[1536] : (unsigned short)0; pv_[i] = ok_ ? pp_[3072] : (unsigned short)0; } } while (0)
#define S1_SHIFT() do { const int hc_ = head * 64 + lane; const float mr_ = args.in[I_RWMIX][hc_], mk_ = args.in[I_RWMIX][1536 + hc_], mv_ = args.in[I_RWMIX][3072 + hc_]; \
            _Pragma("unroll") for (int i = 0; i < 8; ++i) { const float cr_ = bflo(pr_[i + 1]), ck_ = bflo(pk_[i + 1]), cv_ = bflo(pv_[i + 1]); \
                nrv[i] = cr_ + (bflo(pr_[i]) - cr_) * mr_; nkrv[i] = ck_ + (bflo(pk_[i]) - ck_) * mk_; nvv[i] = cv_ + (bflo(pv_[i]) - cv_) * mv_; } } while (0)
        if (bx < 24 * 128) S1_FETCH(bx);
        for (int item = bx; item < 24 * 128; item += G) {
            const int head = item >> 7, chunk = item & 127;
            float vv[8];
            {
                S1_SHIFT();
                float nkkv[8], nnbv[8], nkpv[8];
                { const float kkc = args.in[I_RWKK][head * 64 + lane], kac = args.in[I_RWKA][head * 64 + lane];
#pragma unroll
                  for (int i = 0; i < 8; ++i) { const float kq = nkrv[i] * kkc; float ss = red16_sum(kq * kq); ss += __shfl_xor(ss, 16); ss += __shfl_xor(ss, 32);
                      const float kn = kq * (1.0f / fmaxf(sqrtf(ss), 1e-12f)); nkkv[i] = kn; nnbv[i] = -(kn * nav[i]); nkpv[i] = nkrv[i] * (1.0f + (nav[i] - 1.0f) * kac); } }
                float g[8]; g[0] = nwv[0];
#pragma unroll
                for (int i = 1; i < 8; ++i) g[i] = g[i - 1] * nwv[i];
                *(LAS float*)(lds + S_SEG + (wave * 64 + lane) * 4) = g[7];
                __syncthreads();
                float pre = 1.0f;
                for (int w2 = 0; w2 < wave; ++w2) pre *= *(LAS const float*)(lds + S_SEG + (w2 * 64 + lane) * 4);
                float avs[8];
#pragma unroll
                for (int i = 0; i < 8; ++i) { const float gt = pre * g[i], gp = (i == 0) ? pre : pre * g[i - 1], inv = 1.0f / gt; const int o = (8 * wave + i) * RP + lane * 4;
                    const float av = nkkv[i] * gp, bv = nnbv[i] * inv, kv = nkpv[i] * inv, rvv = nrv[i] * gt;
                    avs[i] = av; *(LAS float*)(lds + S_BT + o) = bv; *(LAS float*)(lds + S_KT + o) = kv; *(LAS float*)(lds + S_RT + o) = rvv; vv[i] = nvv[i];
                    const int ob = (8 * wave + i) * HP + lane * 2;
                    *(LAS unsigned short*)(lds + H_AT + ob) = (unsigned short)f2bf(av); *(LAS unsigned short*)(lds + H_BT + ob) = (unsigned short)f2bf(bv);
                    *(LAS unsigned short*)(lds + H_KT + ob) = (unsigned short)f2bf(kv); *(LAS unsigned short*)(lds + H_RT + ob) = (unsigned short)f2bf(rvv); }
                *(LAS v4u*)(lds + S_AT + lane * HP + wave * 16) = (v4u){pk2(avs[0], avs[1]), pk2(avs[2], avs[3]), pk2(avs[4], avs[5]), pk2(avs[6], avs[7])};
                if (wave == 7) *(LAS float*)(lds + S_GC + lane * 4) = pre * g[7];
                { const float rkl = args.in[I_RWRK][head * 64 + lane];
#pragma unroll
                  for (int i = 0; i < 8; ++i) { const float bsum = wave_sum(nrv[i] * nkpv[i] * rkl); if (lane == 0) BONUS[(size_t)(chunk * 64 + 8 * wave + i) * 24 + head] = bsum; } }
                if (item + G < 24 * 128) S1_FETCH(item + G);
                __syncthreads();
            }
            {
                const int Ls = (wave >> 2) ? H_KT : H_BT, Rs = ((wave >> 1) & 1) ? H_RT : H_AT, hm = wave & 1, which = wave >> 1;
                LAS const unsigned char* Lp = lds + Ls + (32 * hm + l31) * HP + lh * 16;
                LAS const unsigned char* Rp = lds + Rs + l31 * HP + lh * 16;
                f32x16 acc0, acc1;
#pragma unroll
                for (int r = 0; r < 16; ++r) { acc0[r] = 0.f; acc1[r] = 0.f; }
#pragma unroll
                for (int ks = 0; ks < 4; ++ks) { const bf16x8 a = *(LAS const bf16x8*)(Lp + ks * 32), b0 = *(LAS const bf16x8*)(Rp + ks * 32), b1 = *(LAS const bf16x8*)(Rp + 32 * HP + ks * 32);
                    acc0 = __builtin_amdgcn_mfma_f32_32x32x16_bf16(a, b0, acc0, 0, 0, 0); acc1 = __builtin_amdgcn_mfma_f32_32x32x16_bf16(a, b1, acc1, 0, 0, 0); }
                __syncthreads();
                const bool strict = (which == 0) || (which == 2);
#pragma unroll
                for (int nt = 0; nt < 2; ++nt)
#pragma unroll
                    for (int r = 0; r < 16; ++r) { const int j = 32 * hm + (r & 3) + 8 * (r >> 2) + 4 * lh, t = 32 * nt + l31; float val = nt ? acc1[r] : acc0[r];
                        const bool keep = strict ? (j < t) : (j <= t); val = keep ? val : 0.f;
                        int off;
                        if (which == 0) off = S_NABT + t * NP + ((j & 3) * 16 + (j >> 2)) * 4;
                        else off = (which == 1 ? S_MBR : S_MKR) + j * RP + t * 4;
                        if (which == 2) *(LAS unsigned short*)(lds + S_NAK + j * HP + t * 2) = (unsigned short)f2bf(val);
                        else *(LAS float*)(lds + off) = val; }
                __syncthreads();
            }
            {
                const int ci = lane >> 2, g = lane & 3, c = 16 * (wave & 3) + ci; const int slot = (wave < 4) ? S_MBR : S_BT;
                float xr[16];
#pragma unroll
                for (int q = 0; q < 16; ++q) xr[q] = *(LAS const float*)(lds + slot + (4 * q + g) * RP + c * 4);
                __syncthreads();
#pragma unroll
                for (int t = 63; t >= 1; --t) {
                    const float xt = quad_bcast(xr[t >> 2], t & 3);
                    const int nq = (t >> 2) + 1;
#pragma unroll
                    for (int qg = 0; 4 * qg < nq; ++qg) { const f32x4 cf = *(LAS const f32x4*)(lds + S_NABT + t * NP + (g * 16 + 4 * qg) * 4);
#pragma unroll
                        for (int e = 0; e < 4; ++e) if (4 * qg + e < nq) xr[4 * qg + e] = fmaf(cf[e], xt, xr[4 * qg + e]); }
                }
#pragma unroll
                for (int q = 0; q < 16; ++q) *(LAS unsigned short*)(lds + slot + c * HP + (4 * q + g) * 2) = (unsigned short)f2bf(xr[q]);
                __syncthreads();
            }
            {
                const int which = wave >> 2, hm = (wave >> 1) & 1, ch = wave & 1; const int Xs = ch ? S_BT : S_MBR;
                LAS const unsigned char* Ap = lds + (which ? S_NAK : S_AT) + (32 * hm + l31) * HP + lh * 16;
                LAS const unsigned char* Bp = lds + Xs + l31 * HP + lh * 16;
                f32x16 acc0, acc1;
#pragma unroll
                for (int nt = 0; nt < 2; ++nt)
#pragma unroll
                    for (int r = 0; r < 16; ++r) { const int m = 32 * hm + (r & 3) + 8 * (r >> 2) + 4 * lh, n = 32 * nt + l31; float iv;
                        if (which == 0) iv = ch ? ((m == n) ? 1.0f : 0.0f) : *(LAS const float*)(lds + S_RT + n * RP + m * 4);
                        else iv = *(LAS const float*)(lds + (ch ? S_KT : S_MKR) + m * RP + n * 4);
                        if (nt) acc1[r] = iv; else acc0[r] = iv; }
#pragma unroll
                for (int ks = 0; ks < 4; ++ks) { const bf16x8 a = *(LAS const bf16x8*)(Ap + ks * 32), b0 = *(LAS const bf16x8*)(Bp + ks * 32), b1 = *(LAS const bf16x8*)(Bp + 32 * HP + ks * 32);
                    acc0 = __builtin_amdgcn_mfma_f32_32x32x16_bf16(a, b0, acc0, 0, 0, 0); acc1 = __builtin_amdgcn_mfma_f32_32x32x16_bf16(a, b1, acc1, 0, 0, 0); }
#pragma unroll
                for (int nt = 0; nt < 2; ++nt) { const int n = 32 * nt + l31; const float gcn = ch ? *(LAS const float*)(lds + S_GC + n * 4) : 1.0f;
                    if (which == 0) { float* dst = (ch ? PCT : PHIT) + ((size_t)item * 64 + n) * 64 + 32 * hm + 4 * lh;
#pragma unroll
                        for (int i = 0; i < 4; ++i) { f32x4 o;
#pragma unroll
                            for (int e = 0; e < 4; ++e) o[e] = (nt ? acc1[4 * i + e] : acc0[4 * i + e]) * gcn;
                            *(GAS f32x4*)(dst + 8 * i) = o; } }
                    else {
#pragma unroll
                        for (int i = 0; i < 4; ++i) { const int j0 = 32 * hm + 8 * i + 4 * lh; float o[4];
#pragma unroll
                            for (int e = 0; e < 4; ++e) o[e] = (nt ? acc1[4 * i + e] : acc0[4 * i + e]) * gcn;
                            *(LAS v2u*)(lds + (ch ? H_QCT : H_PSIT) + n * HP + j0 * 2) = (v2u){pk2(o[0], o[1]), pk2(o[2], o[3])}; } } }
#pragma unroll
                for (int i = 0; i < 1; ++i) *(LAS v4u*)(lds + S_NABT + lane * HP + wave * 16) = (v4u){pk2(vv[0], vv[1]), pk2(vv[2], vv[3]), pk2(vv[4], vv[5]), pk2(vv[6], vv[7])};
                __syncthreads();
            }
            {
                const int hm = wave >> 2, ct = wave & 3, nt = ct & 1; const int Bs = (ct < 2) ? H_PSIT : H_QCT;
                LAS const unsigned char* Ap = lds + S_NABT + (32 * hm + l31) * HP + lh * 16;
                LAS const unsigned char* Bp = lds + Bs + (32 * nt + l31) * HP + lh * 16;
                f32x16 acc;
#pragma unroll
                for (int r = 0; r < 16; ++r) acc[r] = 0.f;
#pragma unroll
                for (int ks = 0; ks < 4; ++ks) acc = __builtin_amdgcn_mfma_f32_32x32x16_bf16(*(LAS const bf16x8*)(Ap + ks * 32), *(LAS const bf16x8*)(Bp + ks * 32), acc, 0, 0, 0);
                const int n = 32 * nt + l31;
                float* dst = (ct < 2) ? (Y + (size_t)(chunk * 64 + n) * 1536 + head * 64 + 32 * hm + 4 * lh) : (SLOCT + ((size_t)item * 64 + n) * 64 + 32 * hm + 4 * lh);
#pragma unroll
                for (int i = 0; i < 4; ++i) *(GAS f32x4*)(dst + 8 * i) = (f32x4){acc[4 * i], acc[4 * i + 1], acc[4 * i + 2], acc[4 * i + 3]};
                __syncthreads();
            }
        }
        for (int t = gw; t < T; t += NGW) {
            {
                const float* srow = SM + (size_t)t * 1024 + 16 * lane; f32x4 s[4]; float mx = -3.0e38f;
#pragma unroll
                for (int j = 0; j < 4; ++j) { s[j] = *(const GAS f32x4*)(srow + 4 * j); mx = fmaxf(mx, fmaxf(fmaxf(s[j].x, s[j].y), fmaxf(s[j].z, s[j].w))); }
                mx = red16_max(mx); float sum = 0.f;
#pragma unroll
                for (int j = 0; j < 4; ++j) { s[j].x = fexp(s[j].x - mx); s[j].y = fexp(s[j].y - mx); s[j].z = fexp(s[j].z - mx); s[j].w = fexp(s[j].w - mx); sum += (s[j].x + s[j].y) + (s[j].z + s[j].w); }
                sum = red16_sum(sum); const float inv = 1.0f / sum;
                unsigned o[8];
#pragma unroll
                for (int j = 0; j < 4; ++j) { o[2 * j] = pk2(s[j].x * inv, s[j].y * inv); o[2 * j + 1] = pk2(s[j].z * inv, s[j].w * inv); }
                *(GAS v4u*)(PM + (size_t)t * 1024 + 16 * lane) = (v4u){o[0], o[1], o[2], o[3]};
                *(GAS v4u*)(PM + (size_t)t * 1024 + 16 * lane + 8) = (v4u){o[4], o[5], o[6], o[7]};
            }
        }
        if (BOTH(4)) GRID_BAR();
    }

    if (IN(5)) {
        PHASE_IDS();
        constexpr int NSCAN = 96;
        if (bx < NSCAN) {
            const int head = 3 * (bx & 7) + (bx >> 5), rb = (bx >> 3) & 3, gk = lane >> 4, j = lane & 15, n0 = 16 * (wave & 3);
            constexpr int SP = 272, SBUF = 16 * SP;
            for (int i = tid; i < 2 * SBUF / 4; i += 512) *(LAS float*)(lds + i * 4) = 0.f;
            __syncthreads();
            int cur = 0;
            if (wave < 4) {
                const float* bsrc = PCT + ((size_t)head * 128 * 64 + n0 + j) * 64 + 16 * gk;
                const float* xsrc = SLOCT + ((size_t)head * 128 * 64 + n0 + j) * 64 + 16 * rb + 4 * gk;
                f32x4 bqs[3][4], xqs[3];
#define S2_LOAD(set, cc) do { const int cl_ = (cc) < 127 ? (cc) : 127; _Pragma("unroll") for (int q4 = 0; q4 < 4; ++q4) bqs[set][q4] = *(const GAS f32x4*)(bsrc + (size_t)cl_ * 4096 + 4 * q4); \
                    xqs[set] = *(const GAS f32x4*)(xsrc + (size_t)cl_ * 4096); } while (0)
#define S2_STEP(set, cc) do { f32x4 a4[4]; _Pragma("unroll") for (int q4 = 0; q4 < 4; ++q4) a4[q4] = *(LAS const f32x4*)(lds + cur * SBUF + j * SP + (16 * gk + 4 * q4) * 4); \
                    f32x4 acc[4]; _Pragma("unroll") for (int e = 0; e < 4; ++e) acc[e] = (f32x4){0.f, 0.f, 0.f, 0.f}; \
                    _Pragma("unroll") for (int q4 = 0; q4 < 4; ++q4) _Pragma("unroll") for (int e = 0; e < 4; ++e) acc[e] = __builtin_amdgcn_mfma_f32_16x16x4f32(a4[q4][e], bqs[set][q4][e], acc[e], 0, 0, 0); \
                    const f32x4 sum = (acc[0] + acc[1]) + (acc[2] + acc[3]) + xqs[set]; \
                    _Pragma("unroll") for (int r = 0; r < 4; ++r) *(LAS float*)(lds + (cur ^ 1) * SBUF + (4 * gk + r) * SP + (n0 + j) * 4) = sum[r]; \
                    S2_LOAD(set, (cc) + 3); __syncthreads(); cur ^= 1; } while (0)
                S2_LOAD(0, 0); S2_LOAD(1, 1); S2_LOAD(2, 2);
                for (int c = 0; c < 126; c += 3) { S2_STEP(0, c); S2_STEP(1, c + 1); S2_STEP(2, c + 2); } S2_STEP(0, 126); S2_STEP(1, 127);
#undef S2_LOAD
#undef S2_STEP
            } else {
                const int srow = 4 * (wave - 4) + (lane >> 4), sk = 4 * (lane & 15);
                float* dst = S0ALL + ((size_t)head * 128 * 64 + 16 * rb + srow) * 64 + sk;
                for (int c = 0; c < 128; ++c) { const f32x4 sv = *(LAS const f32x4*)(lds + cur * SBUF + srow * SP + sk * 4); *(GAS f32x4*)(dst + (size_t)c * 4096) = sv; __syncthreads(); cur ^= 1; }
            }
        }
        {
            const int GA = G - NSCAN, ca = bx - NSCAN;
            float thr;
            {
                const float* gq = args.in[I_SBQG]; const float* gk = args.in[I_SBKG];
                float mq = fmaxf(fabsf(gq[lane]), fabsf(gq[lane + 64])), mk = fmaxf(fabsf(gk[lane]), fabsf(gk[lane + 64]));
#pragma unroll
                for (int o = 1; o < 64; o <<= 1) { mq = fmaxf(mq, __shfl_xor(mq, o)); mk = fmaxf(mk, __shfl_xor(mk, o)); }
                thr = (11.3137085f * 1.02f * mq * mk + 104.0f) * 1.4426950408889634f;
            }
            constexpr int KPITCH = 272, VPITCH = 136, KBUF = 64 * KPITCH, VBUF = 128 * VPITCH, VOFF = 2 * KBUF, FLAGOFF = VOFF + 2 * VBUF, UQOFF = FLAGOFF + 64;
            const int hh = lane >> 5, l31 = lane & 31;
            __syncthreads();
            for (;;) {
                if (tid == 0) *(LAS int*)(lds + UQOFF) = (int)__hip_atomic_fetch_add((unsigned*)(ctl + CW_Q2), 1u, __ATOMIC_RELAXED, __HIP_MEMORY_SCOPE_AGENT);
                __syncthreads();
                const int uidx = *(LAS const int*)(lds + UQOFF);
                if (uidx >= 12 * 32) break;
                const int head = uidx % 12, qb = 31 - uidx / 12;
                const int q0 = qb * 256 + wave * 32, qi = q0 + l31;
                bf16x8 qf[8];
                { const bf16* qp = QN + (size_t)qi * 1536 + head * 128 + 8 * hh;
#pragma unroll
                  for (int s = 0; s < 8; ++s) qf[s] = *(const GAS bf16x8*)(qp + 16 * s); }
                f32x16 o[4];
#pragma unroll
                for (int c = 0; c < 4; ++c)
#pragma unroll
                    for (int r = 0; r < 16; ++r) o[c][r] = 0.f;
                float carry = 0.f; bool mydone = false;
                const int kkey = tid >> 3, kc = (tid & 7) * 2, vhd = tid >> 2, vp = tid & 3;
                const unsigned kofs = (unsigned)(kkey * 1536 + kc * 8) * 2u, vofs = (unsigned)(vhd * T + vp * 16) * 2u;
                const char* kgb = (const char*)KN + (size_t)head * 256; const char* vgb = (const char*)VT + (size_t)head * 128 * T * 2;
                v4u kr0, kr1, vr0, vr1;
#define SB_LOAD(kt_) do { const char* kb_ = kgb + (size_t)(kt_) * 64 * 1536 * 2; const char* vb_ = vgb + (size_t)(kt_) * 128; \
                          kr0 = *(const GAS v4u*)(kb_ + kofs); kr1 = *(const GAS v4u*)(kb_ + kofs + 16); vr0 = *(const GAS v4u*)(vb_ + vofs); vr1 = *(const GAS v4u*)(vb_ + vofs + 16); } while (0)
#define SB_STORE(buf_) do { LAS unsigned char* kd = lds + (buf_) * KBUF + kkey * KPITCH + kc * 16; *(LAS v4u*)kd = kr0; *(LAS v4u*)(kd + 16) = kr1; \
                          LAS unsigned char* vd = lds + VOFF + (buf_) * VBUF + vhd * VPITCH + vp * 32; *(LAS v2u*)vd = (v2u){vr0.x, vr0.y}; *(LAS v2u*)(vd + 8) = (v2u){vr0.z, vr0.w}; \
                          *(LAS v2u*)(vd + 16) = (v2u){vr1.x, vr1.y}; *(LAS v2u*)(vd + 24) = (v2u){vr1.z, vr1.w}; } while (0)
                int kt = 4 * qb + 3, cur = 0, it = 0;
                SB_LOAD(kt); SB_STORE(0); __syncthreads();
                for (;;) {
                    const bool more = kt > 0;
                    if (more) SB_LOAD(kt - 1);
                    const int k0 = kt * 64;
                    if (!mydone && k0 < q0 + 31) {
                        LAS const unsigned char* Kb = lds + cur * KBUF; LAS const unsigned char* Vb = lds + VOFF + cur * VBUF;
                        bf16x8 wf[2][2];
#pragma unroll
                        for (int b = 1; b >= 0; --b) {
                            f32x16 z;
#pragma unroll
                            for (int r = 0; r < 16; ++r) z[r] = 0.f;
#pragma unroll
                            for (int s = 0; s < 8; ++s) { const bf16x8 kf = *(LAS const bf16x8*)(Kb + (32 * b + l31) * KPITCH + (16 * s + 8 * hh) * 2);
                                z = __builtin_amdgcn_mfma_f32_32x32x16_bf16(kf, qf[s], z, 0, 0, 0); }
                            float sp[16];
                            const int lim = qi - k0 - 32 * b - 4 * hh;
#pragma unroll
                            for (int r = 0; r < 16; ++r) { const float zz = z[r];
                                const float v = fmaxf(zz, 0.f) + __builtin_amdgcn_logf(1.0f + __builtin_amdgcn_exp2f(-fabsf(zz))); sp[r] = (((r & 3) + 8 * (r >> 2)) < lim) ? v : 0.f; }
                            float Gs[4], Gp[4], Tt[4];
#pragma unroll
                            for (int i = 0; i < 4; ++i) { Gs[i] = (sp[4 * i] + sp[4 * i + 1]) + (sp[4 * i + 2] + sp[4 * i + 3]); Gp[i] = __shfl_xor(Gs[i], 32); Tt[i] = Gs[i] + Gp[i]; }
                            float X[4]; X[3] = 0.f; X[2] = Tt[3]; X[1] = X[2] + Tt[2]; X[0] = X[1] + Tt[1];
                            unsigned wp[8];
#pragma unroll
                            for (int i = 0; i < 4; ++i) {
                                const float newer = carry + X[i] + (hh == 0 ? Gp[i] : 0.f);
                                const float t3 = newer + sp[4 * i + 3], t2 = t3 + sp[4 * i + 2], t1 = t2 + sp[4 * i + 1], t0 = t1 + sp[4 * i];
                                const float tl[4] = {t0, t1, t2, t3}; float w[4];
#pragma unroll
                                for (int j = 0; j < 4; ++j) { const float e = __builtin_amdgcn_exp2f(z[4 * i + j] - tl[j]); w[j] = ((j + 8 * i) < lim) ? e : 0.f; }
                                wp[2 * i] = pk2(w[0], w[1]); wp[2 * i + 1] = pk2(w[2], w[3]);
                            }
                            carry += X[0] + Tt[0];
                            wf[b][0] = __builtin_bit_cast(bf16x8, (v4u){wp[0], wp[1], wp[2], wp[3]}); wf[b][1] = __builtin_bit_cast(bf16x8, (v4u){wp[4], wp[5], wp[6], wp[7]});
                        }
#pragma unroll
                        for (int b = 0; b < 2; ++b)
#pragma unroll
                            for (int s = 0; s < 2; ++s)
#pragma unroll
                                for (int c = 0; c < 4; ++c) { LAS const unsigned char* vpz = Vb + (32 * c + l31) * VPITCH + (32 * b + 16 * s + 4 * hh) * 2;
                                    const v2u va = *(LAS const v2u*)vpz, vb2 = *(LAS const v2u*)(vpz + 16);
                                    const bf16x8 vf = __builtin_bit_cast(bf16x8, (v4u){va.x, va.y, vb2.x, vb2.y});
                                    o[c] = __builtin_amdgcn_mfma_f32_32x32x16_bf16(vf, wf[b][s], o[c], 0, 0, 0); }
                        mydone = __all(carry > thr);
                    }
                    if (more) SB_STORE(cur ^ 1);
                    if (lane == 0) *(LAS unsigned*)(lds + FLAGOFF + ((it & 1) * 8 + wave) * 4) = mydone ? 1u : 0u;
                    __syncthreads();
                    if (!more) break;
                    { const v4u f0 = *(LAS const v4u*)(lds + FLAGOFF + (it & 1) * 32), f1 = *(LAS const v4u*)(lds + FLAGOFF + (it & 1) * 32 + 16);
                      if ((f0.x & f0.y & f0.z & f0.w & f1.x & f1.y & f1.z & f1.w) != 0u) break; }
                    --kt; cur ^= 1; ++it;
                }
#undef SB_LOAD
#undef SB_STORE
                bf16* op = OCAT + (size_t)qi * 4096 + head * 128 + 4 * hh;
#pragma unroll
                for (int c = 0; c < 4; ++c)
#pragma unroll
                    for (int i = 0; i < 4; ++i) *(GAS v2u*)(op + 32 * c + 8 * i) = (v2u){pk2(o[c][4 * i], o[c][4 * i + 1]), pk2(o[c][4 * i + 2], o[c][4 * i + 3])};
                __syncthreads();
            }
            if (bx >= NSCAN) { int nt4 = 4; asm volatile("" : "+s"(nt4)); pg8::SchedHeads S; S.G = GA; S.c = ca; S.nunits = 128; S.nt = nt4; S.A0 = (const char*)PM; S.B0 = (const char*)MVT; S.sA = 256 * 1024 * 2; S.hA = 512; S.hB = 256 * 1024 * 2;
              pg8::EpiBf16 E{OCAT, 4096, 3072, 256};
              pg8::gemm_phase(lds, 1024, 1024, S, E); }
        }
        if (BOTH(4)) GRID_BAR();
    }

    if (IN(6)) {
        PHASE_IDS();
        {
            const float* lng = args.in[I_RWLNG]; const float* lnb = args.in[I_RWLNB];
            const int l31 = lane & 31, lh = lane >> 5, sub = wave >> 2, mt = (wave >> 1) & 1, nt = wave & 1;
            LAS float* xch = (LAS float*)lds;
            for (int it0 = 2 * bx; it0 < 24 * 128; it0 += 2 * G) {
                const int item = it0 + sub, head = item >> 7, chunk = item & 127;
                const int tq = 32 * nt + l31; const size_t trow = (size_t)(chunk * 64 + tq);
                const float* ap = S0ALL + ((size_t)item * 64 + 32 * mt + l31) * 64 + 8 * lh;
                const float* bp = PHIT + ((size_t)item * 64 + tq) * 64 + 8 * lh;
                f32x4 af[4][2], bfv[4][2];
#pragma unroll
                for (int ks = 0; ks < 4; ++ks) { af[ks][0] = *(const GAS f32x4*)(ap + 16 * ks); af[ks][1] = *(const GAS f32x4*)(ap + 16 * ks + 4); bfv[ks][0] = *(const GAS f32x4*)(bp + 16 * ks); bfv[ks][1] = *(const GAS f32x4*)(bp + 16 * ks + 4); }
                f32x4 yl[4], vv4[4]; v2u gg[4];
                { const int vc = head * 64 + 32 * mt + 4 * lh; const float* yp = Y + trow * 1536 + vc; const bf16* gp = GB + trow * 1536 + vc;
                  const bf16* pc = P + trow * NINP + PRW + 3072 + vc; const float* mxp = args.in[I_RWMIX] + 3072 + vc;
#pragma unroll
                  for (int i = 0; i < 4; ++i) { yl[i] = *(const GAS f32x4*)(yp + 8 * i); gg[i] = *(const GAS v2u*)(gp + 8 * i);
                      const v2u c2 = *(const GAS v2u*)(pc + 8 * i); v2u p2 = (v2u){0u, 0u}; if (trow > 0) p2 = *(const GAS v2u*)(pc - NINP + 8 * i); const f32x4 mx = *(const GAS f32x4*)(mxp + 8 * i);
                      const float cv4[4] = {bflo(c2.x), bfhi(c2.x), bflo(c2.y), bfhi(c2.y)}, pv4[4] = {bflo(p2.x), bfhi(p2.x), bflo(p2.y), bfhi(p2.y)};
#pragma unroll
                      for (int e = 0; e < 4; ++e) vv4[i][e] = cv4[e] + (pv4[e] - cv4[e]) * mx[e]; } }
                const float bon = BONUS[trow * 24 + head];
                f32x16 acc;
#pragma unroll
                for (int r = 0; r < 16; ++r) acc[r] = 0.f;
#pragma unroll
                for (int ks = 0; ks < 4; ++ks) {
                    const v4u au = (v4u){pk2(af[ks][0].x, af[ks][0].y), pk2(af[ks][0].z, af[ks][0].w), pk2(af[ks][1].x, af[ks][1].y), pk2(af[ks][1].z, af[ks][1].w)};
                    const v4u bu = (v4u){pk2(bfv[ks][0].x, bfv[ks][0].y), pk2(bfv[ks][0].z, bfv[ks][0].w), pk2(bfv[ks][1].x, bfv[ks][1].y), pk2(bfv[ks][1].z, bfv[ks][1].w)};
                    acc = __builtin_amdgcn_mfma_f32_32x32x16_bf16(__builtin_bit_cast(bf16x8, au), __builtin_bit_cast(bf16x8, bu), acc, 0, 0, 0); }
                float yv[16]; float s1 = 0.f, s2 = 0.f;
#pragma unroll
                for (int i = 0; i < 4; ++i)
#pragma unroll
                    for (int e = 0; e < 4; ++e) { const float y = acc[4 * i + e] + yl[i][e]; yv[4 * i + e] = y; s1 += y; s2 += y * y; }
                s1 += __shfl_xor(s1, 32); s2 += __shfl_xor(s2, 32);
                if (lh == 0) { xch[((sub * 2 + mt) * 64 + tq) * 2] = s1; xch[((sub * 2 + mt) * 64 + tq) * 2 + 1] = s2; }
                __syncthreads();
                { const float o1 = xch[((sub * 2 + (mt ^ 1)) * 64 + tq) * 2], o2 = xch[((sub * 2 + (mt ^ 1)) * 64 + tq) * 2 + 1]; s1 += o1; s2 += o2; }
                const float mu = s1 * (1.f / 64.f), var = fmaxf(s2 * (1.f / 64.f) - mu * mu, 0.f), rstd = 1.0f / sqrtf(var + GN_EPS);
                bf16* op = OCAT + trow * 4096 + 1536 + head * 64 + 32 * mt + 4 * lh;
#pragma unroll
                for (int i = 0; i < 4; ++i) { const int vb = head * 64 + 32 * mt + 8 * i + 4 * lh; const f32x4 gv = *(const GAS f32x4*)(lng + vb), bv = *(const GAS f32x4*)(lnb + vb);
                    const float g4[4] = {bflo(gg[i].x), bfhi(gg[i].x), bflo(gg[i].y), bfhi(gg[i].y)}; float o[4];
#pragma unroll
                    for (int e = 0; e < 4; ++e) o[e] = ((yv[4 * i + e] - mu) * rstd * gv[e] + bv[e] + bon * vv4[i][e]) * g4[e];
                    *(GAS v2u*)(op + 8 * i) = (v2u){pk2(o[0], o[1]), pk2(o[2], o[3])}; }
                __syncthreads();
            }
        }
        {
            LAS float* scr = (LAS float*)(lds + wave * 16384);
            for (int qi = gw; qi < Q2_ITEMS; qi += NGW) Q2_BODY;
        }
        if (BOTH(6)) GRID_BAR();
    }

    if (IN(7)) {
        PHASE_IDS();
        pg8::SchedMerge S; S.to.init(32, 16); S.G = G; S.c = bx; S.OC = (const char*)OCAT; S.WC = (const char*)WCAT_T;
        pg8::EpiMerge E{P, MERGED};
        pg8::gemm_phase(lds, 4096, 4096, S, E);
        if (BOTH(7)) GRID_BAR();
    }

    if (IN(8)) {
        PHASE_IDS();
        pg8::SchedPlain S; S.to.init(32, 16); S.G = G; S.c = bx; S.nt = 64; S.A0 = (const char*)MERGED; S.B0 = (const char*)WOUT_T; S.sA = (size_t)256 * 4096 * 2; S.sB = (size_t)256 * 4096 * 2;
        pg8::EpiResF32 E{args.in[I_X], H1};
        pg8::gemm_phase(lds, 4096, 4096, S, E);
        if (BOTH(8)) GRID_BAR();
    }

    if (IN(9)) {
        PHASE_IDS();
        rms_rows4096(H1, args.in[I_FFNG], XN, gw, NGW, T, lane);
        if (BOTH(9)) GRID_BAR();
    }

    if (IN(10)) {
        PHASE_IDS();
        pg8::SchedPlain S; S.to.init(32, 86); S.G = G; S.c = bx; S.nt = 64; S.A0 = (const char*)XN; S.B0 = (const char*)WGU_T; S.sA = (size_t)256 * 4096 * 2; S.sB = (size_t)256 * 4096 * 2;
        pg8::EpiSwiGLU E{ACT};
        pg8::gemm_phase(lds, 4096, 4096, S, E);
        if (BOTH(10)) GRID_BAR();
    }

    if (IN(11)) {
        PHASE_IDS();
        pg8::SchedPlain S; S.to.init(32, 16); S.G = G; S.c = bx; S.nt = 172; S.A0 = (const char*)ACT; S.B0 = (const char*)WD_T; S.sA = (size_t)256 * DFF * 2; S.sB = (size_t)256 * DFF * 2;
        pg8::EpiResF32 E{H1, args.out};
        pg8::gemm_phase(lds, DFF, DFF, S, E);
    }
#undef IN
#undef BOTH
}

extern "C" void kernel_launch(void* const* d_in, const int* in_sizes, int n_in, void* d_out, int out_size, void* d_ws, size_t ws_size, hipStream_t stream) {
    static int grid = 0;
    if (grid == 0) {
        if (n_in != 29 || in_sizes[0] != T * D || out_size != T * D || ws_size < WS_END) {
            fprintf(stderr, "kernel_launch: unexpected problem (n_in %d, in0 %d, out %d, ws %zu, need %zu); nothing launched\n", n_in, n_in > 0 ? in_sizes[0] : -1, out_size, ws_size, (size_t)WS_END); grid = -1; return; }
        int dev = 0, cus = 0, per_cu = 0;
        if (hipGetDevice(&dev) != hipSuccess || hipDeviceGetAttribute(&cus, hipDeviceAttributeMultiprocessorCount, dev) != hipSuccess) { grid = -1; return; }
        if (hipFuncSetAttribute((const void*)hybrid_fwd, hipFuncAttributeMaxDynamicSharedMemorySize, LDS_BYTES) != hipSuccess) { fprintf(stderr, "kernel_launch: hipFuncSetAttribute failed\n"); grid = -1; return; }
        if (hipOccupancyMaxActiveBlocksPerMultiprocessor(&per_cu, (const void*)hybrid_fwd, NWAVES * 64, LDS_BYTES) != hipSuccess || per_cu < 1)
            fprintf(stderr, "kernel_launch: note: occupancy query reports %d workgroups per CU\n", per_cu);
        (void)hipGetLastError();
        grid = cus;
    }
    if (grid < 0) return;
    if (hipMemsetAsync((char*)d_ws + WS_CTL, 0, CTL_ZERO_BYTES, stream) != hipSuccess) return;
    Args a{};
    for (int i = 0; i < 29; ++i) a.in[i] = (const float*)d_in[i];
    a.out = (float*)d_out; a.ws = (unsigned char*)d_ws;
#if MK_PER_PHASE
    for (int p = 0; p < NPHASES; ++p) { a.ph_lo = p; a.ph_hi = p + 1; hipLaunchKernelGGL(hybrid_fwd, dim3(grid), dim3(NWAVES * 64), LDS_BYTES, stream, a); }
#else
    a.ph_lo = 0; a.ph_hi = NPHASES;
    hipLaunchKernelGGL(hybrid_fwd, dim3(grid), dim3(NWAVES * 64), LDS_BYTES, stream, a);
#endif
}
```

```cpp
#include <hip/hip_runtime.h>
#include <cstdio>
#include <cstdint>

#ifndef MK_PER_PHASE
#define MK_PER_PHASE 0
#endif

constexpr int T = 8192, D = 4096, NMEM = 256;
constexpr int SBW = 1536, RWW = 1536, MEMW = 1024, RWSEG = 5344, DFF = 11008;
constexpr int NIN_ORIG = 23264, NINP = 23296;
constexpr int PQ = 0, PK = 1536, PV = 3072, PRW = 4608, PMQ = 9984, PG = 11008;
constexpr float RMS_EPS = 1e-6f, GN_EPS = 64e-5f;

constexpr size_t MiB = 1u << 20;
constexpr size_t WS_CTL = 0, CTL_ZERO_BYTES = 256 * 1024;
constexpr size_t WS_WIN_T = 1 * MiB;
constexpr size_t WS_WCAT_T = WS_WIN_T + 182 * MiB;
constexpr size_t WS_WOUT_T = WS_WCAT_T + 32 * MiB;
constexpr size_t WS_WKV_T = WS_WOUT_T + 32 * MiB;
constexpr size_t WS_LBWA = WS_WKV_T + 16 * MiB;
constexpr size_t WS_LBG = WS_LBWA + 2 * MiB;
constexpr size_t WS_XN = WS_LBG + 2 * MiB;
constexpr size_t WS_MEMN = WS_XN + 64 * MiB;
constexpr size_t WS_P = WS_MEMN + 2 * MiB;
constexpr size_t WS_R = WS_P + 364 * MiB;
constexpr size_t RSZ = 48 * MiB;
constexpr size_t WS_G = WS_R + 6 * RSZ;
constexpr size_t WS_Y = WS_G + 24 * MiB;
constexpr size_t WS_OCAT = WS_Y + 48 * MiB;
constexpr size_t WS_LATE = WS_OCAT + 64 * MiB;
constexpr size_t WS_QN = WS_LATE;
constexpr size_t WS_KN = WS_QN + 24 * MiB;
constexpr size_t WS_VT = WS_KN + 24 * MiB;
constexpr size_t WS_MQN = WS_VT + 24 * MiB;
constexpr size_t WS_MKRAW = WS_MQN + 16 * MiB;
constexpr size_t WS_MKN = WS_MKRAW + 1 * MiB;
constexpr size_t WS_MVT = WS_MKN + 1 * MiB;
constexpr size_t WS_SM = WS_MVT + 2 * MiB;
constexpr size_t WS_PM = WS_SM + 32 * MiB;
constexpr size_t WS_LA1 = WS_PM + 16 * MiB;
constexpr size_t WS_LA2 = WS_LA1 + 4 * MiB;
constexpr size_t WS_EARLY_END = WS_LA2 + 8 * MiB;
constexpr size_t WS_PHIT = WS_EARLY_END;
constexpr size_t WS_PCT = WS_PHIT + 48 * MiB;
constexpr size_t WS_SLOCT = WS_PCT + 48 * MiB;
constexpr size_t WS_BONUS = WS_SLOCT + 48 * MiB;
constexpr size_t WS_RWKV_END = WS_BONUS + 1 * MiB;
constexpr size_t WS_WGU_T = WS_WIN_T;
constexpr size_t WS_WD_T = WS_R + 2 * RSZ;
constexpr size_t WS_END = WS_RWKV_END;
constexpr size_t WS_MERGED = WS_R;
constexpr size_t WS_H1 = WS_LATE;
constexpr size_t WS_ACT = WS_P;
static_assert(WS_H1 + 128 * MiB <= WS_EARLY_END && WS_WD_T + 86 * MiB <= WS_R + 4 * RSZ, "H1 / W_down copy homes");
static_assert(WS_END <= 1454ull * MiB, "workspace map exceeds the guaranteed 4x largest tensor");

constexpr int CW_TMO = 0, CW_CODE = 1, CW_BAR = 4096, CW_Q1 = 32768, CW_Q2 = 32768 + 64;

constexpr int RING_BYTES = 131072, LDSCTL_OFF = 159744, MISC_OFF = LDSCTL_OFF + 320, LDS_BYTES = 163840;
constexpr int NWAVES = 8;

#define GAS __attribute__((address_space(1)))
#define LAS __attribute__((address_space(3)))
typedef unsigned short bf16;
typedef unsigned v4u __attribute__((ext_vector_type(4)));
typedef unsigned v2u __attribute__((ext_vector_type(2)));
typedef float f32x4 __attribute__((ext_vector_type(4)));
typedef float f32x2 __attribute__((ext_vector_type(2)));
typedef float f32x16 __attribute__((ext_vector_type(16)));
typedef short bf16x8 __attribute__((ext_vector_type(8)));
typedef short s16x4 __attribute__((ext_vector_type(4)));
typedef GAS unsigned gu32;

__device__ __forceinline__ unsigned f2bf(float f) { unsigned u = __builtin_bit_cast(unsigned, f); return (u + 0x7fffu + ((u >> 16) & 1u)) >> 16; }
__device__ __forceinline__ unsigned pk2(float lo, float hi) { return f2bf(lo) | (f2bf(hi) << 16); }
__device__ __forceinline__ float bflo(unsigned w) { return __builtin_bit_cast(float, w << 16); }
__device__ __forceinline__ float bfhi(unsigned w) { return __builtin_bit_cast(float, w & 0xffff0000u); }
__device__ __forceinline__ float fexp(float x) { return __builtin_amdgcn_exp2f(x * 1.44269504088896f); }
__device__ __forceinline__ float flog(float x) { return __builtin_amdgcn_logf(x) * 0.693147180559945f; }
__device__ __forceinline__ float frcp(float x) { return __builtin_amdgcn_rcpf(x); }
__device__ __forceinline__ float sigmoidf_(float x) { return frcp(1.0f + fexp(-x)); }
__device__ __forceinline__ float softplusf_(float x) { return fmaxf(x, 0.f) + flog(1.0f + fexp(-fabsf(x))); }
__device__ __forceinline__ float wave_sum(float v) {
#pragma unroll
    for (int o = 1; o < 64; o <<= 1) v += __shfl_xor(v, o);
    return v;
}
__device__ __forceinline__ float dpp_f(float x, const int ctrl_sel) {
    return x;
}
#define DPP_ADD(x, ctrl) ((x) + __builtin_bit_cast(float, __builtin_amdgcn_update_dpp(0, __builtin_bit_cast(int, (x)), (ctrl), 0xF, 0xF, true)))
#define DPP_MAX(x, ctrl) fmaxf((x), __builtin_bit_cast(float, __builtin_amdgcn_update_dpp(0, __builtin_bit_cast(int, (x)), (ctrl), 0xF, 0xF, true)))
__device__ __forceinline__ float quad_bcast(float x, int g) {
    const int xi = __builtin_bit_cast(int, x);
    switch (g) {
        case 0: return __builtin_bit_cast(float, __builtin_amdgcn_update_dpp(0, xi, 0x00, 0xF, 0xF, true));
        case 1: return __builtin_bit_cast(float, __builtin_amdgcn_update_dpp(0, xi, 0x55, 0xF, 0xF, true));
        case 2: return __builtin_bit_cast(float, __builtin_amdgcn_update_dpp(0, xi, 0xAA, 0xF, 0xF, true));
        default: return __builtin_bit_cast(float, __builtin_amdgcn_update_dpp(0, xi, 0xFF, 0xF, 0xF, true));
    }
}
__device__ __forceinline__ float red16_sum(float x) {
    x = DPP_ADD(x, 0xB1); x = DPP_ADD(x, 0x4E); x = DPP_ADD(x, 0x141); x = DPP_ADD(x, 0x140); return x;
}
__device__ __forceinline__ float red16_max(float x) {
    x = DPP_MAX(x, 0xB1); x = DPP_MAX(x, 0x4E); x = DPP_MAX(x, 0x141); x = DPP_MAX(x, 0x140); return x;
}

namespace pg8 {
#define PG8_LAS __attribute__((address_space(3)))
typedef unsigned short bf16_t;
typedef unsigned u32x4 __attribute__((ext_vector_type(4)));
constexpr int BM = 256, BK = 64, HALF = 128, HTB = HALF * BK * 2, STAGE_BYTES = 8 * HTB, NXCD = 8, WGM = 4;

__host__ __device__ __forceinline__ int lds_byte(int r, int c) { const int st = (r >> 4) * 2 + (c >> 5), rr = r & 15, cc = c & 31, ob = rr * 64 + cc * 2; return st * 1024 + (ob ^ (((ob >> 9) & 1) << 5)); }
__host__ __device__ __forceinline__ void stage_rc(int b, int& R, int& C) { const int st = b / 1024, sb = b % 1024, swz = sb ^ (((sb >> 9) & 1) << 5); R = (st >> 1) * 16 + swz / 64; C = (st & 1) * 32 + (swz % 64) / 2; }
__host__ __device__ __forceinline__ int perm32(int rho) { const int n = rho >> 4, i = rho & 15; return 8 * (i >> 2) + 4 * n + (i & 3); }

struct Unit { const char* A; const char* B; int nt, pm, pn, kind; };

struct TileOrder {
    int nM, nN, nwg;
    __device__ __forceinline__ void init(int nM_, int nN_) { nM = nM_; nN = nN_; nwg = nM_ * nN_; }
    __device__ __forceinline__ void map(int L, int& pm, int& pn) const {
        int wgid = L; { const int q = nwg / NXCD, r = nwg % NXCD, xcd = wgid % NXCD, off = wgid / NXCD; wgid = (xcd < r ? xcd * (q + 1) : r * (q + 1) + (xcd - r) * q) + off; }
        const int nig = WGM * nN, gid = wgid / nig, fm = gid * WGM, gsz = (nM - fm) < WGM ? (nM - fm) : WGM;
        pm = fm + ((wgid % nig) % gsz); pn = (wgid % nig) / gsz;
    }
};

__device__ __forceinline__ unsigned cvt_pk_bf16(float lo, float hi) { unsigned r; asm volatile("v_cvt_pk_bf16_f32 %0, %1, %2" : "=v"(r) : "v"(lo), "v"(hi)); return r; }

template <class Epi, class Sched>
__device__ __forceinline__ void gemm_phase(PG8_LAS unsigned char* lds, const int lda, const int ldb, const Sched& S, const Epi& E) {
    const int tid = threadIdx.x, wid = __builtin_amdgcn_readfirstlane(tid >> 6), lane = tid & 63, wr = wid >> 2, wc = wid & 3, fr = lane & 15, fq = lane >> 4;
    unsigned voffA[2], voffB[2];
#pragma unroll
    for (int i = 0; i < 2; ++i) { int R, C; stage_rc(tid * 16 + i * 8192, R, C); const int Rb = Epi::PERM ? ((R & ~31) + perm32(R & 31)) : R;
        voffA[i] = (unsigned)(R * lda + C) * 2u; voffB[i] = (unsigned)(Rb * ldb + C) * 2u; }
    const size_t kstep = (size_t)(BK * 2);
    const size_t hstepA = (size_t)HALF * lda * 2, hstepB = (size_t)HALF * ldb * 2;
    const unsigned ldsw = (unsigned)wid * 1024u;
    const int aoff = lds_byte(wr * 64 + fr, fq * 8), boff = lds_byte(wc * 32 + fr, fq * 8);
#define PG8_SA(b, h) (((b) * 2 + (h)) * HTB)
#define PG8_SB(b, h) ((4 + (b) * 2 + (h)) * HTB)
#define PG8_STAGE(bufoff, gbase, voff) do { _Pragma("unroll") for (int _i = 0; _i < 2; ++_i) \
        __builtin_amdgcn_global_load_lds((const unsigned*)((const char*)(gbase) + (voff)[_i]), (PG8_LAS unsigned*)(lds + (bufoff) + ldsw + _i * 8192), 16, 0, 0); } while (0)
#define PG8_LDA(dst, b, h) do { _Pragma("unroll") for (int m = 0; m < 4; ++m) _Pragma("unroll") for (int k = 0; k < 2; ++k) dst[m][k] = *(const PG8_LAS bf16x8*)(lds + PG8_SA(b, h) + aoff + m * 2048 + k * 1024); } while (0)
#define PG8_LDB(dst, b, h) do { _Pragma("unroll") for (int n = 0; n < 2; ++n) _Pragma("unroll") for (int k = 0; k < 2; ++k) dst[n][k] = *(const PG8_LAS bf16x8*)(lds + PG8_SB(b, h) + boff + n * 2048 + k * 1024); } while (0)
#define PG8_MMA(ai, bj, At, Bt) do { __builtin_amdgcn_s_setprio(1); _Pragma("unroll") for (int m = 0; m < 4; ++m) _Pragma("unroll") for (int n = 0; n < 2; ++n) _Pragma("unroll") for (int k = 0; k < 2; ++k) \
        acc[ai][bj][m][n] = __builtin_amdgcn_mfma_f32_16x16x32_bf16(Bt[n][k], At[m][k], acc[ai][bj][m][n], 0, 0, 0); __builtin_amdgcn_s_setprio(0); } while (0)
#define PG8_WAIT_V(n) asm volatile("s_waitcnt vmcnt(" #n ")" ::: "memory")
#define PG8_WAIT_L(n) asm volatile("s_waitcnt lgkmcnt(" #n ")" ::: "memory")
#define PG8_BAR __builtin_amdgcn_s_barrier()
#define PG8_SCHED __builtin_amdgcn_sched_barrier(0)
    Unit cur, nxt; int ui = 0;
    if (!S.next(0, cur)) return;
    f32x4 acc[2][2][4][2];
#pragma unroll
    for (int a = 0; a < 2; ++a)
#pragma unroll
        for (int b = 0; b < 2; ++b)
#pragma unroll
            for (int m = 0; m < 4; ++m)
#pragma unroll
                for (int n = 0; n < 2; ++n) acc[a][b][m][n] = (f32x4){0.f, 0.f, 0.f, 0.f};
    bf16x8 At[4][2], B0[2][2], B1[2][2];
    const char* cA = cur.A; const char* cB = cur.B; int nt = cur.nt;
    PG8_STAGE(PG8_SB(0, 0), cB, voffB); PG8_STAGE(PG8_SB(0, 1), cB + hstepB, voffB); PG8_STAGE(PG8_SA(0, 0), cA, voffA); PG8_STAGE(PG8_SA(0, 1), cA + hstepA, voffA);
    if (wr == 1) PG8_BAR;
    PG8_WAIT_V(2); PG8_BAR;
    PG8_STAGE(PG8_SB(1, 0), cB + kstep, voffB); PG8_STAGE(PG8_SA(1, 0), cA + kstep, voffA); PG8_STAGE(PG8_SB(1, 1), cB + hstepB + kstep, voffB);
    PG8_WAIT_V(6); PG8_BAR;
    for (;;) {
        const bool has_next = S.next(ui + 1, nxt);
        const char* nA = has_next ? nxt.A : cA; const char* nB = has_next ? nxt.B : cB;
        for (int t = 0; t < nt; t += 2) {
            const bool last = (t == nt - 2);
            const char* a1 = cA + (size_t)(t + 1) * kstep;
            const char* a2 = last ? nA : cA + (size_t)(t + 2) * kstep; const char* b2 = last ? nB : cB + (size_t)(t + 2) * kstep;
            const char* a3 = a2 + kstep; const char* b3 = b2 + kstep;
            PG8_LDB(B0, 0, 0); PG8_LDB(B1, 0, 1); PG8_SCHED; PG8_LDA(At, 0, 0); PG8_STAGE(PG8_SA(1, 1), a1 + hstepA, voffA);
            PG8_WAIT_V(8); PG8_WAIT_L(0); PG8_BAR; PG8_MMA(0, 0, At, B0); PG8_MMA(0, 1, At, B1); PG8_BAR; PG8_SCHED;
            PG8_LDA(At, 0, 1); PG8_STAGE(PG8_SB(0, 0), b2, voffB); PG8_STAGE(PG8_SB(0, 1), b2 + hstepB, voffB); PG8_STAGE(PG8_SA(0, 0), a2, voffA);
            PG8_WAIT_V(8); PG8_WAIT_L(0); PG8_BAR; PG8_MMA(1, 0, At, B0); PG8_MMA(1, 1, At, B1); PG8_BAR; PG8_SCHED;
            PG8_LDB(B0, 1, 0); PG8_LDB(B1, 1, 1); PG8_SCHED; PG8_LDA(At, 1, 0); PG8_STAGE(PG8_SA(0, 1), a2 + hstepA, voffA);
            PG8_WAIT_V(8); PG8_WAIT_L(0); PG8_BAR; PG8_MMA(0, 0, At, B0); PG8_MMA(0, 1, At, B1); PG8_BAR; PG8_SCHED;
            PG8_LDA(At, 1, 1); PG8_STAGE(PG8_SB(1, 0), b3, voffB); PG8_STAGE(PG8_SB(1, 1), b3 + hstepB, voffB); PG8_STAGE(PG8_SA(1, 0), a3, voffA);
            PG8_WAIT_V(8); PG8_WAIT_L(0); PG8_BAR; PG8_MMA(1, 0, At, B0); PG8_MMA(1, 1, At, B1); PG8_BAR; PG8_SCHED;
        }
        if (wr == 0) PG8_BAR;
        const bool keep = E(acc, cur, wr, wc, fr, fq);
        if (!has_next) break;
        if (!keep) {
#pragma unroll
            for (int a = 0; a < 2; ++a)
#pragma unroll
                for (int b = 0; b < 2; ++b)
#pragma unroll
                    for (int m = 0; m < 4; ++m)
#pragma unroll
                        for (int n = 0; n < 2; ++n) acc[a][b][m][n] = (f32x4){0.f, 0.f, 0.f, 0.f};
        }
        cur = nxt; cA = nA; cB = nB; nt = cur.nt; ++ui;
        if (wr == 1) PG8_BAR;
    }
    PG8_WAIT_V(0);
    PG8_BAR;
#undef PG8_SA
#undef PG8_SB
#undef PG8_STAGE
#undef PG8_LDA
#undef PG8_LDB
#undef PG8_MMA
#undef PG8_WAIT_V
#undef PG8_WAIT_L
#undef PG8_BAR
#undef PG8_SCHED
}

struct SchedPlain {
    TileOrder to; int G, c, nt; const char* A0; const char* B0; size_t sA, sB;
    __device__ __forceinline__ bool next(int i, Unit& u) const {
        const int L = i * G + c; if (L >= to.nwg) return false;
        int pm, pn; to.map(L, pm, pn); u.A = A0 + (size_t)pm * sA; u.B = B0 + (size_t)pn * sB; u.nt = nt; u.pm = pm; u.pn = pn; u.kind = 0; return true;
    }
};
struct SchedGemm1 {
    TileOrder to; int G, c; const char *XN, *WIN, *MEMN, *WKV;
    __device__ __forceinline__ bool next(int i, Unit& u) const {
        const int L = i * G + c; u.nt = 64;
        if (L < to.nwg) { int pm, pn; to.map(L, pm, pn); u.A = XN + (size_t)pm * 256 * 4096 * 2; u.B = WIN + (size_t)pn * 256 * 4096 * 2; u.pm = pm; u.pn = pn; u.kind = 0; return true; }
        const int e = L - to.nwg; if (e >= 8) return false;
        if (e < 4) { u.A = MEMN; u.B = WKV + (size_t)e * 256 * 4096 * 2; u.pm = 0; u.pn = e; u.kind = 1; }
        else { u.A = WKV + (size_t)(1024 + 256 * (e - 4)) * 4096 * 2; u.B = MEMN; u.pm = e - 4; u.pn = 0; u.kind = 2; }
        return true;
    }
};
struct SchedHeads {
    int G, c, nunits, nt; const char* A0; const char* B0; size_t sA, hA, hB;
    __device__ __forceinline__ bool next(int i, Unit& u) const {
        const int L = i * G + c; if (L >= nunits) return false;
        const int pm = L & 31, h = L >> 5; u.A = A0 + (size_t)pm * sA + (size_t)h * hA; u.B = B0 + (size_t)h * hB; u.nt = nt; u.pm = pm; u.pn = 0; u.kind = h; return true;
    }
};
struct SchedMerge {
    TileOrder to; int G, c; const char* OC; const char* WC;
    __device__ __forceinline__ bool next(int i, Unit& u) const {
        const int ti = i / 3, b = i - 3 * ti; const int L = ti * G + c; if (L >= to.nwg) return false;
        int pm, pn; to.map(L, pm, pn); const int koff = b * 1536;
        u.A = OC + ((size_t)pm * 256 * 4096 + koff) * 2; u.B = WC + ((size_t)pn * 256 * 4096 + koff) * 2; u.nt = (b < 2) ? 24 : 16; u.pm = pm; u.pn = pn; u.kind = b; return true;
    }
};

struct EpiGemm1 {
    static constexpr bool PERM = true;
    bf16_t *P, *MK, *MVT;
    __device__ __forceinline__ bool operator()(f32x4 (&acc)[2][2][4][2], const Unit& u, int wr, int wc, int fr, int fq) const {
        bf16_t* base; int ldc;
        if (u.kind == 0) { base = P + (size_t)u.pm * 256 * NINP + u.pn * 256; ldc = NINP; }
        else if (u.kind == 1) { base = MK + u.pn * 256; ldc = 1024; }
        else { base = MVT + (size_t)u.pm * 256 * 1024; ldc = 1024; }
        base += (size_t)(wr * 64 + fr) * ldc + wc * 32 + 8 * fq;
#pragma unroll
        for (int ai = 0; ai < 2; ++ai)
#pragma unroll
            for (int m = 0; m < 4; ++m) { bf16_t* rowp = base + (size_t)(ai * HALF + m * 16) * ldc;
#pragma unroll
                for (int bj = 0; bj < 2; ++bj) { const f32x4 v0 = acc[ai][bj][m][0], v1 = acc[ai][bj][m][1];
                    u32x4 w; w.x = cvt_pk_bf16(v0[0], v0[1]); w.y = cvt_pk_bf16(v0[2], v0[3]); w.z = cvt_pk_bf16(v1[0], v1[1]); w.w = cvt_pk_bf16(v1[2], v1[3]);
                    *(u32x4*)(rowp + bj * HALF) = w; } }
        return false;
    }
};
struct EpiBf16 {
    static constexpr bool PERM = true;
    bf16_t* O; int ldc, coff, kstride;
    __device__ __forceinline__ bool operator()(f32x4 (&acc)[2][2][4][2], const Unit& u, int wr, int wc, int fr, int fq) const {
        bf16_t* base = O + (size_t)(u.pm * 256 + wr * 64 + fr) * ldc + coff + u.kind * kstride + u.pn * 256 + wc * 32 + 8 * fq;
#pragma unroll
        for (int ai = 0; ai < 2; ++ai)
#pragma unroll
            for (int m = 0; m < 4; ++m) { bf16_t* rowp = base + (size_t)(ai * HALF + m * 16) * ldc;
#pragma unroll
                for (int bj = 0; bj < 2; ++bj) { const f32x4 v0 = acc[ai][bj][m][0], v1 = acc[ai][bj][m][1];
                    u32x4 w; w.x = cvt_pk_bf16(v0[0], v0[1]); w.y = cvt_pk_bf16(v0[2], v0[3]); w.z = cvt_pk_bf16(v1[0], v1[1]); w.w = cvt_pk_bf16(v1[2], v1[3]);
                    *(u32x4*)(rowp + bj * HALF) = w; } }
        return false;
    }
};
struct EpiScoreF32 {
    static constexpr bool PERM = false;
    float* S;
    __device__ __forceinline__ bool operator()(f32x4 (&acc)[2][2][4][2], const Unit& u, int wr, int wc, int fr, int fq) const {
        float* base = S + (size_t)(u.pm * 256 + wr * 64 + fr) * 1024 + u.kind * 256 + wc * 32 + 4 * fq;
#pragma unroll
        for (int ai = 0; ai < 2; ++ai)
#pragma unroll
            for (int m = 0; m < 4; ++m) { float* rowp = base + (size_t)(ai * HALF + m * 16) * 1024;
#pragma unroll
                for (int bj = 0; bj < 2; ++bj)
#pragma unroll
                    for (int n = 0; n < 2; ++n) *(f32x4*)(rowp + bj * HALF + n * 16) = acc[ai][bj][m][n]; }
        return false;
    }
};
struct EpiLoraWA {
    static constexpr bool PERM = false;
    const float *w0, *a0; float *RW, *RA;
    __device__ __forceinline__ bool operator()(f32x4 (&acc)[2][2][4][2], const Unit& u, int wr, int wc, int fr, int fq) const {
        const bool isw = u.pn < 6; const int cb = (isw ? u.pn : u.pn - 6) * 256 + wc * 32 + 4 * fq;
        const float* bias = (isw ? w0 : a0) + cb; float* base = (isw ? RW : RA) + (size_t)(u.pm * 256 + wr * 64 + fr) * 1536 + cb;
        f32x4 bv[2][2];
#pragma unroll
        for (int bj = 0; bj < 2; ++bj)
#pragma unroll
            for (int n = 0; n < 2; ++n) bv[bj][n] = *(const f32x4*)(bias + bj * HALF + n * 16);
#pragma unroll
        for (int ai = 0; ai < 2; ++ai)
#pragma unroll
            for (int m = 0; m < 4; ++m) { float* rowp = base + (size_t)(ai * HALF + m * 16) * 1536;
#pragma unroll
                for (int bj = 0; bj < 2; ++bj)
#pragma unroll
                    for (int n = 0; n < 2; ++n) { f32x4 x = acc[ai][bj][m][n] + bv[bj][n]; f32x4 o;
#pragma unroll
                        for (int j = 0; j < 4; ++j) { const float sg = sigmoidf_(x[j]); o[j] = isw ? fexp(-0.6065306597126334f * sg) : sg; }
                        *(f32x4*)(rowp + bj * HALF + n * 16) = o; } }
        return false;
    }
};
struct EpiMerge {
    static constexpr bool PERM = true;
    const bf16_t* P; bf16_t* MG;
    __device__ __forceinline__ bool operator()(f32x4 (&acc)[2][2][4][2], const Unit& u, int wr, int wc, int fr, int fq) const {
        const int b = u.kind; const int row0 = u.pm * 256 + wr * 64 + fr, col0 = u.pn * 256 + wc * 32 + 8 * fq;
        const bf16_t* gbase = P + (size_t)row0 * NINP + PG + 4096 * b + col0;
#pragma unroll
        for (int ai = 0; ai < 2; ++ai) {
            u32x4 g0v[4][2], g1v[4][2];
#pragma unroll
            for (int m = 0; m < 4; ++m)
#pragma unroll
                for (int bj = 0; bj < 2; ++bj) { const bf16_t* gp = gbase + (size_t)(ai * HALF + m * 16) * NINP + bj * HALF; g0v[m][bj] = *(const u32x4*)gp; g1v[m][bj] = (b < 2) ? *(const u32x4*)(gp + 4096) : g0v[m][bj]; }
#pragma unroll
            for (int m = 0; m < 4; ++m) { const size_t row = (size_t)(row0 + ai * HALF + m * 16);
#pragma unroll
                for (int bj = 0; bj < 2; ++bj) { const u32x4 g0 = g0v[m][bj];
                    float e0[8]; const unsigned gw0[4] = {g0.x, g0.y, g0.z, g0.w};
#pragma unroll
                    for (int j = 0; j < 4; ++j) { e0[2 * j] = 1.0f + fexp(-bflo(gw0[j])); e0[2 * j + 1] = 1.0f + fexp(-bfhi(gw0[j])); }
                    if (b < 2) { const u32x4 g1 = g1v[m][bj]; const unsigned gw1[4] = {g1.x, g1.y, g1.z, g1.w};
#pragma unroll
                        for (int j = 0; j < 4; ++j) { const float r0 = (1.0f + fexp(-bflo(gw1[j]))) * frcp(e0[2 * j]), r1 = (1.0f + fexp(-bfhi(gw1[j]))) * frcp(e0[2 * j + 1]);
                            acc[ai][bj][m][j >> 1][(2 * j) & 3] *= r0; acc[ai][bj][m][j >> 1][(2 * j + 1) & 3] *= r1; }
                    } else { float v[8];
#pragma unroll
                        for (int j = 0; j < 8; ++j) v[j] = acc[ai][bj][m][j >> 2][j & 3] * frcp(e0[j]);
                        u32x4 w; w.x = cvt_pk_bf16(v[0], v[1]); w.y = cvt_pk_bf16(v[2], v[3]); w.z = cvt_pk_bf16(v[4], v[5]); w.w = cvt_pk_bf16(v[6], v[7]);
                        *(u32x4*)(MG + row * 4096 + col0 + bj * HALF) = w; } } }
            asm volatile("" ::: "memory");
        }
        return b < 2;
    }
};
struct EpiResF32 {
    static constexpr bool PERM = false;
    const float* res; float* out;
    __device__ __forceinline__ bool operator()(f32x4 (&acc)[2][2][4][2], const Unit& u, int wr, int wc, int fr, int fq) const {
        const size_t off0 = (size_t)(u.pm * 256 + wr * 64 + fr) * 4096 + u.pn * 256 + wc * 32 + 4 * fq;
#pragma unroll
        for (int ai = 0; ai < 2; ++ai)
#pragma unroll
            for (int mp = 0; mp < 2; ++mp) { f32x4 rv[2][2][2];
#pragma unroll
                for (int mm = 0; mm < 2; ++mm)
#pragma unroll
                    for (int bj = 0; bj < 2; ++bj)
#pragma unroll
                        for (int n = 0; n < 2; ++n) rv[mm][bj][n] = *(const f32x4*)(res + off0 + (size_t)(ai * HALF + (2 * mp + mm) * 16) * 4096 + bj * HALF + n * 16);
#pragma unroll
                for (int mm = 0; mm < 2; ++mm) { const size_t off = off0 + (size_t)(ai * HALF + (2 * mp + mm) * 16) * 4096;
#pragma unroll
                    for (int bj = 0; bj < 2; ++bj)
#pragma unroll
                        for (int n = 0; n < 2; ++n) *(f32x4*)(out + off + bj * HALF + n * 16) = rv[mm][bj][n] + acc[ai][bj][2 * mp + mm][n]; }
                asm volatile("" ::: "memory"); }
        return false;
    }
};
struct EpiSwiGLU {
    static constexpr bool PERM = true;
    bf16_t* ACT;
    __device__ __forceinline__ bool operator()(f32x4 (&acc)[2][2][4][2], const Unit& u, int wr, int wc, int fr, int fq) const {
        bf16_t* base = ACT + (size_t)(u.pm * 256 + wr * 64 + fr) * DFF + u.pn * 128 + wc * 32 + 8 * fq;
#pragma unroll
        for (int ai = 0; ai < 2; ++ai)
#pragma unroll
            for (int m = 0; m < 4; ++m) { float v[8];
#pragma unroll
                for (int j = 0; j < 8; ++j) { const float g = acc[ai][0][m][j >> 2][j & 3], up = acc[ai][1][m][j >> 2][j & 3]; v[j] = g * sigmoidf_(g) * up; }
                u32x4 w; w.x = cvt_pk_bf16(v[0], v[1]); w.y = cvt_pk_bf16(v[2], v[3]); w.z = cvt_pk_bf16(v[4], v[5]); w.w = cvt_pk_bf16(v[6], v[7]);
                *(u32x4*)(base + (size_t)(ai * HALF + m * 16) * DFF) = w; }
        return false;
    }
};
}

#define XB_TMO      128
#define XB_XCNT(j)  (256  + 64 * (j))
#define XB_XSUB(j)  (1280 + 64 * (j))
#define XB_XGEN(j)  (2304 + 64 * (j))
#define XB_TOP      3328
#define XB_TOPGEN   3392
#define XCD_BAR_WORDS 3456
#define XB_SPIN_CAP (1u << 18)
__device__ __forceinline__ unsigned xb_ld(unsigned* p)              { return __hip_atomic_load(p, __ATOMIC_RELAXED, __HIP_MEMORY_SCOPE_AGENT); }
__device__ __forceinline__ unsigned xb_add(unsigned* p, unsigned v) { return __hip_atomic_fetch_add(p, v, __ATOMIC_RELAXED, __HIP_MEMORY_SCOPE_AGENT); }
__device__ __forceinline__ unsigned xb_xcc_id() { return (unsigned)__builtin_amdgcn_s_getreg((3 << 11) | 20) & 0xFu; }
#define XB_SPIN(cond, bar) do { unsigned _sp = 0; while (cond) { __builtin_amdgcn_s_sleep(1); \
    if ((++_sp & 255u) == 0u) { if (xb_ld(&(bar)[XB_TMO])) break; if (_sp > XB_SPIN_CAP) { atomicAdd(&(bar)[XB_TMO], 1u); break; } } } } while (0)
struct XcdBarrier { unsigned* bar; unsigned x; volatile LAS unsigned* st; };
__device__ __forceinline__ XcdBarrier xcd_barrier_post(unsigned* bar, volatile LAS unsigned* st) {
    XcdBarrier b; b.bar = bar; b.x = xb_xcc_id(); b.st = st;
    if (threadIdx.x == 0) (void)xb_add(&bar[XB_XCNT(b.x)], 1u);
    return b;
}
__device__ __forceinline__ void xcd_barrier_complete(unsigned* bar, unsigned x, unsigned& nloc, unsigned& nx) {
    const unsigned G = gridDim.x * gridDim.y * gridDim.z;
    unsigned sum, cnt, mine, sp = 0u;
    for (;;) {
        sum = 0u; cnt = 0u; mine = 0u;
#pragma unroll
        for (unsigned j = 0; j < 16; ++j) { const unsigned c = xb_ld(&bar[XB_XCNT(j)]); sum += c; cnt += (c > 0u) ? 1u : 0u; mine = (j == x) ? c : mine; }
        if (sum == G) break;
        __builtin_amdgcn_s_sleep(1);
        if ((++sp & 255u) == 0u) { if (xb_ld(&bar[XB_TMO])) break; if (sp > XB_SPIN_CAP) { atomicAdd(&bar[XB_TMO], 1u); break; } }
    }
    nloc = mine > 0u ? mine : 1u; nx = cnt > 0u ? cnt : 1u;
}
__device__ __forceinline__ void xcd_barrier(const XcdBarrier& b) {
    asm volatile("s_waitcnt vmcnt(0)" ::: "memory");
    __syncthreads();
    if (threadIdx.x == 0) {
        unsigned* bar = b.bar;
        __builtin_amdgcn_s_waitcnt(0);
        unsigned nloc = b.st[0], nx = b.st[1];
        if (nloc == 0u) { xcd_barrier_complete(bar, b.x, nloc, nx); b.st[0] = nloc; b.st[1] = nx; }
        const unsigned old = xb_add(&bar[XB_XSUB(b.x)], 1u);
        const unsigned gen = old / nloc;
        if (old + 1u == (gen + 1u) * nloc) {
            __builtin_amdgcn_fence(__ATOMIC_RELEASE, "agent");
            asm volatile("s_waitcnt vmcnt(0)" ::: "memory");
            const unsigned og = xb_add(&bar[XB_TOP], 1u);
            const unsigned tg = og / nx;
            if (og + 1u == (tg + 1u) * nx) xb_add(&bar[XB_TOPGEN], 1u);
            else XB_SPIN(xb_ld(&bar[XB_TOPGEN]) == tg, bar);
            __builtin_amdgcn_fence(__ATOMIC_ACQUIRE, "agent");
            xb_add(&bar[XB_XGEN(b.x)], 1u);
            asm volatile("s_waitcnt vmcnt(0)" ::: "memory");
        } else {
            XB_SPIN(xb_ld(&bar[XB_XGEN(b.x)]) == gen, bar);
            __builtin_amdgcn_fence(__ATOMIC_ACQUIRE, "agent");
            asm volatile("s_waitcnt vmcnt(0)" ::: "memory");
        }
    }
    __syncthreads();
}

struct Args {
    const float* in[29]; float* out; unsigned char* ws; int ph_lo, ph_hi;
};
enum { I_X = 0, I_MEM, I_ATTN_G, I_MEM_G, I_WIN, I_SBQG, I_SBKG, I_RWMIX, I_RWW0, I_RWWUP, I_RWA0, I_RWAUP, I_RWGUP, I_RWKK, I_RWKA, I_RWRK, I_RWLNG, I_RWLNB,
       I_MEMWKV, I_MEMQG, I_MEMKG, I_WSBO, I_WRWO, I_WMEMO, I_WOUT, I_FFNG, I_WGATE, I_WUP, I_WDOWN };

#define LDS_WAIT() asm volatile("s_waitcnt lgkmcnt(0)" ::: "memory")

__device__ __forceinline__ int rowmap(int mode, int n, int roff) {
    if (mode == 1) return n + (n >= 9952 ? 32 : 0);
    if (mode == 2) return (n >> 7) * 256 + (n & 127);
    if (mode == 3) return (n >> 7) * 256 + 128 + (n & 127);
    return n + roff;
}
__device__ __forceinline__ void transpose_item(const float* W, int N, bf16* WT, int ldk, int koff, int mode, int roff, LAS float* scr, int item, int lane) {
    const int nblk = N / 32, kb = item / nblk, nb = item - kb * nblk, k0 = 64 * kb, n0 = 32 * nb;
    { const int rr = lane >> 3, c4 = (lane & 7) * 4; f32x4 wv[8];
#pragma unroll
      for (int i = 0; i < 8; ++i) wv[i] = *(const GAS f32x4*)(W + (size_t)(k0 + 8 * i + rr) * N + n0 + c4);
#pragma unroll
      for (int i = 0; i < 8; ++i) { LAS float* d = scr + (8 * i + rr) * 33 + c4; d[0] = wv[i].x; d[1] = wv[i].y; d[2] = wv[i].z; d[3] = wv[i].w; } }
    LDS_WAIT(); asm volatile("" ::: "memory");
    const int c = lane & 7;
#pragma unroll
    for (int j = 0; j < 4; ++j) { const int n = (lane >> 3) + 8 * j; const LAS float* s = scr + (8 * c) * 33 + n;
        v4u o; o.x = pk2(s[0 * 33], s[1 * 33]); o.y = pk2(s[2 * 33], s[3 * 33]); o.z = pk2(s[4 * 33], s[5 * 33]); o.w = pk2(s[6 * 33], s[7 * 33]);
        *(GAS v4u*)(WT + (size_t)rowmap(mode, n0 + n, roff) * ldk + koff + k0 + 8 * c) = o; }
    LDS_WAIT(); asm volatile("" ::: "memory");
}
__device__ __forceinline__ void rms_rows4096(const float* x, const float* g, bf16* out, int first, int stride, int nrows, int lane) {
    if (first >= nrows) return;
    f32x4 v[16], nv[16];
    { const GAS f32x4* xr = (const GAS f32x4*)(x + (size_t)first * 4096) + lane;
#pragma unroll
      for (int j = 0; j < 16; ++j) v[j] = xr[64 * j]; }
    const GAS f32x4* gr = (const GAS f32x4*)g + lane;
    for (int m = first; m < nrows; m += stride) {
        const bool more = m + stride < nrows;
        if (more) { const GAS f32x4* xr = (const GAS f32x4*)(x + (size_t)(m + stride) * 4096) + lane;
#pragma unroll
            for (int j = 0; j < 16; ++j) nv[j] = xr[64 * j]; }
        float s = 0.f;
#pragma unroll
        for (int j = 0; j < 16; ++j) s += (v[j].x * v[j].x + v[j].y * v[j].y) + (v[j].z * v[j].z + v[j].w * v[j].w);
        const float rstd = 1.0f / sqrtf(wave_sum(s) * (1.f / 4096.f) + RMS_EPS);
        GAS v2u* o8 = (GAS v2u*)(out + (size_t)m * 4096) + lane;
#pragma unroll
        for (int j = 0; j < 16; ++j) { const f32x4 gv = gr[64 * j]; v2u o; o.x = pk2(v[j].x * rstd * gv.x, v[j].y * rstd * gv.y); o.y = pk2(v[j].z * rstd * gv.z, v[j].w * rstd * gv.w); o8[64 * j] = o; }
        if (more) {
#pragma unroll
            for (int j = 0; j < 16; ++j) v[j] = nv[j]; }
    }
}
#define QB 16
#define QUEUE_PULL(headword, nitems, BODY) do { for (;;) { int it_ = 0; if ((threadIdx.x & 63) == 0) it_ = (int)__hip_atomic_fetch_add((unsigned*)(headword), (unsigned)QB, __ATOMIC_RELAXED, __HIP_MEMORY_SCOPE_AGENT); \
        it_ = __builtin_amdgcn_readfirstlane(it_); if (it_ >= (nitems)) break; const int qe_ = (it_ + QB < (nitems)) ? it_ + QB : (nitems); \
        for (int qi = it_; qi < qe_; ++qi) { BODY; } } } while (0)
constexpr int NPHASES = 12;
__global__ void __launch_bounds__(NWAVES * 64, 2) hybrid_fwd(Args args) {
    extern __shared__ __attribute__((aligned(16))) unsigned char lds_raw[];
    LAS unsigned char* lds = (LAS unsigned char*)lds_raw;
    volatile LAS unsigned* MISC = (volatile LAS unsigned*)(lds + MISC_OFF);
    const int G = gridDim.x, bx = blockIdx.x, NGW = G * NWAVES;
    unsigned char* ws = args.ws;
    gu32* ctl = (gu32*)(ws + WS_CTL);
    for (int u = threadIdx.x; u < (LDS_BYTES - LDSCTL_OFF) / 4; u += NWAVES * 64) ((LAS unsigned*)(lds + LDSCTL_OFF))[u] = 0u;
#define PHASE_IDS() int tid = threadIdx.x; asm volatile("" : "+v"(tid)); const int lane = tid & 63, wave = __builtin_amdgcn_readfirstlane(tid >> 6), gw = bx * NWAVES + wave; (void)lane; (void)gw
    __syncthreads();
#if MK_PER_PHASE
    XcdBarrier bar; bar.bar = (unsigned*)(ctl + CW_BAR); bar.x = 0; bar.st = nullptr;
#define GRID_BAR() do { } while (0)
#else
    XcdBarrier bar = xcd_barrier_post((unsigned*)(ctl + CW_BAR), MISC + 8);
#define GRID_BAR() xcd_barrier(bar)
#endif
    const int lo = args.ph_lo, hi = args.ph_hi;
#define IN(k) (lo <= (k) && (k) < hi)
#define BOTH(k) (IN(k) && IN((k) + 1))

    bf16* WIN_T = (bf16*)(ws + WS_WIN_T); bf16* WCAT_T = (bf16*)(ws + WS_WCAT_T); bf16* WOUT_T = (bf16*)(ws + WS_WOUT_T); bf16* WKV_T = (bf16*)(ws + WS_WKV_T);
    bf16* LBWA = (bf16*)(ws + WS_LBWA); bf16* LBG = (bf16*)(ws + WS_LBG); bf16* XN = (bf16*)(ws + WS_XN); bf16* MEMN = (bf16*)(ws + WS_MEMN); bf16* P = (bf16*)(ws + WS_P);
    float* R_R = (float*)(ws + WS_R); float* R_W = (float*)(ws + WS_R + RSZ); float* R_KP = (float*)(ws + WS_R + 2 * RSZ); float* R_V = (float*)(ws + WS_R + 3 * RSZ);
    float* R_KK = (float*)(ws + WS_R + 4 * RSZ); float* R_NB = (float*)(ws + WS_R + 5 * RSZ);
    bf16* GB = (bf16*)(ws + WS_G); float* Y = (float*)(ws + WS_Y); bf16* OCAT = (bf16*)(ws + WS_OCAT);
    bf16* QN = (bf16*)(ws + WS_QN); bf16* KN = (bf16*)(ws + WS_KN); bf16* VT = (bf16*)(ws + WS_VT); bf16* MQN = (bf16*)(ws + WS_MQN);
    bf16* MKRAW = (bf16*)(ws + WS_MKRAW); bf16* MKN = (bf16*)(ws + WS_MKN); bf16* MVT = (bf16*)(ws + WS_MVT);
    float* SM = (float*)(ws + WS_SM); bf16* PM = (bf16*)(ws + WS_PM); bf16* LA1 = (bf16*)(ws + WS_LA1); bf16* LA2 = (bf16*)(ws + WS_LA2);
    float* S0ALL = R_R;     float* BONUS = (float*)(ws + WS_BONUS);
    float* PHIT = (float*)(ws + WS_PHIT); float* PCT = (float*)(ws + WS_PCT); float* SLOCT = (float*)(ws + WS_SLOCT);
    bf16* WGU_T = (bf16*)(ws + WS_WGU_T); bf16* WD_T = (bf16*)(ws + WS_WD_T); bf16* MERGED = (bf16*)(ws + WS_MERGED); float* H1 = (float*)(ws + WS_H1); bf16* ACT = (bf16*)(ws + WS_ACT);

#define Q1_ITEMS (24 * 128 + 24 * 128 + 16 * 128 + 64 * 128 + 172 * 128)
#define Q1_BODY { int r = qi; LAS float* scr = (LAS float*)(lds + wave * 16384); \
        if (r < 24 * 128) transpose_item(args.in[I_WSBO], 4096, WCAT_T, 4096, 0, 0, 0, scr, r, lane); \
        else if ((r -= 24 * 128) < 24 * 128) transpose_item(args.in[I_WRWO], 4096, WCAT_T, 4096, 1536, 0, 0, scr, r, lane); \
        else if ((r -= 24 * 128) < 16 * 128) transpose_item(args.in[I_WMEMO], 4096, WCAT_T, 4096, 3072, 0, 0, scr, r, lane); \
        else if ((r -= 16 * 128) < 64 * 128) transpose_item(args.in[I_WOUT], 4096, WOUT_T, 4096, 0, 0, 0, scr, r, lane); \
        else { r -= 64 * 128; transpose_item(args.in[I_WDOWN], 4096, WD_T, DFF, 0, 0, 0, scr, r, lane); } }
#define Q2_ITEMS (2 * 64 * 344)
#define Q2_BODY { int r = qi; LAS float* scr2 = (LAS float*)(lds + wave * 16384); \
        if (r < 64 * 344) transpose_item(args.in[I_WGATE], DFF, WGU_T, 4096, 0, 2, 0, scr2, r, lane); \
        else transpose_item(args.in[I_WUP], DFF, WGU_T, 4096, 0, 3, 0, scr2, r - 64 * 344, lane); }
    if (IN(0)) {
        PHASE_IDS();
        LAS float* scr = (LAS float*)(lds + wave * 16384);
        constexpr int I_IN = 64 * 727, I_KV = 64 * 64;
        constexpr int NITEMS = I_IN + I_KV;
        for (int it = gw; it < NITEMS; it += NGW) {
            int r = it;
            if (r < I_IN) { transpose_item(args.in[I_WIN], NIN_ORIG, WIN_T, 4096, 0, 1, 0, scr, r, lane); continue; } r -= I_IN;
            transpose_item(args.in[I_MEMWKV], 2048, WKV_T, 4096, 0, 0, 0, scr, r, lane);
        }
        for (int i = bx * 512 + tid; i < 32 * 4096 / 8; i += G * 512) ((GAS v4u*)(WIN_T + (size_t)9952 * 4096))[i] = (v4u){0u, 0u, 0u, 0u};
        for (int i = bx * 512 + tid; i < 3072 * 256; i += G * 512) { const int n = i >> 8, k = i & 255; float v = 0.f;
            if (n < 1536) { if (k < 128) v = args.in[I_RWWUP][(size_t)k * 1536 + n]; } else { if (k >= 128) v = args.in[I_RWAUP][(size_t)(k - 128) * 1536 + (n - 1536)]; }
            LBWA[i] = (bf16)f2bf(v); }
        for (int i = bx * 512 + tid; i < 1536 * 512; i += G * 512) { const int n = i >> 9, k = i & 511; const float v = (k < 480) ? args.in[I_RWGUP][(size_t)k * 1536 + n] : 0.f; LBG[i] = (bf16)f2bf(v); }
        rms_rows4096(args.in[I_X], args.in[I_ATTN_G], XN, gw, NGW, T, lane);
        rms_rows4096(args.in[I_MEM], args.in[I_MEM_G], MEMN, gw, NGW, NMEM, lane);
        if (BOTH(0)) GRID_BAR();
    }

    if (IN(1)) {
        PHASE_IDS();
        pg8::SchedGemm1 S; S.to.init(32, 91); S.G = G; S.c = bx; S.XN = (const char*)XN; S.WIN = (const char*)WIN_T; S.MEMN = (const char*)MEMN; S.WKV = (const char*)WKV_T;
        pg8::EpiGemm1 E{P, MKRAW, MVT};
        pg8::gemm_phase(lds, 4096, 4096, S, E);
        QUEUE_PULL(ctl + CW_Q1, Q1_ITEMS, Q1_BODY);
        if (BOTH(1)) GRID_BAR();
    }

    if (IN(2)) {
        PHASE_IDS();
        QUEUE_PULL(ctl + CW_Q1, Q1_ITEMS, Q1_BODY);
        __syncthreads();
        {
            const float qscale = 0.08838834764831845f * 1.4426950408889634f;
            for (int t = gw; t < T; t += NGW) {
                const bf16* prow = P + (size_t)t * NINP;
#pragma unroll
                for (int which = 0; which < 2; ++which) {
                    const float* gain = args.in[which ? I_SBKG : I_SBQG]; bf16* dst = (which ? KN : QN) + (size_t)t * 1536; const int cb = which ? PK : PQ;
                    const f32x4 g0 = *(const GAS f32x4*)(gain + (8 * lane & 127)), g1 = *(const GAS f32x4*)(gain + (8 * lane & 127) + 4);
#pragma unroll
                    for (int p = 0; p < 3; ++p) {
                        const v4u raw = *(const GAS v4u*)(prow + cb + 512 * p + 8 * lane);
                        float v[8] = {bflo(raw.x), bfhi(raw.x), bflo(raw.y), bfhi(raw.y), bflo(raw.z), bfhi(raw.z), bflo(raw.w), bfhi(raw.w)};
                        float ss = 0.f;
#pragma unroll
                        for (int j = 0; j < 8; ++j) ss += v[j] * v[j];
                        ss = red16_sum(ss);
                        const float rstd = (which ? 1.0f : qscale) / sqrtf(ss * (1.f / 128.f) + RMS_EPS);
                        v4u o; o.x = pk2(v[0] * rstd * g0.x, v[1] * rstd * g0.y); o.y = pk2(v[2] * rstd * g0.z, v[3] * rstd * g0.w);
                        o.z = pk2(v[4] * rstd * g1.x, v[5] * rstd * g1.y); o.w = pk2(v[6] * rstd * g1.z, v[7] * rstd * g1.w);
                        *(GAS v4u*)(dst + 512 * p + 8 * lane) = o;
                    }
                }
                {
                    const float* gain = args.in[I_MEMQG] + ((16 * lane) & 255);
                    const v4u r0 = *(const GAS v4u*)(prow + PMQ + 16 * lane), r1 = *(const GAS v4u*)(prow + PMQ + 16 * lane + 8);
                    float v[16] = {bflo(r0.x), bfhi(r0.x), bflo(r0.y), bfhi(r0.y), bflo(r0.z), bfhi(r0.z), bflo(r0.w), bfhi(r0.w), bflo(r1.x), bfhi(r1.x), bflo(r1.y), bfhi(r1.y), bflo(r1.z), bfhi(r1.z), bflo(r1.w), bfhi(r1.w)};
                    float ss = 0.f;
#pragma unroll
                    for (int j = 0; j < 16; ++j) ss += v[j] * v[j];
                    ss = red16_sum(ss);
                    const float rstd = 0.0625f / sqrtf(ss * (1.f / 256.f) + RMS_EPS);
                    unsigned o[8];
#pragma unroll
                    for (int j = 0; j < 8; ++j) o[j] = pk2(v[2 * j] * rstd * gain[2 * j], v[2 * j + 1] * rstd * gain[2 * j + 1]);
                    *(GAS v4u*)(MQN + (size_t)t * 1024 + 16 * lane) = (v4u){o[0], o[1], o[2], o[3]};
                    *(GAS v4u*)(MQN + (size_t)t * 1024 + 16 * lane + 8) = (v4u){o[4], o[5], o[6], o[7]};
                }
            }
            for (int m = gw; m < NMEM; m += NGW) {
                const float* gain = args.in[I_MEMKG] + ((16 * lane) & 255);
                const v4u r0 = *(const GAS v4u*)(MKRAW + (size_t)m * 1024 + 16 * lane), r1 = *(const GAS v4u*)(MKRAW + (size_t)m * 1024 + 16 * lane + 8);
                float v[16] = {bflo(r0.x), bfhi(r0.x), bflo(r0.y), bfhi(r0.y), bflo(r0.z), bfhi(r0.z), bflo(r0.w), bfhi(r0.w), bflo(r1.x), bfhi(r1.x), bflo(r1.y), bfhi(r1.y), bflo(r1.z), bfhi(r1.z), bflo(r1.w), bfhi(r1.w)};
                float ss = 0.f;
#pragma unroll
                for (int j = 0; j < 16; ++j) ss += v[j] * v[j];
                ss = red16_sum(ss);
                const float rstd = 1.0f / sqrtf(ss * (1.f / 256.f) + RMS_EPS);
                unsigned o[8];
#pragma unroll
                for (int j = 0; j < 8; ++j) o[j] = pk2(v[2 * j] * rstd * gain[2 * j], v[2 * j + 1] * rstd * gain[2 * j + 1]);
                *(GAS v4u*)(MKN + (size_t)m * 1024 + 16 * lane) = (v4u){o[0], o[1], o[2], o[3]};
                *(GAS v4u*)(MKN + (size_t)m * 1024 + 16 * lane + 8) = (v4u){o[4], o[5], o[6], o[7]};
            }
        }
        {
            LAS unsigned char* scr = lds + wave * 16640;
            for (int it = gw; it < 12 * 128; it += NGW) {
                const int h = it >> 7, t0 = (it & 127) * 64;
#pragma unroll
                for (int i = 0; i < 16; ++i) { const int tt = 4 * i + (lane >> 4), c = lane & 15;
                    const v4u raw = *(const GAS v4u*)(P + (size_t)(t0 + tt) * NINP + PV + 128 * h + 8 * c);
                    LAS unsigned* d = (LAS unsigned*)(scr + tt * 260 + c * 16); d[0] = raw.x; d[1] = raw.y; d[2] = raw.z; d[3] = raw.w; }
                LDS_WAIT(); asm volatile("" ::: "memory");
#pragma unroll
                for (int i = 0; i < 16; ++i) { const int d = 8 * i + (lane >> 3), tc = lane & 7;
                    unsigned short e[8];
#pragma unroll
                    for (int j = 0; j < 8; ++j) e[j] = *(const LAS unsigned short*)(scr + (8 * tc + j) * 260 + d * 2);
                    v4u o; o.x = e[0] | ((unsigned)e[1] << 16); o.y = e[2] | ((unsigned)e[3] << 16); o.z = e[4] | ((unsigned)e[5] << 16); o.w = e[6] | ((unsigned)e[7] << 16);
                    *(GAS v4u*)(VT + ((size_t)h * 128 + d) * T + t0 + 8 * tc) = o; }
                LDS_WAIT(); asm volatile("" ::: "memory");
            }
        }
        {
            const float* mix = args.in[I_RWMIX];
            for (int t = gw; t < T; t += NGW) {
                const bf16* cur = P + (size_t)t * NINP + PRW; const bf16* prv = cur - NINP;
                for (int c8 = 576 + lane; c8 < RWSEG / 8; c8 += 64) {
                    const int c0 = 8 * c8;
                    const v4u rc = *(const GAS v4u*)(cur + c0); v4u rp = (v4u){0u, 0u, 0u, 0u}; if (t > 0) rp = *(const GAS v4u*)(prv + c0);
                    const f32x4 m0 = *(const GAS f32x4*)(mix + c0), m1 = *(const GAS f32x4*)(mix + c0 + 4);
                    const float cv[8] = {bflo(rc.x), bfhi(rc.x), bflo(rc.y), bfhi(rc.y), bflo(rc.z), bfhi(rc.z), bflo(rc.w), bfhi(rc.w)};
                    const float pv[8] = {bflo(rp.x), bfhi(rp.x), bflo(rp.y), bfhi(rp.y), bflo(rp.z), bfhi(rp.z), bflo(rp.w), bfhi(rp.w)};
                    const float mv[8] = {m0.x, m0.y, m0.z, m0.w, m1.x, m1.y, m1.z, m1.w};
                    float s[8];
#pragma unroll
                    for (int j = 0; j < 8; ++j) s[j] = cv[j] + (pv[j] - cv[j]) * mv[j];
                    if (c0 < 4864) { const bool isw = c0 < 4736;
                        if (isw) {
#pragma unroll
                            for (int j = 0; j < 8; ++j) { const float e = fexp(2.f * s[j]); s[j] = 1.f - 2.f * frcp(e + 1.f); } }
                        *(GAS v4u*)(LA1 + (size_t)t * 256 + (c0 - 4608)) = (v4u){pk2(s[0], s[1]), pk2(s[2], s[3]), pk2(s[4], s[5]), pk2(s[6], s[7])}; }
                    else {
#pragma unroll
                        for (int j = 0; j < 8; ++j) s[j] = sigmoidf_(s[j]);
                        *(GAS v4u*)(LA2 + (size_t)t * 512 + (c0 - 4864)) = (v4u){pk2(s[0], s[1]), pk2(s[2], s[3]), pk2(s[4], s[5]), pk2(s[6], s[7])}; }
                }
                if (lane < 4) *(GAS v4u*)(LA2 + (size_t)t * 512 + 480 + 8 * lane) = (v4u){0u, 0u, 0u, 0u};
            }
        }
        if (BOTH(2)) GRID_BAR();
    }

    if (IN(3)) {
        PHASE_IDS();
        int nt4 = 4, nt8 = 8; asm volatile("" : "+s"(nt4), "+s"(nt8));
        { pg8::SchedPlain S; S.to.init(32, 12); S.G = G; S.c = bx; S.nt = nt4; S.A0 = (const char*)LA1; S.B0 = (const char*)LBWA; S.sA = 256 * 256 * 2; S.sB = 256 * 256 * 2;
          pg8::EpiLoraWA E{args.in[I_RWW0], args.in[I_RWA0], R_W, R_NB};
          pg8::gemm_phase(lds, 256, 256, S, E); }
        { pg8::SchedPlain S; S.to.init(32, 6); S.G = G; S.c = (bx + G - 64) % G; S.nt = nt8; S.A0 = (const char*)LA2; S.B0 = (const char*)LBG; S.sA = 256 * 512 * 2; S.sB = 256 * 512 * 2;
          pg8::EpiBf16 E{GB, 1536, 0, 0};
          pg8::gemm_phase(lds, 512, 512, S, E); }
        { pg8::SchedHeads S; S.G = G; S.c = (bx + G - 128) % G; S.nunits = 128; S.nt = nt4; S.A0 = (const char*)MQN; S.B0 = (const char*)MKN; S.sA = 256 * 1024 * 2; S.hA = 512; S.hB = 512;
          pg8::EpiScoreF32 E{SM};
          pg8::gemm_phase(lds, 1024, 1024, S, E); }
        if (BOTH(3)) GRID_BAR();
    }

    if (IN(4)) {
        PHASE_IDS();
        constexpr int RP = 260, SLOT = 64 * RP, NP = 272;
        constexpr int S_AT = 0, S_BT = SLOT, S_KT = 2 * SLOT, S_RT = 3 * SLOT, S_NABT = 4 * SLOT, S_NAK = S_NABT + 64 * NP, S_MBR = S_NAK + SLOT, S_MKR = S_MBR + SLOT, S_SEG = S_MKR + SLOT, S_GC = S_SEG + 2048;
        static_assert(S_GC + 256 <= LDSCTL_OFF, "chunk-prep LDS map");
        constexpr int HP = 144, HSL = 64 * HP, H_AT = S_NABT, H_BT = H_AT + HSL, H_KT = H_BT + HSL, H_RT = H_KT + HSL;
        static_assert(H_RT + HSL <= S_SEG, "bf16 operand copies inside the Gram output slots");
        constexpr int H_PSIT = S_GC + 256, H_QCT = H_PSIT + HSL;
        static_assert(H_QCT + HSL <= LDSCTL_OFF, "chunk-prep LDS map (bf16 step-F operands)");
        const int l31 = lane & 31, lh = lane >> 5;
        float nwv[8], nkrv[8], nav[8], nrv[8], nvv[8];
        unsigned short pr_[9], pk_[9], pv_[9];
#define S1_FETCH(it_) do { const int t0_ = ((it_) & 127) * 64 + 8 * wave, hc_ = ((it_) >> 7) * 64 + lane; const size_t gb_ = (size_t)t0_ * 1536 + hc_; \
            _Pragma("unroll") for (int i = 0; i < 8; ++i) { const size_t o_ = gb_ + (size_t)i * 1536; nwv[i] = R_W[o_]; nav[i] = R_NB[o_]; } \
            const bf16* pb_ = P + (size_t)t0_ * NINP + PRW + hc_; \
            _Pragma("unroll") for (int i = 0; i < 9; ++i) { const bool ok_ = (t0_ + i) > 0; const bf16* pp_ = pb_ + (ptrdiff_t)(i - 1) * NINP; \
                pr_[i] = ok_ ? pp_[0] : (unsigned short)0; pk_[i] = ok_ ? pp_[1536] : (unsigned short)0; pv_[i] = ok_ ? pp_[3072] : (unsigned short)0; } } while (0)
#define S1_SHIFT() do { const int hc_ = head * 64 + lane; const float mr_ = args.in[I_RWMIX][hc_], mk_ = args.in[I_RWMIX][1536 + hc_], mv_ = args.in[I_RWMIX][3072 + hc_]; \
            _Pragma("unroll") for (int i = 0; i < 8; ++i) { const float cr_ = bflo(pr_[i + 1]), ck_ = bflo(pk_[i + 1]), cv_ = bflo(pv_[i + 1]); \
                nrv[i] = cr_ + (bflo(pr_[i]) - cr_) * mr_; nkrv[i] = ck_ + (bflo(pk_[i]) - ck_) * mk_; nvv[i] = cv_ + (bflo(pv_[i]) - cv_) * mv_; } } while (0)
        if (bx < 24 * 128) S1_FETCH(bx);
        for (int item = bx; item < 24 * 128; item += G) {
            const int head = item >> 7, chunk = item & 127;
            unsigned vvp[4];
            {
                S1_SHIFT();
                float nkkv[8], nnbv[8], nkpv[8];
                { const float kkc = args.in[I_RWKK][head * 64 + lane], kac = args.in[I_RWKA][head * 64 + lane];
#pragma unroll
                  for (int i = 0; i < 8; ++i) { const float kq = nkrv[i] * kkc; float ss = red16_sum(kq * kq); ss += __shfl_xor(ss, 16); ss += __shfl_xor(ss, 32);
                      const float kn = kq * (1.0f / fmaxf(sqrtf(ss), 1e-12f)); nkkv[i] = kn; nnbv[i] = -(kn * nav[i]); nkpv[i] = nkrv[i] * (1.0f + (nav[i] - 1.0f) * kac); } }
                float g[8]; g[0] = nwv[0];
#pragma unroll
                for (int i = 1; i < 8; ++i) g[i] = g[i - 1] * nwv[i];
                *(LAS float*)(lds + S_SEG + (wave * 64 + lane) * 4) = g[7];
                __syncthreads();
                float pre = 1.0f;
                for (int w2 = 0; w2 < wave; ++w2) pre *= *(LAS const float*)(lds + S_SEG + (w2 * 64 + lane) * 4);
                float avs[8];
#pragma unroll
                for (int i = 0; i < 8; ++i) { const float gt = pre * g[i], gp = (i == 0) ? pre : pre * g[i - 1], inv = 1.0f / gt; const int o = (8 * wave + i) * RP + lane * 4;
                    const float av = nkkv[i] * gp, bv = nnbv[i] * inv, kv = nkpv[i] * inv, rvv = nrv[i] * gt;
                    avs[i] = av; *(LAS float*)(lds + S_BT + o) = bv; *(LAS float*)(lds + S_KT + o) = kv; *(LAS float*)(lds + S_RT + o) = rvv;
                    const int ob = (8 * wave + i) * HP + lane * 2;
                    *(LAS unsigned short*)(lds + H_AT + ob) = (unsigned short)f2bf(av); *(LAS unsigned short*)(lds + H_BT + ob) = (unsigned short)f2bf(bv);
                    *(LAS unsigned short*)(lds + H_KT + ob) = (unsigned short)f2bf(kv); *(LAS unsigned short*)(lds + H_RT + ob) = (unsigned short)f2bf(rvv); }
                *(LAS v4u*)(lds + S_AT + lane * HP + wave * 16) = (v4u){pk2(avs[0], avs[1]), pk2(avs[2], avs[3]), pk2(avs[4], avs[5]), pk2(avs[6], avs[7])};
                vvp[0] = pk2(nvv[0], nvv[1]); vvp[1] = pk2(nvv[2], nvv[3]); vvp[2] = pk2(nvv[4], nvv[5]); vvp[3] = pk2(nvv[6], nvv[7]);
                if (wave == 7) *(LAS float*)(lds + S_GC + lane * 4) = pre * g[7];
                { const float rkl = args.in[I_RWRK][head * 64 + lane];
#pragma unroll
                  for (int i = 0; i < 8; ++i) { const float bsum = wave_sum(nrv[i] * nkpv[i] * rkl); if (lane == 0) BONUS[(size_t)(chunk * 64 + 8 * wave + i) * 24 + head] = bsum; } }
                if (item + G < 24 * 128) S1_FETCH(item + G);
                __syncthreads();
            }
            {
                const int Ls = (wave >> 2) ? H_KT : H_BT, Rs = ((wave >> 1) & 1) ? H_RT : H_AT, hm = wave & 1, which = wave >> 1;
                LAS const unsigned char* Lp = lds + Ls + (32 * hm + l31) * HP + lh * 16;
                LAS const unsigned char* Rp = lds + Rs + l31 * HP + lh * 16;
                f32x16 acc0, acc1;
#pragma unroll
                for (int r = 0; r < 16; ++r) { acc0[r] = 0.f; acc1[r] = 0.f; }
#pragma unroll
                for (int ks = 0; ks < 4; ++ks) { const bf16x8 a = *(LAS const bf16x8*)(Lp + ks * 32), b0 = *(LAS const bf16x8*)(Rp + ks * 32), b1 = *(LAS const bf16x8*)(Rp + 32 * HP + ks * 32);
                    acc0 = __builtin_amdgcn_mfma_f32_32x32x16_bf16(a, b0, acc0, 0, 0, 0); acc1 = __builtin_amdgcn_mfma_f32_32x32x16_bf16(a, b1, acc1, 0, 0, 0); }
                __syncthreads();
                const bool strict = (which == 0) || (which == 2);
#pragma unroll
                for (int nt = 0; nt < 2; ++nt)
#pragma unroll
                    for (int r = 0; r < 16; ++r) { const int j = 32 * hm + (r & 3) + 8 * (r >> 2) + 4 * lh, t = 32 * nt + l31; float val = nt ? acc1[r] : acc0[r];
                        const bool keep = strict ? (j < t) : (j <= t); val = keep ? val : 0.f;
                        int off;
                        if (which == 0) off = S_NABT + t * NP + ((j & 3) * 16 + (j >> 2)) * 4;
                        else off = (which == 1 ? S_MBR : S_MKR) + j * RP + t * 4;
                        if (which == 2) *(LAS unsigned short*)(lds + S_NAK + j * HP + t * 2) = (unsigned short)f2bf(val);
                        else *(LAS float*)(lds + off) = val; }
                __syncthreads();
            }
            {
                const int ci = lane >> 2, g = lane & 3, c = 16 * (wave & 3) + ci; const int slot = (wave < 4) ? S_MBR : S_BT;
                float xr[16];
#pragma unroll
                for (int q = 0; q < 16; ++q) xr[q] = *(LAS const float*)(lds + slot + (4 * q + g) * RP + c * 4);
                __syncthreads();
                f32x4 ca[4], cb[4], cc[4];
#define S1_CF(t_, dst_) do { if ((t_) >= 1) { _Pragma("unroll") for (int qg = 0; qg < 4; ++qg) if (4 * qg < ((t_) >> 2) + 1) dst_[qg] = *(LAS const f32x4*)(lds + S_NABT + (t_) * NP + (g * 16 + 4 * qg) * 4); } } while (0)
#define S1_STEP(t_, cur_, nxt_) do { S1_CF((t_) - 2, nxt_); __builtin_amdgcn_sched_barrier(0); \
                    const float xt = quad_bcast(xr[(t_) >> 2], (t_) & 3);     \
                    _Pragma("unroll") for (int qg = 0; qg < 4; ++qg) { _Pragma("unroll") for (int e = 0; e < 4; ++e) if (4 * qg + e < ((t_) >> 2) + 1) xr[4 * qg + e] = fmaf(cur_[qg][e], xt, xr[4 * qg + e]); } \
                    __builtin_amdgcn_sched_barrier(0); } while (0)
                S1_CF(63, ca); S1_CF(62, cb);
#pragma unroll
                for (int tb = 63; tb >= 1; tb -= 3) { S1_STEP(tb, ca, cc); S1_STEP(tb - 1, cb, ca); S1_STEP(tb - 2, cc, cb); }
#pragma unroll
                for (int q = 0; q < 16; ++q) *(LAS unsigned short*)(lds + slot + c * HP + (4 * q + g) * 2) = (unsigned short)f2bf(xr[q]);
                __syncthreads();
            }
            {
                const int which = wave >> 2, hm = (wave >> 1) & 1, ch = wave & 1; const int Xs = ch ? S_BT : S_MBR;
                LAS const unsigned char* Ap = lds + (which ? S_NAK : S_AT) + (32 * hm + l31) * HP + lh * 16;
                LAS const unsigned char* Bp = lds + Xs + l31 * HP + lh * 16;
                f32x16 acc0, acc1;
                int l31e = l31, lhe = lh; asm volatile("" : "+v"(l31e), "+v"(lhe));
#pragma unroll
                for (int nt = 0; nt < 2; ++nt)
#pragma unroll
                    for (int r = 0; r < 16; ++r) { const int m = 32 * hm + (r & 3) + 8 * (r >> 2) + 4 * lhe, n = 32 * nt + l31e; float iv;
                        if (which == 0) iv = ch ? ((m == n) ? 1.0f : 0.0f) : *(LAS const float*)(lds + S_RT + n * RP + m * 4);
                        else iv = *(LAS const float*)(lds + (ch ? S_KT : S_MKR) + m * RP + n * 4);
                        if (nt) acc1[r] = iv; else acc0[r] = iv; }
#pragma unroll
                for (int ks = 0; ks < 4; ++ks) { const bf16x8 a = *(LAS const bf16x8*)(Ap + ks * 32), b0 = *(LAS const bf16x8*)(Bp + ks * 32), b1 = *(LAS const bf16x8*)(Bp + 32 * HP + ks * 32);
                    acc0 = __builtin_amdgcn_mfma_f32_32x32x16_bf16(a, b0, acc0, 0, 0, 0); acc1 = __builtin_amdgcn_mfma_f32_32x32x16_bf16(a, b1, acc1, 0, 0, 0); }
#pragma unroll
                for (int nt = 0; nt < 2; ++nt) { const int n = 32 * nt + l31; const float gcn = ch ? *(LAS const float*)(lds + S_GC + n * 4) : 1.0f;
                    if (which == 0) { float* dst = (ch ? PCT : PHIT) + ((size_t)item * 64 + n) * 64 + 32 * hm + 4 * lh;
#pragma unroll
                        for (int i = 0; i < 4; ++i) { f32x4 o;
#pragma unroll
                            for (int e = 0; e < 4; ++e) o[e] = (nt ? acc1[4 * i + e] : acc0[4 * i + e]) * gcn;
                            *(GAS f32x4*)(dst + 8 * i) = o; } }
                    else {
#pragma unroll
                        for (int i = 0; i < 4; ++i) { const int j0 = 32 * hm + 8 * i + 4 * lh; float o[4];
#pragma unroll
                            for (int e = 0; e < 4; ++e) o[e] = (nt ? acc1[4 * i + e] : acc0[4 * i + e]) * gcn;
                            *(LAS v2u*)(lds + (ch ? H_QCT : H_PSIT) + n * HP + j0 * 2) = (v2u){pk2(o[0], o[1]), pk2(o[2], o[3])}; } } }
                *(LAS v4u*)(lds + S_NABT + lane * HP + wave * 16) = (v4u){vvp[0], vvp[1], vvp[2], vvp[3]};
                __syncthreads();
            }
            {
                const int hm = wave >> 2, ct = wave & 3, nt = ct & 1; const int Bs = (ct < 2) ? H_PSIT : H_QCT;
                LAS const unsigned char* Ap = lds + S_NABT + (32 * hm + l31) * HP + lh * 16;
                LAS const unsigned char* Bp = lds + Bs + (32 * nt + l31) * HP + lh * 16;
                f32x16 acc;
#pragma unroll
                for (int r = 0; r < 16; ++r) acc[r] = 0.f;
#pragma unroll
                for (int ks = 0; ks < 4; ++ks) acc = __builtin_amdgcn_mfma_f32_32x32x16_bf16(*(LAS const bf16x8*)(Ap + ks * 32), *(LAS const bf16x8*)(Bp + ks * 32), acc, 0, 0, 0);
                const int n = 32 * nt + l31;
                float* dst = (ct < 2) ? (Y + (size_t)(chunk * 64 + n) * 1536 + head * 64 + 32 * hm + 4 * lh) : (SLOCT + ((size_t)item * 64 + n) * 64 + 32 * hm + 4 * lh);
#pragma unroll
                for (int i = 0; i < 4; ++i) *(GAS f32x4*)(dst + 8 * i) = (f32x4){acc[4 * i], acc[4 * i + 1], acc[4 * i + 2], acc[4 * i + 3]};
                __syncthreads();
            }
        }
        for (int t = gw; t < T; t += NGW) {
            {
                const float* srow = SM + (size_t)t * 1024 + 16 * lane; f32x4 s[4]; float mx = -3.0e38f;
#pragma unroll
                for (int j = 0; j < 4; ++j) { s[j] = *(const GAS f32x4*)(srow + 4 * j); mx = fmaxf(mx, fmaxf(fmaxf(s[j].x, s[j].y), fmaxf(s[j].z, s[j].w))); }
                mx = red16_max(mx); float sum = 0.f;
#pragma unroll
                for (int j = 0; j < 4; ++j) { s[j].x = fexp(s[j].x - mx); s[j].y = fexp(s[j].y - mx); s[j].z = fexp(s[j].z - mx); s[j].w = fexp(s[j].w - mx); sum += (s[j].x + s[j].y) + (s[j].z + s[j].w); }
                sum = red16_sum(sum); const float inv = 1.0f / sum;
                unsigned o[8];
#pragma unroll
                for (int j = 0; j < 4; ++j) { o[2 * j] = pk2(s[j].x * inv, s[j].y * inv); o[2 * j + 1] = pk2(s[j].z * inv, s[j].w * inv); }
                *(GAS v4u*)(PM + (size_t)t * 1024 + 16 * lane) = (v4u){o[0], o[1], o[2], o[3]};
                *(GAS v4u*)(PM + (size_t)t * 1024 + 16 * lane + 8) = (v4u){o[4], o[5], o[6], o[7]};
            }
        }
        if (BOTH(4)) GRID_BAR();
    }

    if (IN(5)) {
        PHASE_IDS();
        constexpr int NSCAN = 96;
        if (bx < NSCAN) {
            const int head = 3 * (bx & 7) + (bx >> 5), rb = (bx >> 3) & 3, gk = lane >> 4, j = lane & 15, n0 = 16 * (wave & 3);
            constexpr int SP = 272, SBUF = 16 * SP;
            for (int i = tid; i < 2 * SBUF / 4; i += 512) *(LAS float*)(lds + i * 4) = 0.f;
            __syncthreads();
            int cur = 0;
            if (wave < 4) {
                const float* bsrc = PCT + ((size_t)head * 128 * 64 + n0 + j) * 64 + 16 * gk;
                const float* xsrc = SLOCT + ((size_t)head * 128 * 64 + n0 + j) * 64 + 16 * rb + 4 * gk;
                f32x4 bqs[3][4], xqs[3];
#define S2_LOAD(set, cc) do { const int cl_ = (cc) < 127 ? (cc) : 127; _Pragma("unroll") for (int q4 = 0; q4 < 4; ++q4) bqs[set][q4] = *(const GAS f32x4*)(bsrc + (size_t)cl_ * 4096 + 4 * q4); \
                    xqs[set] = *(const GAS f32x4*)(xsrc + (size_t)cl_ * 4096); } while (0)
#define S2_STEP(set, cc) do { f32x4 a4[4]; _Pragma("unroll") for (int q4 = 0; q4 < 4; ++q4) a4[q4] = *(LAS const f32x4*)(lds + cur * SBUF + j * SP + (16 * gk + 4 * q4) * 4); \
                    f32x4 acc[4]; _Pragma("unroll") for (int e = 0; e < 4; ++e) acc[e] = (f32x4){0.f, 0.f, 0.f, 0.f}; \
                    _Pragma("unroll") for (int q4 = 0; q4 < 4; ++q4) _Pragma("unroll") for (int e = 0; e < 4; ++e) acc[e] = __builtin_amdgcn_mfma_f32_16x16x4f32(a4[q4][e], bqs[set][q4][e], acc[e], 0, 0, 0); \
                    const f32x4 sum = (acc[0] + acc[1]) + (acc[2] + acc[3]) + xqs[set]; \
                    _Pragma("unroll") for (int r = 0; r < 4; ++r) *(LAS float*)(lds + (cur ^ 1) * SBUF + (4 * gk + r) * SP + (n0 + j) * 4) = sum[r]; \
                    S2_LOAD(set, (cc) + 3); __syncthreads(); cur ^= 1; } while (0)
                S2_LOAD(0, 0); S2_LOAD(1, 1); S2_LOAD(2, 2);
                for (int c = 0; c < 126; c += 3) { S2_STEP(0, c); S2_STEP(1, c + 1); S2_STEP(2, c + 2); } S2_STEP(0, 126); S2_STEP(1, 127);
#undef S2_LOAD
#undef S2_STEP
            } else {
                const int srow = 4 * (wave - 4) + (lane >> 4), sk = 4 * (lane & 15);
                float* dst = S0ALL + ((size_t)head * 128 * 64 + 16 * rb + srow) * 64 + sk;
                for (int c = 0; c < 128; ++c) { const f32x4 sv = *(LAS const f32x4*)(lds + cur * SBUF + srow * SP + sk * 4); *(GAS f32x4*)(dst + (size_t)c * 4096) = sv; __syncthreads(); cur ^= 1; }
            }
        }
        {
            const int GA = G - NSCAN, ca = bx - NSCAN;
            float thr;
            {
                const float* gq = args.in[I_SBQG]; const float* gk = args.in[I_SBKG];
                float mq = fmaxf(fabsf(gq[lane]), fabsf(gq[lane + 64])), mk = fmaxf(fabsf(gk[lane]), fabsf(gk[lane + 64]));
#pragma unroll
                for (int o = 1; o < 64; o <<= 1) { mq = fmaxf(mq, __shfl_xor(mq, o)); mk = fmaxf(mk, __shfl_xor(mk, o)); }
                thr = (11.3137085f * 1.02f * mq * mk + 104.0f) * 1.4426950408889634f;
            }
            constexpr int KPITCH = 272, VPITCH = 136, KBUF = 64 * KPITCH, VBUF = 128 * VPITCH, VOFF = 2 * KBUF, FLAGOFF = VOFF + 2 * VBUF, UQOFF = FLAGOFF + 64;
            const int hh = lane >> 5, l31 = lane & 31;
            __syncthreads();
            for (;;) {
                if (tid == 0) *(LAS int*)(lds + UQOFF) = (int)__hip_atomic_fetch_add((unsigned*)(ctl + CW_Q2), 1u, __ATOMIC_RELAXED, __HIP_MEMORY_SCOPE_AGENT);
                __syncthreads();
                const int uidx = *(LAS const int*)(lds + UQOFF);
                if (uidx >= 12 * 32) break;
                const int head = uidx % 12, qb = 31 - uidx / 12;
                const int q0 = qb * 256 + wave * 32, qi = q0 + l31;
                bf16x8 qf[8];
                { const bf16* qp = QN + (size_t)qi * 1536 + head * 128 + 8 * hh;
#pragma unroll
                  for (int s = 0; s < 8; ++s) qf[s] = *(const GAS bf16x8*)(qp + 16 * s); }
                f32x16 o[4];
#pragma unroll
                for (int c = 0; c < 4; ++c)
#pragma unroll
                    for (int r = 0; r < 16; ++r) o[c][r] = 0.f;
                float carry = 0.f; bool mydone = false;
                const int kkey = tid >> 3, kc = (tid & 7) * 2, vhd = tid >> 2, vp = tid & 3;
                const unsigned kofs = (unsigned)(kkey * 1536 + kc * 8) * 2u, vofs = (unsigned)(vhd * T + vp * 16) * 2u;
                const char* kgb = (const char*)KN + (size_t)head * 256; const char* vgb = (const char*)VT + (size_t)head * 128 * T * 2;
                v4u kr0, kr1, vr0, vr1;
#define SB_LOAD(kt_) do { const char* kb_ = kgb + (size_t)(kt_) * 64 * 1536 * 2; const char* vb_ = vgb + (size_t)(kt_) * 128; \
                          kr0 = *(const GAS v4u*)(kb_ + kofs); kr1 = *(const GAS v4u*)(kb_ + kofs + 16); vr0 = *(const GAS v4u*)(vb_ + vofs); vr1 = *(const GAS v4u*)(vb_ + vofs + 16); } while (0)
#define SB_STORE(buf_) do { LAS unsigned char* kd = lds + (buf_) * KBUF + kkey * KPITCH + kc * 16; *(LAS v4u*)kd = kr0; *(LAS v4u*)(kd + 16) = kr1; \
                          LAS unsigned char* vd = lds + VOFF + (buf_) * VBUF + vhd * VPITCH + vp * 32; *(LAS v2u*)vd = (v2u){vr0.x, vr0.y}; *(LAS v2u*)(vd + 8) = (v2u){vr0.z, vr0.w}; \
                          *(LAS v2u*)(vd + 16) = (v2u){vr1.x, vr1.y}; *(LAS v2u*)(vd + 24) = (v2u){vr1.z, vr1.w}; } while (0)
                int kt = 4 * qb + 3, cur = 0, it = 0;
                SB_LOAD(kt); SB_STORE(0); __syncthreads();
                for (;;) {
                    const bool more = kt > 0;
                    if (more) SB_LOAD(kt - 1);
                    const int k0 = kt * 64;
                    if (!mydone && k0 < q0 + 31) {
                        LAS const unsigned char* Kb = lds + cur * KBUF; LAS const unsigned char* Vb = lds + VOFF + cur * VBUF;
                        bf16x8 wf[2][2];
#pragma unroll
                        for (int b = 1; b >= 0; --b) {
                            f32x16 z;
#pragma unroll
                            for (int r = 0; r < 16; ++r) z[r] = 0.f;
#pragma unroll
                            for (int s = 0; s < 8; ++s) { const bf16x8 kf = *(LAS const bf16x8*)(Kb + (32 * b + l31) * KPITCH + (16 * s + 8 * hh) * 2);
                                z = __builtin_amdgcn_mfma_f32_32x32x16_bf16(kf, qf[s], z, 0, 0, 0); }
                            float sp[16];
                            const int lim = qi - k0 - 32 * b - 4 * hh;
#pragma unroll
                            for (int r = 0; r < 16; ++r) { const float zz = z[r];
                                const float v = fmaxf(zz, 0.f) + __builtin_amdgcn_logf(1.0f + __builtin_amdgcn_exp2f(-fabsf(zz))); sp[r] = (((r & 3) + 8 * (r >> 2)) < lim) ? v : 0.f; }
                            float Gs[4], Gp[4], Tt[4];
#pragma unroll
                            for (int i = 0; i < 4; ++i) { Gs[i] = (sp[4 * i] + sp[4 * i + 1]) + (sp[4 * i + 2] + sp[4 * i + 3]); Gp[i] = __shfl_xor(Gs[i], 32); Tt[i] = Gs[i] + Gp[i]; }
                            float X[4]; X[3] = 0.f; X[2] = Tt[3]; X[1] = X[2] + Tt[2]; X[0] = X[1] + Tt[1];
                            unsigned wp[8];
#pragma unroll
                            for (int i = 0; i < 4; ++i) {
                                const float newer = carry + X[i] + (hh == 0 ? Gp[i] : 0.f);
                                const float t3 = newer + sp[4 * i + 3], t2 = t3 + sp[4 * i + 2], t1 = t2 + sp[4 * i + 1], t0 = t1 + sp[4 * i];
                                const float tl[4] = {t0, t1, t2, t3}; float w[4];
#pragma unroll
                                for (int j = 0; j < 4; ++j) { const float e = __builtin_amdgcn_exp2f(z[4 * i + j] - tl[j]); w[j] = ((j + 8 * i) < lim) ? e : 0.f; }
                                wp[2 * i] = pk2(w[0], w[1]); wp[2 * i + 1] = pk2(w[2], w[3]);
                            }
                            carry += X[0] + Tt[0];
                            wf[b][0] = __builtin_bit_cast(bf16x8, (v4u){wp[0], wp[1], wp[2], wp[3]}); wf[b][1] = __builtin_bit_cast(bf16x8, (v4u){wp[4], wp[5], wp[6], wp[7]});
                        }
#pragma unroll
                        for (int b = 0; b < 2; ++b)
#pragma unroll
                            for (int s = 0; s < 2; ++s)
#pragma unroll
                                for (int c = 0; c < 4; ++c) { LAS const unsigned char* vpz = Vb + (32 * c + l31) * VPITCH + (32 * b + 16 * s + 4 * hh) * 2;
                                    const v2u va = *(LAS const v2u*)vpz, vb2 = *(LAS const v2u*)(vpz + 16);
                                    const bf16x8 vf = __builtin_bit_cast(bf16x8, (v4u){va.x, va.y, vb2.x, vb2.y});
                                    o[c] = __builtin_amdgcn_mfma_f32_32x32x16_bf16(vf, wf[b][s], o[c], 0, 0, 0); }
                        mydone = __all(carry > thr);
                    }
                    if (more) SB_STORE(cur ^ 1);
                    if (lane == 0) *(LAS unsigned*)(lds + FLAGOFF + ((it & 1) * 8 + wave) * 4) = mydone ? 1u : 0u;
                    __syncthreads();
                    if (!more) break;
                    { const v4u f0 = *(LAS const v4u*)(lds + FLAGOFF + (it & 1) * 32), f1 = *(LAS const v4u*)(lds + FLAGOFF + (it & 1) * 32 + 16);
                      if ((f0.x & f0.y & f0.z & f0.w & f1.x & f1.y & f1.z & f1.w) != 0u) break; }
                    --kt; cur ^= 1; ++it;
                }
#undef SB_LOAD
#undef SB_STORE
                bf16* op = OCAT + (size_t)qi * 4096 + head * 128 + 4 * hh;
#pragma unroll
                for (int c = 0; c < 4; ++c)
#pragma unroll
                    for (int i = 0; i < 4; ++i) *(GAS v2u*)(op + 32 * c + 8 * i) = (v2u){pk2(o[c][4 * i], o[c][4 * i + 1]), pk2(o[c][4 * i + 2], o[c][4 * i + 3])};
                __syncthreads();
            }
            if (bx >= NSCAN) { int nt4 = 4; asm volatile("" : "+s"(nt4)); pg8::SchedHeads S; S.G = GA; S.c = ca; S.nunits = 128; S.nt = nt4; S.A0 = (const char*)PM; S.B0 = (const char*)MVT; S.sA = 256 * 1024 * 2; S.hA = 512; S.hB = 256 * 1024 * 2;
              pg8::EpiBf16 E{OCAT, 4096, 3072, 256};
              pg8::gemm_phase(lds, 1024, 1024, S, E); }
        }
        if (BOTH(4)) GRID_BAR();
    }

    if (IN(6)) {
        PHASE_IDS();
        {
            const float* lng = args.in[I_RWLNG]; const float* lnb = args.in[I_RWLNB];
            const int l31 = lane & 31, lh = lane >> 5, sub = wave >> 2, mt = (wave >> 1) & 1, nt = wave & 1;
            LAS float* xch = (LAS float*)lds;
            for (int it0 = 2 * bx; it0 < 24 * 128; it0 += 2 * G) {
                const int item = it0 + sub, head = item >> 7, chunk = item & 127;
                const int tq = 32 * nt + l31; const size_t trow = (size_t)(chunk * 64 + tq);
                const float* ap = S0ALL + ((size_t)item * 64 + 32 * mt + l31) * 64 + 8 * lh;
                const float* bp = PHIT + ((size_t)item * 64 + tq) * 64 + 8 * lh;
                f32x4 af[4][2], bfv[4][2];
#pragma unroll
                for (int ks = 0; ks < 4; ++ks) { af[ks][0] = *(const GAS f32x4*)(ap + 16 * ks); af[ks][1] = *(const GAS f32x4*)(ap + 16 * ks + 4); bfv[ks][0] = *(const GAS f32x4*)(bp + 16 * ks); bfv[ks][1] = *(const GAS f32x4*)(bp + 16 * ks + 4); }
                f32x4 yl[4], vv4[4]; v2u gg[4];
                { const int vc = head * 64 + 32 * mt + 4 * lh; const float* yp = Y + trow * 1536 + vc; const bf16* gp = GB + trow * 1536 + vc;
                  const bf16* pc = P + trow * NINP + PRW + 3072 + vc; const float* mxp = args.in[I_RWMIX] + 3072 + vc;
#pragma unroll
                  for (int i = 0; i < 4; ++i) { yl[i] = *(const GAS f32x4*)(yp + 8 * i); gg[i] = *(const GAS v2u*)(gp + 8 * i);
                      const v2u c2 = *(const GAS v2u*)(pc + 8 * i); v2u p2 = (v2u){0u, 0u}; if (trow > 0) p2 = *(const GAS v2u*)(pc - NINP + 8 * i); const f32x4 mx = *(const GAS f32x4*)(mxp + 8 * i);
                      const float cv4[4] = {bflo(c2.x), bfhi(c2.x), bflo(c2.y), bfhi(c2.y)}, pv4[4] = {bflo(p2.x), bfhi(p2.x), bflo(p2.y), bfhi(p2.y)};
#pragma unroll
                      for (int e = 0; e < 4; ++e) vv4[i][e] = cv4[e] + (pv4[e] - cv4[e]) * mx[e]; } }
                const float bon = BONUS[trow * 24 + head];
                f32x16 acc;
#pragma unroll
                for (int r = 0; r < 16; ++r) acc[r] = 0.f;
#pragma unroll
                for (int ks = 0; ks < 4; ++ks) {
                    const v4u au = (v4u){pk2(af[ks][0].x, af[ks][0].y), pk2(af[ks][0].z, af[ks][0].w), pk2(af[ks][1].x, af[ks][1].y), pk2(af[ks][1].z, af[ks][1].w)};
                    const v4u bu = (v4u){pk2(bfv[ks][0].x, bfv[ks][0].y), pk2(bfv[ks][0].z, bfv[ks][0].w), pk2(bfv[ks][1].x, bfv[ks][1].y), pk2(bfv[ks][1].z, bfv[ks][1].w)};
                    acc = __builtin_amdgcn_mfma_f32_32x32x16_bf16(__builtin_bit_cast(bf16x8, au), __builtin_bit_cast(bf16x8, bu), acc, 0, 0, 0); }
                float yv[16]; float s1 = 0.f, s2 = 0.f;
#pragma unroll
                for (int i = 0; i < 4; ++i)
#pragma unroll
                    for (int e = 0; e < 4; ++e) { const float y = acc[4 * i + e] + yl[i][e]; yv[4 * i + e] = y; s1 += y; s2 += y * y; }
                s1 += __shfl_xor(s1, 32); s2 += __shfl_xor(s2, 32);
                if (lh == 0) { xch[((sub * 2 + mt) * 64 + tq) * 2] = s1; xch[((sub * 2 + mt) * 64 + tq) * 2 + 1] = s2; }
                __syncthreads();
                { const float o1 = xch[((sub * 2 + (mt ^ 1)) * 64 + tq) * 2], o2 = xch[((sub * 2 + (mt ^ 1)) * 64 + tq) * 2 + 1]; s1 += o1; s2 += o2; }
                const float mu = s1 * (1.f / 64.f), var = fmaxf(s2 * (1.f / 64.f) - mu * mu, 0.f), rstd = 1.0f / sqrtf(var + GN_EPS);
                bf16* op = OCAT + trow * 4096 + 1536 + head * 64 + 32 * mt + 4 * lh;
#pragma unroll
                for (int i = 0; i < 4; ++i) { const int vb = head * 64 + 32 * mt + 8 * i + 4 * lh; const f32x4 gv = *(const GAS f32x4*)(lng + vb), bv = *(const GAS f32x4*)(lnb + vb);
                    const float g4[4] = {bflo(gg[i].x), bfhi(gg[i].x), bflo(gg[i].y), bfhi(gg[i].y)}; float o[4];
#pragma unroll
                    for (int e = 0; e < 4; ++e) o[e] = ((yv[4 * i + e] - mu) * rstd * gv[e] + bv[e] + bon * vv4[i][e]) * g4[e];
                    *(GAS v2u*)(op + 8 * i) = (v2u){pk2(o[0], o[1]), pk2(o[2], o[3])}; }
                __syncthreads();
            }
        }
        {
            LAS float* scr = (LAS float*)(lds + wave * 16384);
            for (int qi = gw; qi < Q2_ITEMS; qi += NGW) Q2_BODY;
        }
        if (BOTH(6)) GRID_BAR();
    }

    if (IN(7)) {
        PHASE_IDS();
        pg8::SchedMerge S; S.to.init(32, 16); S.G = G; S.c = bx; S.OC = (const char*)OCAT; S.WC = (const char*)WCAT_T;
        pg8::EpiMerge E{P, MERGED};
        pg8::gemm_phase(lds, 4096, 4096, S, E);
        if (BOTH(7)) GRID_BAR();
    }

    if (IN(8)) {
        PHASE_IDS();
        pg8::SchedPlain S; S.to.init(32, 16); S.G = G; S.c = bx; S.nt = 64; S.A0 = (const char*)MERGED; S.B0 = (const char*)WOUT_T; S.sA = (size_t)256 * 4096 * 2; S.sB = (size_t)256 * 4096 * 2;
        pg8::EpiResF32 E{args.in[I_X], H1};
        pg8::gemm_phase(lds, 4096, 4096, S, E);
        if (BOTH(8)) GRID_BAR();
    }

    if (IN(9)) {
        PHASE_IDS();
        rms_rows4096(H1, args.in[I_FFNG], XN, gw, NGW, T, lane);
        if (BOTH(9)) GRID_BAR();
    }

    if (IN(10)) {
        PHASE_IDS();
        pg8::SchedPlain S; S.to.init(32, 86); S.G = G; S.c = bx; S.nt = 64; S.A0 = (const char*)XN; S.B0 = (const char*)WGU_T; S.sA = (size_t)256 * 4096 * 2; S.sB = (size_t)256 * 4096 * 2;
        pg8::EpiSwiGLU E{ACT};
        pg8::gemm_phase(lds, 4096, 4096, S, E);
        if (BOTH(10)) GRID_BAR();
    }

    if (IN(11)) {
        PHASE_IDS();
        pg8::SchedPlain S; S.to.init(32, 16); S.G = G; S.c = bx; S.nt = 172; S.A0 = (const char*)ACT; S.B0 = (const char*)WD_T; S.sA = (size_t)256 * DFF * 2; S.sB = (size_t)256 * DFF * 2;
        pg8::EpiResF32 E{H1, args.out};
        pg8::gemm_phase(lds, DFF, DFF, S, E);
    }
#undef IN
#undef BOTH
}

extern "C" void kernel_launch(void* const* d_in, const int* in_sizes, int n_in, void* d_out, int out_size, void* d_ws, size_t ws_size, hipStream_t stream) {
    static int grid = 0;
    if (grid == 0) {
        if (n_in != 29 || in_sizes[0] != T * D || out_size != T * D || ws_size < WS_END) {
            fprintf(stderr, "kernel_launch: unexpected problem (n_in %d, in0 %d, out %d, ws %zu, need %zu); nothing launched\n", n_in, n_in > 0 ? in_sizes[0] : -1, out_size, ws_size, (size_t)WS_END); grid = -1; return; }
        int dev = 0, cus = 0, per_cu = 0;
        if (hipGetDevice(&dev) != hipSuccess || hipDeviceGetAttribute(&cus, hipDeviceAttributeMultiprocessorCount, dev) != hipSuccess) { grid = -1; return; }
        if (hipFuncSetAttribute((const void*)hybrid_fwd, hipFuncAttributeMaxDynamicSharedMemorySize, LDS_BYTES) != hipSuccess) { fprintf(stderr, "kernel_launch: hipFuncSetAttribute failed\n"); grid = -1; return; }
        if (hipOccupancyMaxActiveBlocksPerMultiprocessor(&per_cu, (const void*)hybrid_fwd, NWAVES * 64, LDS_BYTES) != hipSuccess || per_cu < 1)
            fprintf(stderr, "kernel_launch: note: occupancy query reports %d workgroups per CU\n", per_cu);
        (void)hipGetLastError();
        grid = cus;
    }
    if (grid < 0) return;
    if (hipMemsetAsync((char*)d_ws + WS_CTL, 0, CTL_ZERO_BYTES, stream) != hipSuccess) return;
    Args a{};
    for (int i = 0; i < 29; ++i) a.in[i] = (const float*)d_in[i];
    a.out = (float*)d_out; a.ws = (unsigned char*)d_ws;
#if MK_PER_PHASE
    for (int p = 0; p < NPHASES; ++p) { a.ph_lo = p; a.ph_hi = p + 1; hipLaunchKernelGGL(hybrid_fwd, dim3(grid), dim3(NWAVES * 64), LDS_BYTES, stream, a); }
#else
    a.ph_lo = 0; a.ph_hi = NPHASES;
    hipLaunchKernelGGL(hybrid_fwd, dim3(grid), dim3(NWAVES * 64), LDS_BYTES, stream, a);
#endif
}
```

```cpp
#include <hip/hip_runtime.h>
#include <cstdio>
#include <cstdint>

#ifndef MK_PER_PHASE
#define MK_PER_PHASE 0
#endif

constexpr int T = 8192, D = 4096, NMEM = 256;
constexpr int SBW = 1536, RWW = 1536, MEMW = 1024, RWSEG = 5344, DFF = 11008;
constexpr int NIN_ORIG = 23264, NINP = 23296;
constexpr int PQ = 0, PK = 1536, PV = 3072, PRW = 4608, PMQ = 9984, PG = 11008;
constexpr float RMS_EPS = 1e-6f, GN_EPS = 64e-5f;

constexpr size_t MiB = 1u << 20;
constexpr size_t WS_CTL = 0, CTL_ZERO_BYTES = 256 * 1024;
constexpr size_t WS_WIN_T = 1 * MiB;
constexpr size_t WS_WCAT_T = WS_WIN_T + 182 * MiB;
constexpr size_t WS_WOUT_T = WS_WCAT_T + 32 * MiB;
constexpr size_t WS_WKV_T = WS_WOUT_T + 32 * MiB;
constexpr size_t WS_LBWA = WS_WKV_T + 16 * MiB;
constexpr size_t WS_LBG = WS_LBWA + 2 * MiB;
constexpr size_t WS_XN = WS_LBG + 2 * MiB;
constexpr size_t WS_MEMN = WS_XN + 64 * MiB;
constexpr size_t WS_P = WS_MEMN + 2 * MiB;
constexpr size_t WS_R = WS_P + 364 * MiB;
constexpr size_t RSZ = 48 * MiB;
constexpr size_t WS_G = WS_R + 6 * RSZ;
constexpr size_t WS_Y = WS_G + 24 * MiB;
constexpr size_t WS_OCAT = WS_Y + 48 * MiB;
constexpr size_t WS_LATE = WS_OCAT + 64 * MiB;
constexpr size_t WS_QN = WS_LATE;
constexpr size_t WS_KN = WS_QN + 24 * MiB;
constexpr size_t WS_VT = WS_KN + 24 * MiB;
constexpr size_t WS_MQN = WS_VT + 24 * MiB;
constexpr size_t WS_MKRAW = WS_MQN + 16 * MiB;
constexpr size_t WS_MKN = WS_MKRAW + 1 * MiB;
constexpr size_t WS_MVT = WS_MKN + 1 * MiB;
constexpr size_t WS_SM = WS_MVT + 2 * MiB;
constexpr size_t WS_PM = WS_SM + 32 * MiB;
constexpr size_t WS_LA1 = WS_PM + 16 * MiB;
constexpr size_t WS_LA2 = WS_LA1 + 4 * MiB;
constexpr size_t WS_EARLY_END = WS_LA2 + 8 * MiB;
constexpr size_t WS_PHIT = WS_EARLY_END;
constexpr size_t WS_PCT = WS_PHIT + 48 * MiB;
constexpr size_t WS_SLOCT = WS_PCT + 48 * MiB;
constexpr size_t WS_BONUS = WS_SLOCT + 48 * MiB;
constexpr size_t WS_RWKV_END = WS_BONUS + 1 * MiB;
constexpr size_t WS_WGU_T = WS_WIN_T;
constexpr size_t WS_WD_T = WS_R + 2 * RSZ;
constexpr size_t WS_END = WS_RWKV_END;
constexpr size_t WS_MERGED = WS_R;
constexpr size_t WS_H1 = WS_LATE;
constexpr size_t WS_ACT = WS_P;
static_assert(WS_H1 + 128 * MiB <= WS_EARLY_END && WS_WD_T + 86 * MiB <= WS_R + 4 * RSZ, "H1 / W_down copy homes");
static_assert(WS_END <= 1454ull * MiB, "workspace map exceeds the guaranteed 4x largest tensor");

constexpr int CW_TMO = 0, CW_CODE = 1, CW_BAR = 4096, CW_Q1 = 32768, CW_Q2 = 32768 + 64;

constexpr int RING_BYTES = 131072, LDSCTL_OFF = 159744, MISC_OFF = LDSCTL_OFF + 320, LDS_BYTES = 163840;
constexpr int NWAVES = 8;

#define GAS __attribute__((address_space(1)))
#define LAS __attribute__((address_space(3)))
typedef unsigned short bf16;
typedef unsigned v4u __attribute__((ext_vector_type(4)));
typedef unsigned v2u __attribute__((ext_vector_type(2)));
typedef float f32x4 __attribute__((ext_vector_type(4)));
typedef float f32x2 __attribute__((ext_vector_type(2)));
typedef float f32x16 __attribute__((ext_vector_type(16)));
typedef short bf16x8 __attribute__((ext_vector_type(8)));
typedef short s16x4 __attribute__((ext_vector_type(4)));
typedef GAS unsigned gu32;

__device__ __forceinline__ unsigned f2bf(float f) { unsigned u = __builtin_bit_cast(unsigned, f); return (u + 0x7fffu + ((u >> 16) & 1u)) >> 16; }
__device__ __forceinline__ unsigned pk2(float lo, float hi) { return f2bf(lo) | (f2bf(hi) << 16); }
__device__ __forceinline__ float bflo(unsigned w) { return __builtin_bit_cast(float, w << 16); }
__device__ __forceinline__ float bfhi(unsigned w) { return __builtin_bit_cast(float, w & 0xffff0000u); }
__device__ __forceinline__ float fexp(float x) { return __builtin_amdgcn_exp2f(x * 1.44269504088896f); }
__device__ __forceinline__ float flog(float x) { return __builtin_amdgcn_logf(x) * 0.693147180559945f; }
__device__ __forceinline__ float frcp(float x) { return __builtin_amdgcn_rcpf(x); }
__device__ __forceinline__ float sigmoidf_(float x) { return frcp(1.0f + fexp(-x)); }
__device__ __forceinline__ float softplusf_(float x) { return fmaxf(x, 0.f) + flog(1.0f + fexp(-fabsf(x))); }
__device__ __forceinline__ float wave_sum(float v) {
#pragma unroll
    for (int o = 1; o < 64; o <<= 1) v += __shfl_xor(v, o);
    return v;
}
__device__ __forceinline__ float dpp_f(float x, const int ctrl_sel) {
    return x;
}
#define DPP_ADD(x, ctrl) ((x) + __builtin_bit_cast(float, __builtin_amdgcn_update_dpp(0, __builtin_bit_cast(int, (x)), (ctrl), 0xF, 0xF, true)))
#define DPP_MAX(x, ctrl) fmaxf((x), __builtin_bit_cast(float, __builtin_amdgcn_update_dpp(0, __builtin_bit_cast(int, (x)), (ctrl), 0xF, 0xF, true)))
__device__ __forceinline__ float quad_bcast(float x, int g) {
    const int xi = __builtin_bit_cast(int, x);
    switch (g) {
        case 0: return __builtin_bit_cast(float, __builtin_amdgcn_update_dpp(0, xi, 0x00, 0xF, 0xF, true));
        case 1: return __builtin_bit_cast(float, __builtin_amdgcn_update_dpp(0, xi, 0x55, 0xF, 0xF, true));
        case 2: return __builtin_bit_cast(float, __builtin_amdgcn_update_dpp(0, xi, 0xAA, 0xF, 0xF, true));
        default: return __builtin_bit_cast(float, __builtin_amdgcn_update_dpp(0, xi, 0xFF, 0xF, 0xF, true));
    }
}
__device__ __forceinline__ float red16_sum(float x) {
    x = DPP_ADD(x, 0xB1); x = DPP_ADD(x, 0x4E); x = DPP_ADD(x, 0x141); x = DPP_ADD(x, 0x140); return x;
}
__device__ __forceinline__ float wave_sum_u(float x) {
    x = red16_sum(x);
    x += __builtin_bit_cast(float, __builtin_amdgcn_update_dpp(0, __builtin_bit_cast(int, x), 0x142, 0xA, 0xF, false));
    x += __builtin_bit_cast(float, __builtin_amdgcn_update_dpp(0, __builtin_bit_cast(int, x), 0x143, 0xC, 0xF, false));
    return __builtin_bit_cast(float, __builtin_amdgcn_readlane(__builtin_bit_cast(int, x), 63));
}
__device__ __forceinline__ float red16_max(float x) {
    x = DPP_MAX(x, 0xB1); x = DPP_MAX(x, 0x4E); x = DPP_MAX(x, 0x141); x = DPP_MAX(x, 0x140); return x;
}

namespace pg8 {
#define PG8_LAS __attribute__((address_space(3)))
typedef unsigned short bf16_t;
typedef unsigned u32x4 __attribute__((ext_vector_type(4)));
constexpr int BM = 256, BK = 64, HALF = 128, HTB = HALF * BK * 2, STAGE_BYTES = 8 * HTB, NXCD = 8, WGM = 4;

__host__ __device__ __forceinline__ int lds_byte(int r, int c) { const int st = (r >> 4) * 2 + (c >> 5), rr = r & 15, cc = c & 31, ob = rr * 64 + cc * 2; return st * 1024 + (ob ^ (((ob >> 9) & 1) << 5)); }
__host__ __device__ __forceinline__ void stage_rc(int b, int& R, int& C) { const int st = b / 1024, sb = b % 1024, swz = sb ^ (((sb >> 9) & 1) << 5); R = (st >> 1) * 16 + swz / 64; C = (st & 1) * 32 + (swz % 64) / 2; }
__host__ __device__ __forceinline__ int perm32(int rho) { const int n = rho >> 4, i = rho & 15; return 8 * (i >> 2) + 4 * n + (i & 3); }

struct Unit { const char* A; const char* B; int nt, pm, pn, kind; };

struct TileOrder {
    int nM, nN, nwg;
    __device__ __forceinline__ void init(int nM_, int nN_) { nM = nM_; nN = nN_; nwg = nM_ * nN_; }
    __device__ __forceinline__ void map(int L, int& pm, int& pn) const {
        int wgid = L; { const int q = nwg / NXCD, r = nwg % NXCD, xcd = wgid % NXCD, off = wgid / NXCD; wgid = (xcd < r ? xcd * (q + 1) : r * (q + 1) + (xcd - r) * q) + off; }
        const int nig = WGM * nN, gid = wgid / nig, fm = gid * WGM, gsz = (nM - fm) < WGM ? (nM - fm) : WGM;
        pm = fm + ((wgid % nig) % gsz); pn = (wgid % nig) / gsz;
    }
};

__device__ __forceinline__ unsigned cvt_pk_bf16(float lo, float hi) { unsigned r; asm volatile("v_cvt_pk_bf16_f32 %0, %1, %2" : "=v"(r) : "v"(lo), "v"(hi)); return r; }

template <class Epi, class Sched>
__device__ __forceinline__ void gemm_phase(PG8_LAS unsigned char* lds, const int lda, const int ldb, const Sched& S, const Epi& E) {
    const int tid = threadIdx.x, wid = __builtin_amdgcn_readfirstlane(tid >> 6), lane = tid & 63, wr = wid >> 2, wc = wid & 3, fr = lane & 15, fq = lane >> 4;
    unsigned voffA[2], voffB[2];
#pragma unroll
    for (int i = 0; i < 2; ++i) { int R, C; stage_rc(tid * 16 + i * 8192, R, C); const int Rb = Epi::PERM ? ((R & ~31) + perm32(R & 31)) : R;
        voffA[i] = (unsigned)(R * lda + C) * 2u; voffB[i] = (unsigned)(Rb * ldb + C) * 2u; }
    const size_t kstep = (size_t)(BK * 2);
    const size_t hstepA = (size_t)HALF * lda * 2, hstepB = (size_t)HALF * ldb * 2;
    const unsigned ldsw = (unsigned)wid * 1024u;
    const int aoff = lds_byte(wr * 64 + fr, fq * 8), boff = lds_byte(wc * 32 + fr, fq * 8);
#define PG8_SA(b, h) (((b) * 2 + (h)) * HTB)
#define PG8_SB(b, h) ((4 + (b) * 2 + (h)) * HTB)
#define PG8_STAGE(bufoff, gbase, voff) do { _Pragma("unroll") for (int _i = 0; _i < 2; ++_i) \
        __builtin_amdgcn_global_load_lds((const unsigned*)((const char*)(gbase) + (voff)[_i]), (PG8_LAS unsigned*)(lds + (bufoff) + ldsw + _i * 8192), 16, 0, 0); } while (0)
#define PG8_LDA(dst, b, h) do { _Pragma("unroll") for (int m = 0; m < 4; ++m) _Pragma("unroll") for (int k = 0; k < 2; ++k) dst[m][k] = *(const PG8_LAS bf16x8*)(lds + PG8_SA(b, h) + aoff + m * 2048 + k * 1024); } while (0)
#define PG8_LDB(dst, b, h) do { _Pragma("unroll") for (int n = 0; n < 2; ++n) _Pragma("unroll") for (int k = 0; k < 2; ++k) dst[n][k] = *(const PG8_LAS bf16x8*)(lds + PG8_SB(b, h) + boff + n * 2048 + k * 1024); } while (0)
#define PG8_MMA(ai, bj, At, Bt) do { __builtin_amdgcn_s_setprio(1); _Pragma("unroll") for (int m = 0; m < 4; ++m) _Pragma("unroll") for (int n = 0; n < 2; ++n) _Pragma("unroll") for (int k = 0; k < 2; ++k) \
        acc[ai][bj][m][n] = __builtin_amdgcn_mfma_f32_16x16x32_bf16(Bt[n][k], At[m][k], acc[ai][bj][m][n], 0, 0, 0); __builtin_amdgcn_s_setprio(0); } while (0)
#define PG8_WAIT_V(n) asm volatile("s_waitcnt vmcnt(" #n ")" ::: "memory")
#define PG8_WAIT_L(n) asm volatile("s_waitcnt lgkmcnt(" #n ")" ::: "memory")
#define PG8_BAR __builtin_amdgcn_s_barrier()
#define PG8_SCHED __builtin_amdgcn_sched_barrier(0)
    Unit cur, nxt; int ui = 0;
    if (!S.next(0, cur)) return;
    f32x4 acc[2][2][4][2];
#pragma unroll
    for (int a = 0; a < 2; ++a)
#pragma unroll
        for (int b = 0; b < 2; ++b)
#pragma unroll
            for (int m = 0; m < 4; ++m)
#pragma unroll
                for (int n = 0; n < 2; ++n) acc[a][b][m][n] = (f32x4){0.f, 0.f, 0.f, 0.f};
    bf16x8 At[4][2], B0[2][2], B1[2][2];
    const char* cA = cur.A; const char* cB = cur.B; int nt = cur.nt;
    PG8_STAGE(PG8_SB(0, 0), cB, voffB); PG8_STAGE(PG8_SB(0, 1), cB + hstepB, voffB); PG8_STAGE(PG8_SA(0, 0), cA, voffA); PG8_STAGE(PG8_SA(0, 1), cA + hstepA, voffA);
    if (wr == 1) PG8_BAR;
    PG8_WAIT_V(2); PG8_BAR;
    PG8_STAGE(PG8_SB(1, 0), cB + kstep, voffB); PG8_STAGE(PG8_SA(1, 0), cA + kstep, voffA); PG8_STAGE(PG8_SB(1, 1), cB + hstepB + kstep, voffB);
    PG8_WAIT_V(6); PG8_BAR;
    for (;;) {
        const bool has_next = S.next(ui + 1, nxt);
        const char* nA = has_next ? nxt.A : cA; const char* nB = has_next ? nxt.B : cB;
        for (int t = 0; t < nt; t += 2) {
            const bool last = (t == nt - 2);
            const char* a1 = cA + (size_t)(t + 1) * kstep;
            const char* a2 = last ? nA : cA + (size_t)(t + 2) * kstep; const char* b2 = last ? nB : cB + (size_t)(t + 2) * kstep;
            const char* a3 = a2 + kstep; const char* b3 = b2 + kstep;
            PG8_LDB(B0, 0, 0); PG8_LDB(B1, 0, 1); PG8_SCHED; PG8_LDA(At, 0, 0); PG8_STAGE(PG8_SA(1, 1), a1 + hstepA, voffA);
            PG8_WAIT_V(8); PG8_WAIT_L(0); PG8_BAR; PG8_MMA(0, 0, At, B0); PG8_MMA(0, 1, At, B1); PG8_BAR; PG8_SCHED;
            PG8_LDA(At, 0, 1); PG8_STAGE(PG8_SB(0, 0), b2, voffB); PG8_STAGE(PG8_SB(0, 1), b2 + hstepB, voffB); PG8_STAGE(PG8_SA(0, 0), a2, voffA);
            PG8_WAIT_V(8); PG8_WAIT_L(0); PG8_BAR; PG8_MMA(1, 0, At, B0); PG8_MMA(1, 1, At, B1); PG8_BAR; PG8_SCHED;
            PG8_LDB(B0, 1, 0); PG8_LDB(B1, 1, 1); PG8_SCHED; PG8_LDA(At, 1, 0); PG8_STAGE(PG8_SA(0, 1), a2 + hstepA, voffA);
            PG8_WAIT_V(8); PG8_WAIT_L(0); PG8_BAR; PG8_MMA(0, 0, At, B0); PG8_MMA(0, 1, At, B1); PG8_BAR; PG8_SCHED;
            PG8_LDA(At, 1, 1); PG8_STAGE(PG8_SB(1, 0), b3, voffB); PG8_STAGE(PG8_SB(1, 1), b3 + hstepB, voffB); PG8_STAGE(PG8_SA(1, 0), a3, voffA);
            PG8_WAIT_V(8); PG8_WAIT_L(0); PG8_BAR; PG8_MMA(1, 0, At, B0); PG8_MMA(1, 1, At, B1); PG8_BAR; PG8_SCHED;
        }
        if (wr == 0) PG8_BAR;
        const bool keep = E(acc, cur, wr, wc, fr, fq);
        if (!has_next) break;
        if (!keep) {
#pragma unroll
            for (int a = 0; a < 2; ++a)
#pragma unroll
                for (int b = 0; b < 2; ++b)
#pragma unroll
                    for (int m = 0; m < 4; ++m)
#pragma unroll
                        for (int n = 0; n < 2; ++n) acc[a][b][m][n] = (f32x4){0.f, 0.f, 0.f, 0.f};
        }
        cur = nxt; cA = nA; cB = nB; nt = cur.nt; ++ui;
        if (wr == 1) PG8_BAR;
    }
    PG8_WAIT_V(0);
    PG8_BAR;
#undef PG8_SA
#undef PG8_SB
#undef PG8_STAGE
#undef PG8_LDA
#undef PG8_LDB
#undef PG8_MMA
#undef PG8_WAIT_V
#undef PG8_WAIT_L
#undef PG8_BAR
#undef PG8_SCHED
}

struct SchedPlain {
    TileOrder to; int G, c, nt; const char* A0; const char* B0; size_t sA, sB;
    __device__ __forceinline__ bool next(int i, Unit& u) const {
        const int L = i * G + c; if (L >= to.nwg) return false;
        int pm, pn; to.map(L, pm, pn); u.A = A0 + (size_t)pm * sA; u.B = B0 + (size_t)pn * sB; u.nt = nt; u.pm = pm; u.pn = pn; u.kind = 0; return true;
    }
};
struct SchedGemm1 {
    TileOrder to; int G, c; const char *XN, *WIN, *MEMN, *WKV;
    __device__ __forceinline__ bool next(int i, Unit& u) const {
        const int L = i * G + c; u.nt = 64;
        if (L < to.nwg) { int pm, pn; to.map(L, pm, pn); u.A = XN + (size_t)pm * 256 * 4096 * 2; u.B = WIN + (size_t)pn * 256 * 4096 * 2; u.pm = pm; u.pn = pn; u.kind = 0; return true; }
        const int e = L - to.nwg; if (e >= 8) return false;
        if (e < 4) { u.A = MEMN; u.B = WKV + (size_t)e * 256 * 4096 * 2; u.pm = 0; u.pn = e; u.kind = 1; }
        else { u.A = WKV + (size_t)(1024 + 256 * (e - 4)) * 4096 * 2; u.B = MEMN; u.pm = e - 4; u.pn = 0; u.kind = 2; }
        return true;
    }
};
struct SchedHeads {
    int G, c, nunits, nt; const char* A0; const char* B0; size_t sA, hA, hB;
    __device__ __forceinline__ bool next(int i, Unit& u) const {
        const int L = i * G + c; if (L >= nunits) return false;
        const int pm = L & 31, h = L >> 5; u.A = A0 + (size_t)pm * sA + (size_t)h * hA; u.B = B0 + (size_t)h * hB; u.nt = nt; u.pm = pm; u.pn = 0; u.kind = h; return true;
    }
};
struct SchedMerge {
    TileOrder to; int G, c; const char* OC; const char* WC;
    __device__ __forceinline__ bool next(int i, Unit& u) const {
        const int ti = i / 3, b = i - 3 * ti; const int L = ti * G + c; if (L >= to.nwg) return false;
        int pm, pn; to.map(L, pm, pn); const int koff = b * 1536;
        u.A = OC + ((size_t)pm * 256 * 4096 + koff) * 2; u.B = WC + ((size_t)pn * 256 * 4096 + koff) * 2; u.nt = (b < 2) ? 24 : 16; u.pm = pm; u.pn = pn; u.kind = b; return true;
    }
};

struct EpiGemm1 {
    static constexpr bool PERM = true;
    bf16_t *P, *MK, *MVT;
    __device__ __forceinline__ bool operator()(f32x4 (&acc)[2][2][4][2], const Unit& u, int wr, int wc, int fr, int fq) const {
        bf16_t* base; int ldc;
        if (u.kind == 0) { base = P + (size_t)u.pm * 256 * NINP + u.pn * 256; ldc = NINP; }
        else if (u.kind == 1) { base = MK + u.pn * 256; ldc = 1024; }
        else { base = MVT + (size_t)u.pm * 256 * 1024; ldc = 1024; }
        base += (size_t)(wr * 64 + fr) * ldc + wc * 32 + 8 * fq;
#pragma unroll
        for (int ai = 0; ai < 2; ++ai)
#pragma unroll
            for (int m = 0; m < 4; ++m) { bf16_t* rowp = base + (size_t)(ai * HALF + m * 16) * ldc;
#pragma unroll
                for (int bj = 0; bj < 2; ++bj) { const f32x4 v0 = acc[ai][bj][m][0], v1 = acc[ai][bj][m][1];
                    u32x4 w; w.x = cvt_pk_bf16(v0[0], v0[1]); w.y = cvt_pk_bf16(v0[2], v0[3]); w.z = cvt_pk_bf16(v1[0], v1[1]); w.w = cvt_pk_bf16(v1[2], v1[3]);
                    *(u32x4*)(rowp + bj * HALF) = w; } }
        return false;
    }
};
struct EpiBf16 {
    static constexpr bool PERM = true;
    bf16_t* O; int ldc, coff, kstride;
    __device__ __forceinline__ bool operator()(f32x4 (&acc)[2][2][4][2], const Unit& u, int wr, int wc, int fr, int fq) const {
        bf16_t* base = O + (size_t)(u.pm * 256 + wr * 64 + fr) * ldc + coff + u.kind * kstride + u.pn * 256 + wc * 32 + 8 * fq;
#pragma unroll
        for (int ai = 0; ai < 2; ++ai)
#pragma unroll
            for (int m = 0; m < 4; ++m) { bf16_t* rowp = base + (size_t)(ai * HALF + m * 16) * ldc;
#pragma unroll
                for (int bj = 0; bj < 2; ++bj) { const f32x4 v0 = acc[ai][bj][m][0], v1 = acc[ai][bj][m][1];
                    u32x4 w; w.x = cvt_pk_bf16(v0[0], v0[1]); w.y = cvt_pk_bf16(v0[2], v0[3]); w.z = cvt_pk_bf16(v1[0], v1[1]); w.w = cvt_pk_bf16(v1[2], v1[3]);
                    *(u32x4*)(rowp + bj * HALF) = w; } }
        return false;
    }
};
struct EpiScoreF32 {
    static constexpr bool PERM = false;
    float* S;
    __device__ __forceinline__ bool operator()(f32x4 (&acc)[2][2][4][2], const Unit& u, int wr, int wc, int fr, int fq) const {
        float* base = S + (size_t)(u.pm * 256 + wr * 64 + fr) * 1024 + u.kind * 256 + wc * 32 + 4 * fq;
#pragma unroll
        for (int ai = 0; ai < 2; ++ai)
#pragma unroll
            for (int m = 0; m < 4; ++m) { float* rowp = base + (size_t)(ai * HALF + m * 16) * 1024;
#pragma unroll
                for (int bj = 0; bj < 2; ++bj)
#pragma unroll
                    for (int n = 0; n < 2; ++n) *(f32x4*)(rowp + bj * HALF + n * 16) = acc[ai][bj][m][n]; }
        return false;
    }
};
struct EpiLoraWA {
    static constexpr bool PERM = false;
    const float *w0, *a0; float *RW, *RA;
    __device__ __forceinline__ bool operator()(f32x4 (&acc)[2][2][4][2], const Unit& u, int wr, int wc, int fr, int fq) const {
        const bool isw = u.pn < 6; const int cb = (isw ? u.pn : u.pn - 6) * 256 + wc * 32 + 4 * fq;
        const float* bias = (isw ? w0 : a0) + cb; float* base = (isw ? RW : RA) + (size_t)(u.pm * 256 + wr * 64 + fr) * 1536 + cb;
        f32x4 bv[2][2];
#pragma unroll
        for (int bj = 0; bj < 2; ++bj)
#pragma unroll
            for (int n = 0; n < 2; ++n) bv[bj][n] = *(const f32x4*)(bias + bj * HALF + n * 16);
#pragma unroll
        for (int ai = 0; ai < 2; ++ai)
#pragma unroll
            for (int m = 0; m < 4; ++m) { float* rowp = base + (size_t)(ai * HALF + m * 16) * 1536;
#pragma unroll
                for (int bj = 0; bj < 2; ++bj)
#pragma unroll
                    for (int n = 0; n < 2; ++n) { f32x4 x = acc[ai][bj][m][n] + bv[bj][n]; f32x4 o;
#pragma unroll
                        for (int j = 0; j < 4; ++j) { const float sg = sigmoidf_(x[j]); o[j] = isw ? fexp(-0.6065306597126334f * sg) : sg; }
                        *(f32x4*)(rowp + bj * HALF + n * 16) = o; } }
        return false;
    }
};
struct EpiMerge {
    static constexpr bool PERM = true;
    const bf16_t* P; bf16_t* MG;
    __device__ __forceinline__ bool operator()(f32x4 (&acc)[2][2][4][2], const Unit& u, int wr, int wc, int fr, int fq) const {
        const int b = u.kind; const int row0 = u.pm * 256 + wr * 64 + fr, col0 = u.pn * 256 + wc * 32 + 8 * fq;
        const bf16_t* gbase = P + (size_t)row0 * NINP + PG + 4096 * b + col0;
#pragma unroll
        for (int ai = 0; ai < 2; ++ai) {
            u32x4 g0v[4][2], g1v[4][2];
#pragma unroll
            for (int m = 0; m < 4; ++m)
#pragma unroll
                for (int bj = 0; bj < 2; ++bj) { const bf16_t* gp = gbase + (size_t)(ai * HALF + m * 16) * NINP + bj * HALF; g0v[m][bj] = *(const u32x4*)gp; g1v[m][bj] = (b < 2) ? *(const u32x4*)(gp + 4096) : g0v[m][bj]; }
#pragma unroll
            for (int m = 0; m < 4; ++m) { const size_t row = (size_t)(row0 + ai * HALF + m * 16);
#pragma unroll
                for (int bj = 0; bj < 2; ++bj) { const u32x4 g0 = g0v[m][bj];
                    float e0[8]; const unsigned gw0[4] = {g0.x, g0.y, g0.z, g0.w};
#pragma unroll
                    for (int j = 0; j < 4; ++j) { e0[2 * j] = 1.0f + fexp(-bflo(gw0[j])); e0[2 * j + 1] = 1.0f + fexp(-bfhi(gw0[j])); }
                    if (b < 2) { const u32x4 g1 = g1v[m][bj]; const unsigned gw1[4] = {g1.x, g1.y, g1.z, g1.w};
#pragma unroll
                        for (int j = 0; j < 4; ++j) { const float r0 = (1.0f + fexp(-bflo(gw1[j]))) * frcp(e0[2 * j]), r1 = (1.0f + fexp(-bfhi(gw1[j]))) * frcp(e0[2 * j + 1]);
                            acc[ai][bj][m][j >> 1][(2 * j) & 3] *= r0; acc[ai][bj][m][j >> 1][(2 * j + 1) & 3] *= r1; }
                    } else { float v[8];
#pragma unroll
                        for (int j = 0; j < 8; ++j) v[j] = acc[ai][bj][m][j >> 2][j & 3] * frcp(e0[j]);
                        u32x4 w; w.x = cvt_pk_bf16(v[0], v[1]); w.y = cvt_pk_bf16(v[2], v[3]); w.z = cvt_pk_bf16(v[4], v[5]); w.w = cvt_pk_bf16(v[6], v[7]);
                        *(u32x4*)(MG + row * 4096 + col0 + bj * HALF) = w; } } }
            asm volatile("" ::: "memory");
        }
        return b < 2;
    }
};
struct EpiResF32 {
    static constexpr bool PERM = false;
    const float* res; float* out;
    __device__ __forceinline__ bool operator()(f32x4 (&acc)[2][2][4][2], const Unit& u, int wr, int wc, int fr, int fq) const {
        const size_t off0 = (size_t)(u.pm * 256 + wr * 64 + fr) * 4096 + u.pn * 256 + wc * 32 + 4 * fq;
#pragma unroll
        for (int ai = 0; ai < 2; ++ai)
#pragma unroll
            for (int mp = 0; mp < 2; ++mp) { f32x4 rv[2][2][2];
#pragma unroll
                for (int mm = 0; mm < 2; ++mm)
#pragma unroll
                    for (int bj = 0; bj < 2; ++bj)
#pragma unroll
                        for (int n = 0; n < 2; ++n) rv[mm][bj][n] = *(const f32x4*)(res + off0 + (size_t)(ai * HALF + (2 * mp + mm) * 16) * 4096 + bj * HALF + n * 16);
#pragma unroll
                for (int mm = 0; mm < 2; ++mm) { const size_t off = off0 + (size_t)(ai * HALF + (2 * mp + mm) * 16) * 4096;
#pragma unroll
                    for (int bj = 0; bj < 2; ++bj)
#pragma unroll
                        for (int n = 0; n < 2; ++n) *(f32x4*)(out + off + bj * HALF + n * 16) = rv[mm][bj][n] + acc[ai][bj][2 * mp + mm][n]; }
                asm volatile("" ::: "memory"); }
        return false;
    }
};
struct EpiSwiGLU {
    static constexpr bool PERM = true;
    bf16_t* ACT;
    __device__ __forceinline__ bool operator()(f32x4 (&acc)[2][2][4][2], const Unit& u, int wr, int wc, int fr, int fq) const {
        bf16_t* base = ACT + (size_t)(u.pm * 256 + wr * 64 + fr) * DFF + u.pn * 128 + wc * 32 + 8 * fq;
#pragma unroll
        for (int ai = 0; ai < 2; ++ai)
#pragma unroll
            for (int m = 0; m < 4; ++m) { float v[8];
#pragma unroll
                for (int j = 0; j < 8; ++j) { const float g = acc[ai][0][m][j >> 2][j & 3], up = acc[ai][1][m][j >> 2][j & 3]; v[j] = g * sigmoidf_(g) * up; }
                u32x4 w; w.x = cvt_pk_bf16(v[0], v[1]); w.y = cvt_pk_bf16(v[2], v[3]); w.z = cvt_pk_bf16(v[4], v[5]); w.w = cvt_pk_bf16(v[6], v[7]);
                *(u32x4*)(base + (size_t)(ai * HALF + m * 16) * DFF) = w; }
        return false;
    }
};
}

#define XB_TMO      128
#define XB_XCNT(j)  (256  + 64 * (j))
#define XB_XSUB(j)  (1280 + 64 * (j))
#define XB_XGEN(j)  (2304 + 64 * (j))
#define XB_TOP      3328
#define XB_TOPGEN   3392
#define XCD_BAR_WORDS 3456
#define XB_SPIN_CAP (1u << 18)
__device__ __forceinline__ unsigned xb_ld(unsigned* p)              { return __hip_atomic_load(p, __ATOMIC_RELAXED, __HIP_MEMORY_SCOPE_AGENT); }
__device__ __forceinline__ unsigned xb_add(unsigned* p, unsigned v) { return __hip_atomic_fetch_add(p, v, __ATOMIC_RELAXED, __HIP_MEMORY_SCOPE_AGENT); }
__device__ __forceinline__ unsigned xb_xcc_id() { return (unsigned)__builtin_amdgcn_s_getreg((3 << 11) | 20) & 0xFu; }
#define XB_SPIN(cond, bar) do { unsigned _sp = 0; while (cond) { __builtin_amdgcn_s_sleep(1); \
    if ((++_sp & 255u) == 0u) { if (xb_ld(&(bar)[XB_TMO])) break; if (_sp > XB_SPIN_CAP) { atomicAdd(&(bar)[XB_TMO], 1u); break; } } } } while (0)
struct XcdBarrier { unsigned* bar; unsigned x; volatile LAS unsigned* st; };
__device__ __forceinline__ XcdBarrier xcd_barrier_post(unsigned* bar, volatile LAS unsigned* st) {
    XcdBarrier b; b.bar = bar; b.x = xb_xcc_id(); b.st = st;
    if (threadIdx.x == 0) (void)xb_add(&bar[XB_XCNT(b.x)], 1u);
    return b;
}
__device__ __forceinline__ void xcd_barrier_complete(unsigned* bar, unsigned x, unsigned& nloc, unsigned& nx) {
    const unsigned G = gridDim.x * gridDim.y * gridDim.z;
    unsigned sum, cnt, mine, sp = 0u;
    for (;;) {
        sum = 0u; cnt = 0u; mine = 0u;
#pragma unroll
        for (unsigned j = 0; j < 16; ++j) { const unsigned c = xb_ld(&bar[XB_XCNT(j)]); sum += c; cnt += (c > 0u) ? 1u : 0u; mine = (j == x) ? c : mine; }
        if (sum == G) break;
        __builtin_amdgcn_s_sleep(1);
        if ((++sp & 255u) == 0u) { if (xb_ld(&bar[XB_TMO])) break; if (sp > XB_SPIN_CAP) { atomicAdd(&bar[XB_TMO], 1u); break; } }
    }
    nloc = mine > 0u ? mine : 1u; nx = cnt > 0u ? cnt : 1u;
}
__device__ __forceinline__ void xcd_barrier(const XcdBarrier& b) {
    asm volatile("s_waitcnt vmcnt(0)" ::: "memory");
    __syncthreads();
    if (threadIdx.x == 0) {
        unsigned* bar = b.bar;
        __builtin_amdgcn_s_waitcnt(0);
        unsigned nloc = b.st[0], nx = b.st[1];
        if (nloc == 0u) { xcd_barrier_complete(bar, b.x, nloc, nx); b.st[0] = nloc; b.st[1] = nx; }
        const unsigned old = xb_add(&bar[XB_XSUB(b.x)], 1u);
        const unsigned gen = old / nloc;
        if (old + 1u == (gen + 1u) * nloc) {
            __builtin_amdgcn_fence(__ATOMIC_RELEASE, "agent");
            asm volatile("s_waitcnt vmcnt(0)" ::: "memory");
            const unsigned og = xb_add(&bar[XB_TOP], 1u);
            const unsigned tg = og / nx;
            if (og + 1u == (tg + 1u) * nx) xb_add(&bar[XB_TOPGEN], 1u);
            else XB_SPIN(xb_ld(&bar[XB_TOPGEN]) == tg, bar);
            __builtin_amdgcn_fence(__ATOMIC_ACQUIRE, "agent");
            xb_add(&bar[XB_XGEN(b.x)], 1u);
            asm volatile("s_waitcnt vmcnt(0)" ::: "memory");
        } else {
            XB_SPIN(xb_ld(&bar[XB_XGEN(b.x)]) == gen, bar);
            __builtin_amdgcn_fence(__ATOMIC_ACQUIRE, "agent");
            asm volatile("s_waitcnt vmcnt(0)" ::: "memory");
        }
    }
    __syncthreads();
}

struct Args {
    const float* in[29]; float* out; unsigned char* ws; int ph_lo, ph_hi;
};
enum { I_X = 0, I_MEM, I_ATTN_G, I_MEM_G, I_WIN, I_SBQG, I_SBKG, I_RWMIX, I_RWW0, I_RWWUP, I_RWA0, I_RWAUP, I_RWGUP, I_RWKK, I_RWKA, I_RWRK, I_RWLNG, I_RWLNB,
       I_MEMWKV, I_MEMQG, I_MEMKG, I_WSBO, I_WRWO, I_WMEMO, I_WOUT, I_FFNG, I_WGATE, I_WUP, I_WDOWN };

#define LDS_WAIT() asm volatile("s_waitcnt lgkmcnt(0)" ::: "memory")

__device__ __forceinline__ int rowmap(int mode, int n, int roff) {
    if (mode == 1) return n + (n >= 9952 ? 32 : 0);
    if (mode == 2) return (n >> 7) * 256 + (n & 127);
    if (mode == 3) return (n >> 7) * 256 + 128 + (n & 127);
    return n + roff;
}
__device__ __forceinline__ void transpose_item(const float* W, int N, bf16* WT, int ldk, int koff, int mode, int roff, LAS float* scr, int item, int lane) {
    const int nblk = N / 32, kb = item / nblk, nb = item - kb * nblk, k0 = 64 * kb, n0 = 32 * nb;
    { const int rr = lane >> 3, c4 = (lane & 7) * 4; f32x4 wv[8];
#pragma unroll
      for (int i = 0; i < 8; ++i) wv[i] = *(const GAS f32x4*)(W + (size_t)(k0 + 8 * i + rr) * N + n0 + c4);
#pragma unroll
      for (int i = 0; i < 8; ++i) { LAS float* d = scr + (8 * i + rr) * 33 + c4; d[0] = wv[i].x; d[1] = wv[i].y; d[2] = wv[i].z; d[3] = wv[i].w; } }
    LDS_WAIT(); asm volatile("" ::: "memory");
    const int c = lane & 7;
#pragma unroll
    for (int j = 0; j < 4; ++j) { const int n = (lane >> 3) + 8 * j; const LAS float* s = scr + (8 * c) * 33 + n;
        v4u o; o.x = pk2(s[0 * 33], s[1 * 33]); o.y = pk2(s[2 * 33], s[3 * 33]); o.z = pk2(s[4 * 33], s[5 * 33]); o.w = pk2(s[6 * 33], s[7 * 33]);
        *(GAS v4u*)(WT + (size_t)rowmap(mode, n0 + n, roff) * ldk + koff + k0 + 8 * c) = o; }
    LDS_WAIT(); asm volatile("" ::: "memory");
}
__device__ __forceinline__ void rms_rows4096(const float* x, const float* g, bf16* out, int first, int stride, int nrows, int lane) {
    if (first >= nrows) return;
    f32x4 v[16], nv[16];
    { const GAS f32x4* xr = (const GAS f32x4*)(x + (size_t)first * 4096) + lane;
#pragma unroll
      for (int j = 0; j < 16; ++j) v[j] = xr[64 * j]; }
    const GAS f32x4* gr = (const GAS f32x4*)g + lane;
    for (int m = first; m < nrows; m += stride) {
        const bool more = m + stride < nrows;
        if (more) { const GAS f32x4* xr = (const GAS f32x4*)(x + (size_t)(m + stride) * 4096) + lane;
#pragma unroll
            for (int j = 0; j < 16; ++j) nv[j] = xr[64 * j]; }
        float s = 0.f;
#pragma unroll
        for (int j = 0; j < 16; ++j) s += (v[j].x * v[j].x + v[j].y * v[j].y) + (v[j].z * v[j].z + v[j].w * v[j].w);
        const float rstd = 1.0f / sqrtf(wave_sum(s) * (1.f / 4096.f) + RMS_EPS);
        GAS v2u* o8 = (GAS v2u*)(out + (size_t)m * 4096) + lane;
#pragma unroll
        for (int j = 0; j < 16; ++j) { const f32x4 gv = gr[64 * j]; v2u o; o.x = pk2(v[j].x * rstd * gv.x, v[j].y * rstd * gv.y); o.y = pk2(v[j].z * rstd * gv.z, v[j].w * rstd * gv.w); o8[64 * j] = o; }
        if (more) {
#pragma unroll
            for (int j = 0; j < 16; ++j) v[j] = nv[j]; }
    }
}
#define QB 16
#define QUEUE_PULL(headword, nitems, BODY) do { for (;;) { int it_ = 0; if ((threadIdx.x & 63) == 0) it_ = (int)__hip_atomic_fetch_add((unsigned*)(headword), (unsigned)QB, __ATOMIC_RELAXED, __HIP_MEMORY_SCOPE_AGENT); \
        it_ = __builtin_amdgcn_readfirstlane(it_); if (it_ >= (nitems)) break; const int qe_ = (it_ + QB < (nitems)) ? it_ + QB : (nitems); \
        for (int qi = it_; qi < qe_; ++qi) { BODY; } } } while (0)
constexpr int NPHASES = 12;
__global__ void __launch_bounds__(NWAVES * 64, 2) hybrid_fwd(Args args) {
    extern __shared__ __attribute__((aligned(16))) unsigned char lds_raw[];
    LAS unsigned char* lds = (LAS unsigned char*)lds_raw;
    volatile LAS unsigned* MISC = (volatile LAS unsigned*)(lds + MISC_OFF);
    const int G = gridDim.x, bx = blockIdx.x, NGW = G * NWAVES;
    unsigned char* ws = args.ws;
    gu32* ctl = (gu32*)(ws + WS_CTL);
    for (int u = threadIdx.x; u < (LDS_BYTES - LDSCTL_OFF) / 4; u += NWAVES * 64) ((LAS unsigned*)(lds + LDSCTL_OFF))[u] = 0u;
#define PHASE_IDS() int tid = threadIdx.x; asm volatile("" : "+v"(tid)); const int lane = tid & 63, wave = __builtin_amdgcn_readfirstlane(tid >> 6), gw = bx * NWAVES + wave; (void)lane; (void)gw
    __syncthreads();
#if MK_PER_PHASE
    XcdBarrier bar; bar.bar = (unsigned*)(ctl + CW_BAR); bar.x = 0; bar.st = nullptr;
#define GRID_BAR() do { } while (0)
#else
    XcdBarrier bar = xcd_barrier_post((unsigned*)(ctl + CW_BAR), MISC + 8);
#define GRID_BAR() xcd_barrier(bar)
#endif
    const int lo = args.ph_lo, hi = args.ph_hi;
#define IN(k) (lo <= (k) && (k) < hi)
#define BOTH(k) (IN(k) && IN((k) + 1))

    bf16* WIN_T = (bf16*)(ws + WS_WIN_T); bf16* WCAT_T = (bf16*)(ws + WS_WCAT_T); bf16* WOUT_T = (bf16*)(ws + WS_WOUT_T); bf16* WKV_T = (bf16*)(ws + WS_WKV_T);
    bf16* LBWA = (bf16*)(ws + WS_LBWA); bf16* LBG = (bf16*)(ws + WS_LBG); bf16* XN = (bf16*)(ws + WS_XN); bf16* MEMN = (bf16*)(ws + WS_MEMN); bf16* P = (bf16*)(ws + WS_P);
    float* R_R = (float*)(ws + WS_R); float* R_W = (float*)(ws + WS_R + RSZ); float* R_KP = (float*)(ws + WS_R + 2 * RSZ); float* R_V = (float*)(ws + WS_R + 3 * RSZ);
    float* R_KK = (float*)(ws + WS_R + 4 * RSZ); float* R_NB = (float*)(ws + WS_R + 5 * RSZ);
    bf16* GB = (bf16*)(ws + WS_G); float* Y = (float*)(ws + WS_Y); bf16* OCAT = (bf16*)(ws + WS_OCAT);
    bf16* QN = (bf16*)(ws + WS_QN); bf16* KN = (bf16*)(ws + WS_KN); bf16* VT = (bf16*)(ws + WS_VT); bf16* MQN = (bf16*)(ws + WS_MQN);
    bf16* MKRAW = (bf16*)(ws + WS_MKRAW); bf16* MKN = (bf16*)(ws + WS_MKN); bf16* MVT = (bf16*)(ws + WS_MVT);
    float* SM = (float*)(ws + WS_SM); bf16* PM = (bf16*)(ws + WS_PM); bf16* LA1 = (bf16*)(ws + WS_LA1); bf16* LA2 = (bf16*)(ws + WS_LA2);
    float* S0ALL = R_R;     float* BONUS = (float*)(ws + WS_BONUS);
    float* PHIT = (float*)(ws + WS_PHIT); float* PCT = (float*)(ws + WS_PCT); float* SLOCT = (float*)(ws + WS_SLOCT);
    bf16* WGU_T = (bf16*)(ws + WS_WGU_T); bf16* WD_T = (bf16*)(ws + WS_WD_T); bf16* MERGED = (bf16*)(ws + WS_MERGED); float* H1 = (float*)(ws + WS_H1); bf16* ACT = (bf16*)(ws + WS_ACT);

#define Q1_ITEMS (24 * 128 + 24 * 128 + 16 * 128 + 64 * 128 + 172 * 128)
#define Q1_BODY { int r = qi; LAS float* scr = (LAS float*)(lds + wave * 16384); \
        if (r < 24 * 128) transpose_item(args.in[I_WSBO], 4096, WCAT_T, 4096, 0, 0, 0, scr, r, lane); \
        else if ((r -= 24 * 128) < 24 * 128) transpose_item(args.in[I_WRWO], 4096, WCAT_T, 4096, 1536, 0, 0, scr, r, lane); \
        else if ((r -= 24 * 128) < 16 * 128) transpose_item(args.in[I_WMEMO], 4096, WCAT_T, 4096, 3072, 0, 0, scr, r, lane); \
        else if ((r -= 16 * 128) < 64 * 128) transpose_item(args.in[I_WOUT], 4096, WOUT_T, 4096, 0, 0, 0, scr, r, lane); \
        else { r -= 64 * 128; transpose_item(args.in[I_WDOWN], 4096, WD_T, DFF, 0, 0, 0, scr, r, lane); } }
#define Q2_ITEMS (2 * 64 * 344)
#define Q2_BODY { int r = qi; LAS float* scr2 = (LAS float*)(lds + wave * 16384); \
        if (r < 64 * 344) transpose_item(args.in[I_WGATE], DFF, WGU_T, 4096, 0, 2, 0, scr2, r, lane); \
        else transpose_item(args.in[I_WUP], DFF, WGU_T, 4096, 0, 3, 0, scr2, r - 64 * 344, lane); }
    if (IN(0)) {
        PHASE_IDS();
        LAS float* scr = (LAS float*)(lds + wave * 16384);
        constexpr int I_IN = 64 * 727, I_KV = 64 * 64;
        constexpr int NITEMS = I_IN + I_KV;
        for (int it = gw; it < NITEMS; it += NGW) {
            int r = it;
            if (r < I_IN) { transpose_item(args.in[I_WIN], NIN_ORIG, WIN_T, 4096, 0, 1, 0, scr, r, lane); continue; } r -= I_IN;
            transpose_item(args.in[I_MEMWKV], 2048, WKV_T, 4096, 0, 0, 0, scr, r, lane);
        }
        for (int i = bx * 512 + tid; i < 32 * 4096 / 8; i += G * 512) ((GAS v4u*)(WIN_T + (size_t)9952 * 4096))[i] = (v4u){0u, 0u, 0u, 0u};
        for (int i = bx * 512 + tid; i < 3072 * 256; i += G * 512) { const int n = i >> 8, k = i & 255; float v = 0.f;
            if (n < 1536) { if (k < 128) v = args.in[I_RWWUP][(size_t)k * 1536 + n]; } else { if (k >= 128) v = args.in[I_RWAUP][(size_t)(k - 128) * 1536 + (n - 1536)]; }
            LBWA[i] = (bf16)f2bf(v); }
        for (int i = bx * 512 + tid; i < 1536 * 512; i += G * 512) { const int n = i >> 9, k = i & 511; const float v = (k < 480) ? args.in[I_RWGUP][(size_t)k * 1536 + n] : 0.f; LBG[i] = (bf16)f2bf(v); }
        rms_rows4096(args.in[I_X], args.in[I_ATTN_G], XN, gw, NGW, T, lane);
        rms_rows4096(args.in[I_MEM], args.in[I_MEM_G], MEMN, gw, NGW, NMEM, lane);
        if (BOTH(0)) GRID_BAR();
    }

    if (IN(1)) {
        PHASE_IDS();
        pg8::SchedGemm1 S; S.to.init(32, 91); S.G = G; S.c = bx; S.XN = (const char*)XN; S.WIN = (const char*)WIN_T; S.MEMN = (const char*)MEMN; S.WKV = (const char*)WKV_T;
        pg8::EpiGemm1 E{P, MKRAW, MVT};
        pg8::gemm_phase(lds, 4096, 4096, S, E);
        QUEUE_PULL(ctl + CW_Q1, Q1_ITEMS, Q1_BODY);
        if (BOTH(1)) GRID_BAR();
    }

    if (IN(2)) {
        PHASE_IDS();
        QUEUE_PULL(ctl + CW_Q1, Q1_ITEMS, Q1_BODY);
        __syncthreads();
        {
            const float qscale = 0.08838834764831845f * 1.4426950408889634f;
            for (int t = gw; t < T; t += NGW) {
                const bf16* prow = P + (size_t)t * NINP;
#pragma unroll
                for (int which = 0; which < 2; ++which) {
                    const float* gain = args.in[which ? I_SBKG : I_SBQG]; bf16* dst = (which ? KN : QN) + (size_t)t * 1536; const int cb = which ? PK : PQ;
                    const f32x4 g0 = *(const GAS f32x4*)(gain + (8 * lane & 127)), g1 = *(const GAS f32x4*)(gain + (8 * lane & 127) + 4);
#pragma unroll
                    for (int p = 0; p < 3; ++p) {
                        const v4u raw = *(const GAS v4u*)(prow + cb + 512 * p + 8 * lane);
                        float v[8] = {bflo(raw.x), bfhi(raw.x), bflo(raw.y), bfhi(raw.y), bflo(raw.z), bfhi(raw.z), bflo(raw.w), bfhi(raw.w)};
                        float ss = 0.f;
#pragma unroll
                        for (int j = 0; j < 8; ++j) ss += v[j] * v[j];
                        ss = red16_sum(ss);
                        const float rstd = (which ? 1.0f : qscale) / sqrtf(ss * (1.f / 128.f) + RMS_EPS);
                        v4u o; o.x = pk2(v[0] * rstd * g0.x, v[1] * rstd * g0.y); o.y = pk2(v[2] * rstd * g0.z, v[3] * rstd * g0.w);
                        o.z = pk2(v[4] * rstd * g1.x, v[5] * rstd * g1.y); o.w = pk2(v[6] * rstd * g1.z, v[7] * rstd * g1.w);
                        *(GAS v4u*)(dst + 512 * p + 8 * lane) = o;
                    }
                }
                {
                    const float* gain = args.in[I_MEMQG] + ((16 * lane) & 255);
                    const v4u r0 = *(const GAS v4u*)(prow + PMQ + 16 * lane), r1 = *(const GAS v4u*)(prow + PMQ + 16 * lane + 8);
                    float v[16] = {bflo(r0.x), bfhi(r0.x), bflo(r0.y), bfhi(r0.y), bflo(r0.z), bfhi(r0.z), bflo(r0.w), bfhi(r0.w), bflo(r1.x), bfhi(r1.x), bflo(r1.y), bfhi(r1.y), bflo(r1.z), bfhi(r1.z), bflo(r1.w), bfhi(r1.w)};
                    float ss = 0.f;
#pragma unroll
                    for (int j = 0; j < 16; ++j) ss += v[j] * v[j];
                    ss = red16_sum(ss);
                    const float rstd = 0.0625f / sqrtf(ss * (1.f / 256.f) + RMS_EPS);
                    unsigned o[8];
#pragma unroll
                    for (int j = 0; j < 8; ++j) o[j] = pk2(v[2 * j] * rstd * gain[2 * j], v[2 * j + 1] * rstd * gain[2 * j + 1]);
                    *(GAS v4u*)(MQN + (size_t)t * 1024 + 16 * lane) = (v4u){o[0], o[1], o[2], o[3]};
                    *(GAS v4u*)(MQN + (size_t)t * 1024 + 16 * lane + 8) = (v4u){o[4], o[5], o[6], o[7]};
                }
            }
            for (int m = gw; m < NMEM; m += NGW) {
                const float* gain = args.in[I_MEMKG] + ((16 * lane) & 255);
                const v4u r0 = *(const GAS v4u*)(MKRAW + (size_t)m * 1024 + 16 * lane), r1 = *(const GAS v4u*)(MKRAW + (size_t)m * 1024 + 16 * lane + 8);
                float v[16] = {bflo(r0.x), bfhi(r0.x), bflo(r0.y), bfhi(r0.y), bflo(r0.z), bfhi(r0.z), bflo(r0.w), bfhi(r0.w), bflo(r1.x), bfhi(r1.x), bflo(r1.y), bfhi(r1.y), bflo(r1.z), bfhi(r1.z), bflo(r1.w), bfhi(r1.w)};
                float ss = 0.f;
#pragma unroll
                for (int j = 0; j < 16; ++j) ss += v[j] * v[j];
                ss = red16_sum(ss);
                const float rstd = 1.0f / sqrtf(ss * (1.f / 256.f) + RMS_EPS);
                unsigned o[8];
#pragma unroll
                for (int j = 0; j < 8; ++j) o[j] = pk2(v[2 * j] * rstd * gain[2 * j], v[2 * j + 1] * rstd * gain[2 * j + 1]);
                *(GAS v4u*)(MKN + (size_t)m * 1024 + 16 * lane) = (v4u){o[0], o[1], o[2], o[3]};
                *(GAS v4u*)(MKN + (size_t)m * 1024 + 16 * lane + 8) = (v4u){o[4], o[5], o[6], o[7]};
            }
        }
        {
            LAS unsigned char* scr = lds + wave * 16640;
            for (int it = gw; it < 12 * 128; it += NGW) {
                const int h = it >> 7, t0 = (it & 127) * 64;
#pragma unroll
                for (int i = 0; i < 16; ++i) { const int tt = 4 * i + (lane >> 4), c = lane & 15;
                    const v4u raw = *(const GAS v4u*)(P + (size_t)(t0 + tt) * NINP + PV + 128 * h + 8 * c);
                    LAS unsigned* d = (LAS unsigned*)(scr + tt * 260 + c * 16); d[0] = raw.x; d[1] = raw.y; d[2] = raw.z; d[3] = raw.w; }
                LDS_WAIT(); asm volatile("" ::: "memory");
#pragma unroll
                for (int i = 0; i < 16; ++i) { const int d = 8 * i + (lane >> 3), tc = lane & 7;
                    unsigned short e[8];
#pragma unroll
                    for (int j = 0; j < 8; ++j) e[j] = *(const LAS unsigned short*)(scr + (8 * tc + j) * 260 + d * 2);
                    v4u o; o.x = e[0] | ((unsigned)e[1] << 16); o.y = e[2] | ((unsigned)e[3] << 16); o.z = e[4] | ((unsigned)e[5] << 16); o.w = e[6] | ((unsigned)e[7] << 16);
                    *(GAS v4u*)(VT + ((size_t)h * 128 + d) * T + t0 + 8 * tc) = o; }
                LDS_WAIT(); asm volatile("" ::: "memory");
            }
        }
        {
            const float* mix = args.in[I_RWMIX];
            for (int t = gw; t < T; t += NGW) {
                const bf16* cur = P + (size_t)t * NINP + PRW; const bf16* prv = cur - NINP;
                for (int c8 = 576 + lane; c8 < RWSEG / 8; c8 += 64) {
                    const int c0 = 8 * c8;
                    const v4u rc = *(const GAS v4u*)(cur + c0); v4u rp = (v4u){0u, 0u, 0u, 0u}; if (t > 0) rp = *(const GAS v4u*)(prv + c0);
                    const f32x4 m0 = *(const GAS f32x4*)(mix + c0), m1 = *(const GAS f32x4*)(mix + c0 + 4);
                    const float cv[8] = {bflo(rc.x), bfhi(rc.x), bflo(rc.y), bfhi(rc.y), bflo(rc.z), bfhi(rc.z), bflo(rc.w), bfhi(rc.w)};
                    const float pv[8] = {bflo(rp.x), bfhi(rp.x), bflo(rp.y), bfhi(rp.y), bflo(rp.z), bfhi(rp.z), bflo(rp.w), bfhi(rp.w)};
                    const float mv[8] = {m0.x, m0.y, m0.z, m0.w, m1.x, m1.y, m1.z, m1.w};
                    float s[8];
#pragma unroll
                    for (int j = 0; j < 8; ++j) s[j] = cv[j] + (pv[j] - cv[j]) * mv[j];
                    if (c0 < 4864) { const bool isw = c0 < 4736;
                        if (isw) {
#pragma unroll
                            for (int j = 0; j < 8; ++j) { const float e = fexp(2.f * s[j]); s[j] = 1.f - 2.f * frcp(e + 1.f); } }
                        *(GAS v4u*)(LA1 + (size_t)t * 256 + (c0 - 4608)) = (v4u){pk2(s[0], s[1]), pk2(s[2], s[3]), pk2(s[4], s[5]), pk2(s[6], s[7])}; }
                    else {
#pragma unroll
                        for (int j = 0; j < 8; ++j) s[j] = sigmoidf_(s[j]);
                        *(GAS v4u*)(LA2 + (size_t)t * 512 + (c0 - 4864)) = (v4u){pk2(s[0], s[1]), pk2(s[2], s[3]), pk2(s[4], s[5]), pk2(s[6], s[7])}; }
                }
                if (lane < 4) *(GAS v4u*)(LA2 + (size_t)t * 512 + 480 + 8 * lane) = (v4u){0u, 0u, 0u, 0u};
            }
        }
        if (BOTH(2)) GRID_BAR();
    }

    if (IN(3)) {
        PHASE_IDS();
        int nt4 = 4, nt8 = 8; asm volatile("" : "+s"(nt4), "+s"(nt8));
        { pg8::SchedPlain S; S.to.init(32, 12); S.G = G; S.c = bx; S.nt = nt4; S.A0 = (const char*)LA1; S.B0 = (const char*)LBWA; S.sA = 256 * 256 * 2; S.sB = 256 * 256 * 2;
          pg8::EpiLoraWA E{args.in[I_RWW0], args.in[I_RWA0], R_W, R_NB};
          pg8::gemm_phase(lds, 256, 256, S, E); }
        { pg8::SchedPlain S; S.to.init(32, 6); S.G = G; S.c = (bx + G - 64) % G; S.nt = nt8; S.A0 = (const char*)LA2; S.B0 = (const char*)LBG; S.sA = 256 * 512 * 2; S.sB = 256 * 512 * 2;
          pg8::EpiBf16 E{GB, 1536, 0, 0};
          pg8::gemm_phase(lds, 512, 512, S, E); }
        { pg8::SchedHeads S; S.G = G; S.c = (bx + G - 128) % G; S.nunits = 128; S.nt = nt4; S.A0 = (const char*)MQN; S.B0 = (const char*)MKN; S.sA = 256 * 1024 * 2; S.hA = 512; S.hB = 512;
          pg8::EpiScoreF32 E{SM};
          pg8::gemm_phase(lds, 1024, 1024, S, E); }
        if (BOTH(3)) GRID_BAR();
    }

    if (IN(4)) {
        PHASE_IDS();
        constexpr int RP = 260, SLOT = 64 * RP, NP = 272;
        constexpr int S_AT = 0, S_BT = SLOT, S_KT = 2 * SLOT, S_RT = 3 * SLOT, S_NABT = 4 * SLOT, S_NAK = S_NABT + 64 * NP, S_MBR = S_NAK + SLOT, S_MKR = S_MBR + SLOT, S_SEG = S_MKR + SLOT, S_GC = S_SEG + 2048;
        static_assert(S_GC + 256 <= LDSCTL_OFF, "chunk-prep LDS map");
        constexpr int HP = 144, HSL = 64 * HP, H_AT = S_NABT, H_BT = H_AT + HSL, H_KT = H_BT + HSL, H_RT = H_KT + HSL;
        static_assert(H_RT + HSL <= S_SEG, "bf16 operand copies inside the Gram output slots");
        constexpr int H_PSIT = S_GC + 256, H_QCT = H_PSIT + HSL;
        static_assert(H_QCT + HSL <= LDSCTL_OFF, "chunk-prep LDS map (bf16 step-F operands)");
        const int l31 = lane & 31, lh = lane >> 5;
        float nwv[8], nkrv[8], nav[8], nrv[8], nvv[8];
        unsigned short pr_[9], pk_[9], pv_[9];
        float cmr, cmk, cmv, ckk, cka, crk;
#define S1_FETCH(it_) do { const int t0_ = ((it_) & 127) * 64 + 8 * wave, hc_ = ((it_) >> 7) * 64 + lane; const size_t gb_ = (size_t)t0_ * 1536 + hc_; \
            cmr = args.in[I_RWMIX][hc_]; cmk = args.in[I_RWMIX][1536 + hc_]; cmv = args.in[I_RWMIX][3072 + hc_]; ckk = args.in[I_RWKK][hc_]; cka = args.in[I_RWKA][hc_]; crk = args.in[I_RWRK][hc_]; \
            _Pragma("unroll") for (int i = 0; i < 8; ++i) { const size_t o_ = gb_ + (size_t)i * 1536; nwv[i] = R_W[o_]; nav[i] = R_NB[o_]; } \
            const bf16* pb_ = P + (size_t)t0_ * NINP + PRW + hc_; \
            _Pragma("unroll") for (int i = 0; i < 9; ++i) { const bool ok_ = (t0_ + i) > 0; const bf16* pp_ = pb_ + (ptrdiff_t)(i - 1) * NINP; \
                pr_[i] = ok_ ? pp_[0] : (unsigned short)0; pk_[i] = ok_ ? pp_[1536] : (unsigned short)0; pv_[i] = ok_ ? pp_[3072] : (unsigned short)0; } } while (0)
#define S1_SHIFT() do { const float mr_ = cmr, mk_ = cmk, mv_ = cmv; \
            _Pragma("unroll") for (int i = 0; i < 8; ++i) { const float cr_ = bflo(pr_[i + 1]), ck_ = bflo(pk_[i + 1]), cv_ = bflo(pv_[i + 1]); \
                nrv[i] = cr_ + (bflo(pr_[i]) - cr_) * mr_; nkrv[i] = ck_ + (bflo(pk_[i]) - ck_) * mk_; nvv[i] = cv_ + (bflo(pv_[i]) - cv_) * mv_; } } while (0)
#define S1_MAP(u_) ((((u_) % 24) << 7) + (u_) / 24)
        if (bx < 24 * 128) S1_FETCH(S1_MAP(bx));
        for (int unit = bx; unit < 24 * 128; unit += G) {
            const int item = S1_MAP(unit);
            const int head = item >> 7, chunk = item & 127;
            unsigned vvp[4];
            {
                S1_SHIFT();
                float nkkv[8], nnbv[8], nkpv[8];
                { const float kkc = ckk, kac = cka;
#pragma unroll
                  for (int i = 0; i < 8; ++i) { const float kq = nkrv[i] * kkc; const float ss = wave_sum_u(kq * kq);
                      const float kn = kq * (1.0f / fmaxf(sqrtf(ss), 1e-12f)); nkkv[i] = kn; nnbv[i] = -(kn * nav[i]); nkpv[i] = nkrv[i] * (1.0f + (nav[i] - 1.0f) * kac); } }
                float g[8]; g[0] = nwv[0];
#pragma unroll
                for (int i = 1; i < 8; ++i) g[i] = g[i - 1] * nwv[i];
                *(LAS float*)(lds + S_SEG + (wave * 64 + lane) * 4) = g[7];
                __syncthreads();
                float pre = 1.0f;
#pragma unroll
                for (int w2 = 0; w2 < 7; ++w2) { const float gw2 = *(LAS const float*)(lds + S_SEG + (w2 * 64 + lane) * 4); pre *= (w2 < wave) ? gw2 : 1.0f; }
                float avs[8];
#pragma unroll
                for (int i = 0; i < 8; ++i) { const float gt = pre * g[i], gp = (i == 0) ? pre : pre * g[i - 1], inv = 1.0f / gt; const int o = (8 * wave + i) * RP + lane * 4;
                    const float av = nkkv[i] * gp, bv = nnbv[i] * inv, kv = nkpv[i] * inv, rvv = nrv[i] * gt;
                    avs[i] = av; *(LAS float*)(lds + S_BT + o) = bv; *(LAS float*)(lds + S_KT + o) = kv; *(LAS float*)(lds + S_RT + o) = rvv;
                    const int ob = (8 * wave + i) * HP + lane * 2;
                    *(LAS unsigned short*)(lds + H_AT + ob) = (unsigned short)f2bf(av); *(LAS unsigned short*)(lds + H_BT + ob) = (unsigned short)f2bf(bv);
                    *(LAS unsigned short*)(lds + H_KT + ob) = (unsigned short)f2bf(kv); *(LAS unsigned short*)(lds + H_RT + ob) = (unsigned short)f2bf(rvv); }
                *(LAS v4u*)(lds + S_AT + lane * HP + wave * 16) = (v4u){pk2(avs[0], avs[1]), pk2(avs[2], avs[3]), pk2(avs[4], avs[5]), pk2(avs[6], avs[7])};
                vvp[0] = pk2(nvv[0], nvv[1]); vvp[1] = pk2(nvv[2], nvv[3]); vvp[2] = pk2(nvv[4], nvv[5]); vvp[3] = pk2(nvv[6], nvv[7]);
                if (wave == 7) *(LAS float*)(lds + S_GC + lane * 4) = pre * g[7];
                { const float rkl = crk;
#pragma unroll
                  for (int i = 0; i < 8; ++i) { const float bsum = wave_sum_u(nrv[i] * nkpv[i] * rkl); if (lane == 0) BONUS[(size_t)(chunk * 64 + 8 * wave + i) * 24 + head] = bsum; } }
                if (unit + G < 24 * 128) S1_FETCH(S1_MAP(unit + G));
                __syncthreads();
            }
            {
                const int Ls = (wave >> 2) ? H_KT : H_BT, Rs = ((wave >> 1) & 1) ? H_RT : H_AT, hm = wave & 1, which = wave >> 1;
                LAS const unsigned char* Lp = lds + Ls + (32 * hm + l31) * HP + lh * 16;
                LAS const unsigned char* Rp = lds + Rs + l31 * HP + lh * 16;
                f32x16 acc0, acc1;
#pragma unroll
                for (int r = 0; r < 16; ++r) { acc0[r] = 0.f; acc1[r] = 0.f; }
#pragma unroll
                for (int ks = 0; ks < 4; ++ks) { const bf16x8 a = *(LAS const bf16x8*)(Lp + ks * 32), b0 = *(LAS const bf16x8*)(Rp + ks * 32), b1 = *(LAS const bf16x8*)(Rp + 32 * HP + ks * 32);
                    acc0 = __builtin_amdgcn_mfma_f32_32x32x16_bf16(a, b0, acc0, 0, 0, 0); acc1 = __builtin_amdgcn_mfma_f32_32x32x16_bf16(a, b1, acc1, 0, 0, 0); }
                __syncthreads();
                const bool strict = (which == 0) || (which == 2);
#pragma unroll
                for (int nt = 0; nt < 2; ++nt)
#pragma unroll
                    for (int r = 0; r < 16; ++r) { const int j = 32 * hm + (r & 3) + 8 * (r >> 2) + 4 * lh, t = 32 * nt + l31; float val = nt ? acc1[r] : acc0[r];
                        const bool keep = strict ? (j < t) : (j <= t); val = keep ? val : 0.f;
                        int off;
                        if (which == 0) off = S_NABT + t * NP + ((j & 3) * 16 + (j >> 2)) * 4;
                        else off = (which == 1 ? S_MBR : S_MKR) + j * RP + t * 4;
                        if (which == 2) *(LAS unsigned short*)(lds + S_NAK + j * HP + t * 2) = (unsigned short)f2bf(val);
                        else *(LAS float*)(lds + off) = val; }
                __syncthreads();
            }
            {
                const int ci = lane >> 2, g = lane & 3, c = 16 * (wave & 3) + ci; const int slot = (wave < 4) ? S_MBR : S_BT;
                float xr[16];
#pragma unroll
                for (int q = 0; q < 16; ++q) xr[q] = *(LAS const float*)(lds + slot + (4 * q + g) * RP + c * 4);
                __syncthreads();
                f32x4 ca[4], cb[4], cc[4];
#define S1_CF(t_, dst_) do { if ((t_) >= 1) { _Pragma("unroll") for (int qg = 0; qg < 4; ++qg) if (4 * qg < ((t_) >> 2) + 1) dst_[qg] = *(LAS const f32x4*)(lds + S_NABT + (t_) * NP + (g * 16 + 4 * qg) * 4); } } while (0)
#define S1_STEP(t_, cur_, nxt_) do { S1_CF((t_) - 2, nxt_); __builtin_amdgcn_sched_barrier(0); \
                    const float xt = quad_bcast(xr[(t_) >> 2], (t_) & 3);     \
                    _Pragma("unroll") for (int qg = 0; qg < 4; ++qg) { _Pragma("unroll") for (int e = 0; e < 4; ++e) if (4 * qg + e < ((t_) >> 2) + 1) xr[4 * qg + e] = fmaf(cur_[qg][e], xt, xr[4 * qg + e]); } \
                    __builtin_amdgcn_sched_barrier(0); } while (0)
                S1_CF(63, ca); S1_CF(62, cb);
#pragma unroll
                for (int tb = 63; tb >= 1; tb -= 3) { S1_STEP(tb, ca, cc); S1_STEP(tb - 1, cb, ca); S1_STEP(tb - 2, cc, cb); }
#pragma unroll
                for (int q = 0; q < 16; ++q) *(LAS unsigned short*)(lds + slot + c * HP + (4 * q + g) * 2) = (unsigned short)f2bf(xr[q]);
                __syncthreads();
            }
            {
                const int which = wave >> 2, hm = (wave >> 1) & 1, ch = wave & 1; const int Xs = ch ? S_BT : S_MBR;
                LAS const unsigned char* Ap = lds + (which ? S_NAK : S_AT) + (32 * hm + l31) * HP + lh * 16;
                LAS const unsigned char* Bp = lds + Xs + l31 * HP + lh * 16;
                f32x16 acc0, acc1;
                int l31e = l31, lhe = lh; asm volatile("" : "+v"(l31e), "+v"(lhe));
#pragma unroll
                for (int nt = 0; nt < 2; ++nt)
#pragma unroll
                    for (int r = 0; r < 16; ++r) { const int m = 32 * hm + (r & 3) + 8 * (r >> 2) + 4 * lhe, n = 32 * nt + l31e; float iv;
                        if (which == 0) iv = ch ? ((m == n) ? 1.0f : 0.0f) : *(LAS const float*)(lds + S_RT + n * RP + m * 4);
                        else iv = *(LAS const float*)(lds + (ch ? S_KT : S_MKR) + m * RP + n * 4);
                        if (nt) acc1[r] = iv; else acc0[r] = iv; }
#pragma unroll
                for (int ks = 0; ks < 4; ++ks) { const bf16x8 a = *(LAS const bf16x8*)(Ap + ks * 32), b0 = *(LAS const bf16x8*)(Bp + ks * 32), b1 = *(LAS const bf16x8*)(Bp + 32 * HP + ks * 32);
                    acc0 = __builtin_amdgcn_mfma_f32_32x32x16_bf16(a, b0, acc0, 0, 0, 0); acc1 = __builtin_amdgcn_mfma_f32_32x32x16_bf16(a, b1, acc1, 0, 0, 0); }
#pragma unroll
                for (int nt = 0; nt < 2; ++nt) { const int n = 32 * nt + l31; const float gcn = ch ? *(LAS const float*)(lds + S_GC + n * 4) : 1.0f;
                    if (which == 0) { float* dst = (ch ? PCT : PHIT) + ((size_t)item * 64 + n) * 64 + 32 * hm + 4 * lh;
#pragma unroll
                        for (int i = 0; i < 4; ++i) { f32x4 o;
#pragma unroll
                            for (int e = 0; e < 4; ++e) o[e] = (nt ? acc1[4 * i + e] : acc0[4 * i + e]) * gcn;
                            *(GAS f32x4*)(dst + 8 * i) = o; } }
                    else {
#pragma unroll
                        for (int i = 0; i < 4; ++i) { const int j0 = 32 * hm + 8 * i + 4 * lh; float o[4];
#pragma unroll
                            for (int e = 0; e < 4; ++e) o[e] = (nt ? acc1[4 * i + e] : acc0[4 * i + e]) * gcn;
                            *(LAS v2u*)(lds + (ch ? H_QCT : H_PSIT) + n * HP + j0 * 2) = (v2u){pk2(o[0], o[1]), pk2(o[2], o[3])}; } } }
                *(LAS v4u*)(lds + S_NABT + lane * HP + wave * 16) = (v4u){vvp[0], vvp[1], vvp[2], vvp[3]};
                __syncthreads();
            }
            {
                const int hm = wave >> 2, ct = wave & 3, nt = ct & 1; const int Bs = (ct < 2) ? H_PSIT : H_QCT;
                LAS const unsigned char* Ap = lds + S_NABT + (32 * hm + l31) * HP + lh * 16;
                LAS const unsigned char* Bp = lds + Bs + (32 * nt + l31) * HP + lh * 16;
                f32x16 acc;
#pragma unroll
                for (int r = 0; r < 16; ++r) acc[r] = 0.f;
#pragma unroll
                for (int ks = 0; ks < 4; ++ks) acc = __builtin_amdgcn_mfma_f32_32x32x16_bf16(*(LAS const bf16x8*)(Ap + ks * 32), *(LAS const bf16x8*)(Bp + ks * 32), acc, 0, 0, 0);
                const int n = 32 * nt + l31;
                float* dst = (ct < 2) ? (Y + (size_t)(chunk * 64 + n) * 1536 + head * 64 + 32 * hm + 4 * lh) : (SLOCT + ((size_t)item * 64 + n) * 64 + 32 * hm + 4 * lh);
#pragma unroll
                for (int i = 0; i < 4; ++i) *(GAS f32x4*)(dst + 8 * i) = (f32x4){acc[4 * i], acc[4 * i + 1], acc[4 * i + 2], acc[4 * i + 3]};
                __syncthreads();
            }
        }
        for (int t = gw; t < T; t += NGW) {
            {
                const float* srow = SM + (size_t)t * 1024 + 16 * lane; f32x4 s[4]; float mx = -3.0e38f;
#pragma unroll
                for (int j = 0; j < 4; ++j) { s[j] = *(const GAS f32x4*)(srow + 4 * j); mx = fmaxf(mx, fmaxf(fmaxf(s[j].x, s[j].y), fmaxf(s[j].z, s[j].w))); }
                mx = red16_max(mx); float sum = 0.f;
#pragma unroll
                for (int j = 0; j < 4; ++j) { s[j].x = fexp(s[j].x - mx); s[j].y = fexp(s[j].y - mx); s[j].z = fexp(s[j].z - mx); s[j].w = fexp(s[j].w - mx); sum += (s[j].x + s[j].y) + (s[j].z + s[j].w); }
                sum = red16_sum(sum); const float inv = 1.0f / sum;
                unsigned o[8];
#pragma unroll
                for (int j = 0; j < 4; ++j) { o[2 * j] = pk2(s[j].x * inv, s[j].y * inv); o[2 * j + 1] = pk2(s[j].z * inv, s[j].w * inv); }
                *(GAS v4u*)(PM + (size_t)t * 1024 + 16 * lane) = (v4u){o[0], o[1], o[2], o[3]};
                *(GAS v4u*)(PM + (size_t)t * 1024 + 16 * lane + 8) = (v4u){o[4], o[5], o[6], o[7]};
            }
        }
        if (BOTH(4)) GRID_BAR();
    }

    if (IN(5)) {
        PHASE_IDS();
        constexpr int NSCAN = 96;
        if (bx < NSCAN) {
            const int head = 3 * (bx & 7) + (bx >> 5), rb = (bx >> 3) & 3, gk = lane >> 4, j = lane & 15, n0 = 16 * (wave & 3);
            constexpr int SP = 272, SBUF = 16 * SP;
            for (int i = tid; i < 2 * SBUF / 4; i += 512) *(LAS float*)(lds + i * 4) = 0.f;
            __syncthreads();
            int cur = 0;
            if (wave < 4) {
                const float* bsrc = PCT + ((size_t)head * 128 * 64 + n0 + j) * 64 + 16 * gk;
                const float* xsrc = SLOCT + ((size_t)head * 128 * 64 + n0 + j) * 64 + 16 * rb + 4 * gk;
                f32x4 bqs[3][4], xqs[3];
#define S2_LOAD(set, cc) do { const int cl_ = (cc) < 127 ? (cc) : 127; _Pragma("unroll") for (int q4 = 0; q4 < 4; ++q4) bqs[set][q4] = *(const GAS f32x4*)(bsrc + (size_t)cl_ * 4096 + 4 * q4); \
                    xqs[set] = *(const GAS f32x4*)(xsrc + (size_t)cl_ * 4096); } while (0)
#define S2_STEP(set, cc) do { f32x4 a4[4]; _Pragma("unroll") for (int q4 = 0; q4 < 4; ++q4) a4[q4] = *(LAS const f32x4*)(lds + cur * SBUF + j * SP + (16 * gk + 4 * q4) * 4); \
                    f32x4 acc[4]; _Pragma("unroll") for (int e = 0; e < 4; ++e) acc[e] = (f32x4){0.f, 0.f, 0.f, 0.f}; \
                    _Pragma("unroll") for (int q4 = 0; q4 < 4; ++q4) _Pragma("unroll") for (int e = 0; e < 4; ++e) acc[e] = __builtin_amdgcn_mfma_f32_16x16x4f32(a4[q4][e], bqs[set][q4][e], acc[e], 0, 0, 0); \
                    const f32x4 sum = (acc[0] + acc[1]) + (acc[2] + acc[3]) + xqs[set]; \
                    _Pragma("unroll") for (int r = 0; r < 4; ++r) *(LAS float*)(lds + (cur ^ 1) * SBUF + (4 * gk + r) * SP + (n0 + j) * 4) = sum[r]; \
                    S2_LOAD(set, (cc) + 3); __syncthreads(); cur ^= 1; } while (0)
                S2_LOAD(0, 0); S2_LOAD(1, 1); S2_LOAD(2, 2);
                for (int c = 0; c < 126; c += 3) { S2_STEP(0, c); S2_STEP(1, c + 1); S2_STEP(2, c + 2); } S2_STEP(0, 126); S2_STEP(1, 127);
#undef S2_LOAD
#undef S2_STEP
            } else {
                const int srow = 4 * (wave - 4) + (lane >> 4), sk = 4 * (lane & 15);
                float* dst = S0ALL + ((size_t)head * 128 * 64 + 16 * rb + srow) * 64 + sk;
                for (int c = 0; c < 128; ++c) { const f32x4 sv = *(LAS const f32x4*)(lds + cur * SBUF + srow * SP + sk * 4); *(GAS f32x4*)(dst + (size_t)c * 4096) = sv; __syncthreads(); cur ^= 1; }
            }
        }
        {
            const int GA = G - NSCAN, ca = bx - NSCAN;
            float thr;
            {
                const float* gq = args.in[I_SBQG]; const float* gk = args.in[I_SBKG];
                float mq = fmaxf(fabsf(gq[lane]), fabsf(gq[lane + 64])), mk = fmaxf(fabsf(gk[lane]), fabsf(gk[lane + 64]));
#pragma unroll
                for (int o = 1; o < 64; o <<= 1) { mq = fmaxf(mq, __shfl_xor(mq, o)); mk = fmaxf(mk, __shfl_xor(mk, o)); }
                thr = (11.3137085f * 1.02f * mq * mk + 104.0f) * 1.4426950408889634f;
            }
            constexpr int KPITCH = 272, VPITCH = 136, KBUF = 64 * KPITCH, VBUF = 128 * VPITCH, VOFF = 2 * KBUF, FLAGOFF = VOFF + 2 * VBUF, UQOFF = FLAGOFF + 64;
            const int hh = lane >> 5, l31 = lane & 31;
            __syncthreads();
            for (;;) {
                if (tid == 0) *(LAS int*)(lds + UQOFF) = (int)__hip_atomic_fetch_add((unsigned*)(ctl + CW_Q2), 1u, __ATOMIC_RELAXED, __HIP_MEMORY_SCOPE_AGENT);
                __syncthreads();
                const int uidx = *(LAS const int*)(lds + UQOFF);
                if (uidx >= 12 * 32) break;
                const int head = uidx % 12, qb = 31 - uidx / 12;
                const int q0 = qb * 256 + wave * 32, qi = q0 + l31;
                bf16x8 qf[8];
                { const bf16* qp = QN + (size_t)qi * 1536 + head * 128 + 8 * hh;
#pragma unroll
                  for (int s = 0; s < 8; ++s) qf[s] = *(const GAS bf16x8*)(qp + 16 * s); }
                f32x16 o[4];
#pragma unroll
                for (int c = 0; c < 4; ++c)
#pragma unroll
                    for (int r = 0; r < 16; ++r) o[c][r] = 0.f;
                float carry = 0.f; bool mydone = false;
                const int kkey = tid >> 3, kc = (tid & 7) * 2, vhd = tid >> 2, vp = tid & 3;
                const unsigned kofs = (unsigned)(kkey * 1536 + kc * 8) * 2u, vofs = (unsigned)(vhd * T + vp * 16) * 2u;
                const char* kgb = (const char*)KN + (size_t)head * 256; const char* vgb = (const char*)VT + (size_t)head * 128 * T * 2;
                v4u kr0, kr1, vr0, vr1;
#define SB_LOAD(kt_) do { const char* kb_ = kgb + (size_t)(kt_) * 64 * 1536 * 2; const char* vb_ = vgb + (size_t)(kt_) * 128; \
                          kr0 = *(const GAS v4u*)(kb_ + kofs); kr1 = *(const GAS v4u*)(kb_ + kofs + 16); vr0 = *(const GAS v4u*)(vb_ + vofs); vr1 = *(const GAS v4u*)(vb_ + vofs + 16); } while (0)
#define SB_STORE(buf_) do { LAS unsigned char* kd = lds + (buf_) * KBUF + kkey * KPITCH + kc * 16; *(LAS v4u*)kd = kr0; *(LAS v4u*)(kd + 16) = kr1; \
                          LAS unsigned char* vd = lds + VOFF + (buf_) * VBUF + vhd * VPITCH + vp * 32; *(LAS v2u*)vd = (v2u){vr0.x, vr0.y}; *(LAS v2u*)(vd + 8) = (v2u){vr0.z, vr0.w}; \
                          *(LAS v2u*)(vd + 16) = (v2u){vr1.x, vr1.y}; *(LAS v2u*)(vd + 24) = (v2u){vr1.z, vr1.w}; } while (0)
                int kt = 4 * qb + 3, cur = 0, it = 0;
                SB_LOAD(kt); SB_STORE(0); __syncthreads();
                for (;;) {
                    const bool more = kt > 0;
                    if (more) SB_LOAD(kt - 1);
                    const int k0 = kt * 64;
                    if (!mydone && k0 < q0 + 31) {
                        LAS const unsigned char* Kb = lds + cur * KBUF; LAS const unsigned char* Vb = lds + VOFF + cur * VBUF;
                        bf16x8 wf[2][2];
#pragma unroll
                        for (int b = 1; b >= 0; --b) {
                            f32x16 z;
#pragma unroll
                            for (int r = 0; r < 16; ++r) z[r] = 0.f;
#pragma unroll
                            for (int s = 0; s < 8; ++s) { const bf16x8 kf = *(LAS const bf16x8*)(Kb + (32 * b + l31) * KPITCH + (16 * s + 8 * hh) * 2);
                                z = __builtin_amdgcn_mfma_f32_32x32x16_bf16(kf, qf[s], z, 0, 0, 0); }
                            float sp[16];
                            const int lim = qi - k0 - 32 * b - 4 * hh;
#pragma unroll
                            for (int r = 0; r < 16; ++r) { const float zz = z[r];
                                const float v = fmaxf(zz, 0.f) + __builtin_amdgcn_logf(1.0f + __builtin_amdgcn_exp2f(-fabsf(zz))); sp[r] = (((r & 3) + 8 * (r >> 2)) < lim) ? v : 0.f; }
                            float Gs[4], Gp[4], Tt[4];
#pragma unroll
                            for (int i = 0; i < 4; ++i) { Gs[i] = (sp[4 * i] + sp[4 * i + 1]) + (sp[4 * i + 2] + sp[4 * i + 3]); Gp[i] = __shfl_xor(Gs[i], 32); Tt[i] = Gs[i] + Gp[i]; }
                            float X[4]; X[3] = 0.f; X[2] = Tt[3]; X[1] = X[2] + Tt[2]; X[0] = X[1] + Tt[1];
                            unsigned wp[8];
#pragma unroll
                            for (int i = 0; i < 4; ++i) {
                                const float newer = carry + X[i] + (hh == 0 ? Gp[i] : 0.f);
                                const float t3 = newer + sp[4 * i + 3], t2 = t3 + sp[4 * i + 2], t1 = t2 + sp[4 * i + 1], t0 = t1 + sp[4 * i];
                                const float tl[4] = {t0, t1, t2, t3}; float w[4];
#pragma unroll
                                for (int j = 0; j < 4; ++j) { const float e = __builtin_amdgcn_exp2f(z[4 * i + j] - tl[j]); w[j] = ((j + 8 * i) < lim) ? e : 0.f; }
                                wp[2 * i] = pk2(w[0], w[1]); wp[2 * i + 1] = pk2(w[2], w[3]);
                            }
                            carry += X[0] + Tt[0];
                            wf[b][0] = __builtin_bit_cast(bf16x8, (v4u){wp[0], wp[1], wp[2], wp[3]}); wf[b][1] = __builtin_bit_cast(bf16x8, (v4u){wp[4], wp[5], wp[6], wp[7]});
                        }
#pragma unroll
                        for (int b = 0; b < 2; ++b)
#pragma unroll
                            for (int s = 0; s < 2; ++s)
#pragma unroll
                                for (int c = 0; c < 4; ++c) { LAS const unsigned char* vpz = Vb + (32 * c + l31) * VPITCH + (32 * b + 16 * s + 4 * hh) * 2;
                                    const v2u va = *(LAS const v2u*)vpz, vb2 = *(LAS const v2u*)(vpz + 16);
                                    const bf16x8 vf = __builtin_bit_cast(bf16x8, (v4u){va.x, va.y, vb2.x, vb2.y});
                                    o[c] = __builtin_amdgcn_mfma_f32_32x32x16_bf16(vf, wf[b][s], o[c], 0, 0, 0); }
                        mydone = __all(carry > thr);
                    }
                    if (more) SB_STORE(cur ^ 1);
                    if (lane == 0) *(LAS unsigned*)(lds + FLAGOFF + ((it & 1) * 8 + wave) * 4) = mydone ? 1u : 0u;
                    __syncthreads();
                    if (!more) break;
                    { const v4u f0 = *(LAS const v4u*)(lds + FLAGOFF + (it & 1) * 32), f1 = *(LAS const v4u*)(lds + FLAGOFF + (it & 1) * 32 + 16);
                      if ((f0.x & f0.y & f0.z & f0.w & f1.x & f1.y & f1.z & f1.w) != 0u) break; }
                    --kt; cur ^= 1; ++it;
                }
#undef SB_LOAD
#undef SB_STORE
                bf16* op = OCAT + (size_t)qi * 4096 + head * 128 + 4 * hh;
#pragma unroll
                for (int c = 0; c < 4; ++c)
#pragma unroll
                    for (int i = 0; i < 4; ++i) *(GAS v2u*)(op + 32 * c + 8 * i) = (v2u){pk2(o[c][4 * i], o[c][4 * i + 1]), pk2(o[c][4 * i + 2], o[c][4 * i + 3])};
                __syncthreads();
            }
            if (bx >= NSCAN) { int nt4 = 4; asm volatile("" : "+s"(nt4)); pg8::SchedHeads S; S.G = GA; S.c = ca; S.nunits = 128; S.nt = nt4; S.A0 = (const char*)PM; S.B0 = (const char*)MVT; S.sA = 256 * 1024 * 2; S.hA = 512; S.hB = 256 * 1024 * 2;
              pg8::EpiBf16 E{OCAT, 4096, 3072, 256};
              pg8::gemm_phase(lds, 1024, 1024, S, E); }
        }
        if (BOTH(4)) GRID_BAR();
    }

    if (IN(6)) {
        PHASE_IDS();
        {
            const float* lng = args.in[I_RWLNG]; const float* lnb = args.in[I_RWLNB];
            const int l31 = lane & 31, lh = lane >> 5, sub = wave >> 2, mt = (wave >> 1) & 1, nt = wave & 1;
            LAS float* xch = (LAS float*)lds;
            for (int it0 = 2 * bx; it0 < 24 * 128; it0 += 2 * G) {
                const int item = it0 + sub, head = item >> 7, chunk = item & 127;
                const int tq = 32 * nt + l31; const size_t trow = (size_t)(chunk * 64 + tq);
                const float* ap = S0ALL + ((size_t)item * 64 + 32 * mt + l31) * 64 + 8 * lh;
                const float* bp = PHIT + ((size_t)item * 64 + tq) * 64 + 8 * lh;
                f32x4 af[4][2], bfv[4][2];
#pragma unroll
                for (int ks = 0; ks < 4; ++ks) { af[ks][0] = *(const GAS f32x4*)(ap + 16 * ks); af[ks][1] = *(const GAS f32x4*)(ap + 16 * ks + 4); bfv[ks][0] = *(const GAS f32x4*)(bp + 16 * ks); bfv[ks][1] = *(const GAS f32x4*)(bp + 16 * ks + 4); }
                f32x4 yl[4], vv4[4]; v2u gg[4];
                { const int vc = head * 64 + 32 * mt + 4 * lh; const float* yp = Y + trow * 1536 + vc; const bf16* gp = GB + trow * 1536 + vc;
                  const bf16* pc = P + trow * NINP + PRW + 3072 + vc; const float* mxp = args.in[I_RWMIX] + 3072 + vc;
#pragma unroll
                  for (int i = 0; i < 4; ++i) { yl[i] = *(const GAS f32x4*)(yp + 8 * i); gg[i] = *(const GAS v2u*)(gp + 8 * i);
                      const v2u c2 = *(const GAS v2u*)(pc + 8 * i); v2u p2 = (v2u){0u, 0u}; if (trow > 0) p2 = *(const GAS v2u*)(pc - NINP + 8 * i); const f32x4 mx = *(const GAS f32x4*)(mxp + 8 * i);
                      const float cv4[4] = {bflo(c2.x), bfhi(c2.x), bflo(c2.y), bfhi(c2.y)}, pv4[4] = {bflo(p2.x), bfhi(p2.x), bflo(p2.y), bfhi(p2.y)};
#pragma unroll
                      for (int e = 0; e < 4; ++e) vv4[i][e] = cv4[e] + (pv4[e] - cv4[e]) * mx[e]; } }
                const float bon = BONUS[trow * 24 + head];
                f32x16 acc;
#pragma unroll
                for (int r = 0; r < 16; ++r) acc[r] = 0.f;
#pragma unroll
                for (int ks = 0; ks < 4; ++ks) {
                    const v4u au = (v4u){pk2(af[ks][0].x, af[ks][0].y), pk2(af[ks][0].z, af[ks][0].w), pk2(af[ks][1].x, af[ks][1].y), pk2(af[ks][1].z, af[ks][1].w)};
                    const v4u bu = (v4u){pk2(bfv[ks][0].x, bfv[ks][0].y), pk2(bfv[ks][0].z, bfv[ks][0].w), pk2(bfv[ks][1].x, bfv[ks][1].y), pk2(bfv[ks][1].z, bfv[ks][1].w)};
                    acc = __builtin_amdgcn_mfma_f32_32x32x16_bf16(__builtin_bit_cast(bf16x8, au), __builtin_bit_cast(bf16x8, bu), acc, 0, 0, 0); }
                float yv[16]; float s1 = 0.f, s2 = 0.f;
#pragma unroll
                for (int i = 0; i < 4; ++i)
#pragma unroll
                    for (int e = 0; e < 4; ++e) { const float y = acc[4 * i + e] + yl[i][e]; yv[4 * i + e] = y; s1 += y; s2 += y * y; }
                s1 += __shfl_xor(s1, 32); s2 += __shfl_xor(s2, 32);
                if (lh == 0) { xch[((sub * 2 + mt) * 64 + tq) * 2] = s1; xch[((sub * 2 + mt) * 64 + tq) * 2 + 1] = s2; }
                __syncthreads();
                { const float o1 = xch[((sub * 2 + (mt ^ 1)) * 64 + tq) * 2], o2 = xch[((sub * 2 + (mt ^ 1)) * 64 + tq) * 2 + 1]; s1 += o1; s2 += o2; }
                const float mu = s1 * (1.f / 64.f), var = fmaxf(s2 * (1.f / 64.f) - mu * mu, 0.f), rstd = 1.0f / sqrtf(var + GN_EPS);
                bf16* op = OCAT + trow * 4096 + 1536 + head * 64 + 32 * mt + 4 * lh;
#pragma unroll
                for (int i = 0; i < 4; ++i) { const int vb = head * 64 + 32 * mt + 8 * i + 4 * lh; const f32x4 gv = *(const GAS f32x4*)(lng + vb), bv = *(const GAS f32x4*)(lnb + vb);
                    const float g4[4] = {bflo(gg[i].x), bfhi(gg[i].x), bflo(gg[i].y), bfhi(gg[i].y)}; float o[4];
#pragma unroll
                    for (int e = 0; e < 4; ++e) o[e] = ((yv[4 * i + e] - mu) * rstd * gv[e] + bv[e] + bon * vv4[i][e]) * g4[e];
                    *(GAS v2u*)(op + 8 * i) = (v2u){pk2(o[0], o[1]), pk2(o[2], o[3])}; }
                __syncthreads();
            }
        }
        {
            LAS float* scr = (LAS float*)(lds + wave * 16384);
            for (int qi = gw; qi < Q2_ITEMS; qi += NGW) Q2_BODY;
        }
        if (BOTH(6)) GRID_BAR();
    }

    if (IN(7)) {
        PHASE_IDS();
        pg8::SchedMerge S; S.to.init(32, 16); S.G = G; S.c = bx; S.OC = (const char*)OCAT; S.WC = (const char*)WCAT_T;
        pg8::EpiMerge E{P, MERGED};
        pg8::gemm_phase(lds, 4096, 4096, S, E);
        if (BOTH(7)) GRID_BAR();
    }

    if (IN(8)) {
        PHASE_IDS();
        pg8::SchedPlain S; S.to.init(32, 16); S.G = G; S.c = bx; S.nt = 64; S.A0 = (const char*)MERGED; S.B0 = (const char*)WOUT_T; S.sA = (size_t)256 * 4096 * 2; S.sB = (size_t)256 * 4096 * 2;
        pg8::EpiResF32 E{args.in[I_X], H1};
        pg8::gemm_phase(lds, 4096, 4096, S, E);
        if (BOTH(8)) GRID_BAR();
    }

    if (IN(9)) {
        PHASE_IDS();
        rms_rows4096(H1, args.in[I_FFNG], XN, gw, NGW, T, lane);
        if (BOTH(9)) GRID_BAR();
    }

    if (IN(10)) {
        PHASE_IDS();
        pg8::SchedPlain S; S.to.init(32, 86); S.G = G; S.c = bx; S.nt = 64; S.A0 = (const char*)XN; S.B0 = (const char*)WGU_T; S.sA = (size_t)256 * 4096 * 2; S.sB = (size_t)256 * 4096 * 2;
        pg8::EpiSwiGLU E{ACT};
        pg8::gemm_phase(lds, 4096, 4096, S, E);
        if (BOTH(10)) GRID_BAR();
    }

    if (IN(11)) {
        PHASE_IDS();
        pg8::SchedPlain S; S.to.init(32, 16); S.G = G; S.c = bx; S.nt = 172; S.A0 = (const char*)ACT; S.B0 = (const char*)WD_T; S.sA = (size_t)256 * DFF * 2; S.sB = (size_t)256 * DFF * 2;
        pg8::EpiResF32 E{H1, args.out};
        pg8::gemm_phase(lds, DFF, DFF, S, E);
    }
#undef IN
#undef BOTH
}

extern "C" void kernel_launch(void* const* d_in, const int* in_sizes, int n_in, void* d_out, int out_size, void* d_ws, size_t ws_size, hipStream_t stream) {
    static int grid = 0;
    if (grid == 0) {
        if (n_in != 29 || in_sizes[0] != T * D || out_size != T * D || ws_size < WS_END) {
            fprintf(stderr, "kernel_launch: unexpected problem (n_in %d, in0 %d, out %d, ws %zu, need %zu); nothing launched\n", n_in, n_in > 0 ? in_sizes[0] : -1, out_size, ws_size, (size_t)WS_END); grid = -1; return; }
        int dev = 0, cus = 0, per_cu = 0;
        if (hipGetDevice(&dev) != hipSuccess || hipDeviceGetAttribute(&cus, hipDeviceAttributeMultiprocessorCount, dev) != hipSuccess) { grid = -1; return; }
        if (hipFuncSetAttribute((const void*)hybrid_fwd, hipFuncAttributeMaxDynamicSharedMemorySize, LDS_BYTES) != hipSuccess) { fprintf(stderr, "kernel_launch: hipFuncSetAttribute failed\n"); grid = -1; return; }
        if (hipOccupancyMaxActiveBlocksPerMultiprocessor(&per_cu, (const void*)hybrid_fwd, NWAVES * 64, LDS_BYTES) != hipSuccess || per_cu < 1)
            fprintf(stderr, "kernel_launch: note: occupancy query reports %d workgroups per CU\n", per_cu);
        (void)hipGetLastError();
        grid = cus;
    }
    if (grid < 0) return;
    if (hipMemsetAsync((char*)d_ws + WS_CTL, 0, CTL_ZERO_BYTES, stream) != hipSuccess) return;
    Args a{};
    for (int i = 0; i < 29; ++i) a.in[i] = (const float*)d_in[i];
    a.out = (float*)d_out; a.ws = (unsigned char*)d_ws;
#if MK_PER_PHASE
    for (int p = 0; p < NPHASES; ++p) { a.ph_lo = p; a.ph_hi = p + 1; hipLaunchKernelGGL(hybrid_fwd, dim3(grid), dim3(NWAVES * 64), LDS_BYTES, stream, a); }
#else
    a.ph_lo = 0; a.ph_hi = NPHASES;
    hipLaunchKernelGGL(hybrid_fwd, dim3(grid), dim3(NWAVES * 64), LDS_BYTES, stream, a);
#endif
}
```

```cpp
#include <hip/hip_runtime.h>
#include <cstdio>
#include <cstdint>

#ifndef MK_PER_PHASE
#define MK_PER_PHASE 0
#endif

constexpr int T = 8192, D = 4096, NMEM = 256;
constexpr int SBW = 1536, RWW = 1536, MEMW = 1024, RWSEG = 5344, DFF = 11008;
constexpr int NIN_ORIG = 23264, NINP = 23296;
constexpr int PQ = 0, PK = 1536, PV = 3072, PRW = 4608, PMQ = 9984, PG = 11008;
constexpr float RMS_EPS = 1e-6f, GN_EPS = 64e-5f;

constexpr size_t MiB = 1u << 20;
constexpr size_t WS_CTL = 0, CTL_ZERO_BYTES = 256 * 1024;
constexpr size_t WS_WIN_T = 1 * MiB;
constexpr size_t WS_WCAT_T = WS_WIN_T + 182 * MiB;
constexpr size_t WS_WOUT_T = WS_WCAT_T + 32 * MiB;
constexpr size_t WS_WKV_T = WS_WOUT_T + 32 * MiB;
constexpr size_t WS_LBWA = WS_WKV_T + 16 * MiB;
constexpr size_t WS_LBG = WS_LBWA + 2 * MiB;
constexpr size_t WS_XN = WS_LBG + 2 * MiB;
constexpr size_t WS_MEMN = WS_XN + 64 * MiB;
constexpr size_t WS_P = WS_MEMN + 2 * MiB;
constexpr size_t WS_R = WS_P + 364 * MiB;
constexpr size_t RSZ = 48 * MiB;
constexpr size_t WS_G = WS_R + 6 * RSZ;
constexpr size_t WS_Y = WS_G + 24 * MiB;
constexpr size_t WS_OCAT = WS_Y + 48 * MiB;
constexpr size_t WS_LATE = WS_OCAT + 64 * MiB;
constexpr size_t WS_QN = WS_LATE;
constexpr size_t WS_KN = WS_QN + 24 * MiB;
constexpr size_t WS_VT = WS_KN + 24 * MiB;
constexpr size_t WS_MQN = WS_VT + 24 * MiB;
constexpr size_t WS_MKRAW = WS_MQN + 16 * MiB;
constexpr size_t WS_MKN = WS_MKRAW + 1 * MiB;
constexpr size_t WS_MVT = WS_MKN + 1 * MiB;
constexpr size_t WS_SM = WS_MVT + 2 * MiB;
constexpr size_t WS_PM = WS_SM + 32 * MiB;
constexpr size_t WS_LA1 = WS_PM + 16 * MiB;
constexpr size_t WS_LA2 = WS_LA1 + 4 * MiB;
constexpr size_t WS_EARLY_END = WS_LA2 + 8 * MiB;
constexpr size_t WS_PHIT = WS_EARLY_END;
constexpr size_t WS_PCT = WS_PHIT + 48 * MiB;
constexpr size_t WS_SLOCT = WS_PCT + 48 * MiB;
constexpr size_t WS_BONUS = WS_SLOCT + 48 * MiB;
constexpr size_t WS_RWKV_END = WS_BONUS + 1 * MiB;
constexpr size_t WS_WGU_T = WS_WIN_T;
constexpr size_t WS_WD_T = WS_R + 2 * RSZ;
constexpr size_t WS_END = WS_RWKV_END;
constexpr size_t WS_MERGED = WS_R;
constexpr size_t WS_H1 = WS_LATE;
constexpr size_t WS_ACT = WS_P;
static_assert(WS_H1 + 128 * MiB <= WS_EARLY_END && WS_WD_T + 86 * MiB <= WS_R + 4 * RSZ, "H1 / W_down copy homes");
static_assert(WS_END <= 1454ull * MiB, "workspace map exceeds the guaranteed 4x largest tensor");

constexpr int CW_TMO = 0, CW_CODE = 1, CW_BAR = 4096, CW_Q1 = 32768, CW_Q2 = 32768 + 64;

constexpr int RING_BYTES = 131072, LDSCTL_OFF = 159744, MISC_OFF = LDSCTL_OFF + 320, LDS_BYTES = 163840;
constexpr int NWAVES = 8;

#define GAS __attribute__((address_space(1)))
#define LAS __attribute__((address_space(3)))
typedef unsigned short bf16;
typedef unsigned v4u __attribute__((ext_vector_type(4)));
typedef unsigned v2u __attribute__((ext_vector_type(2)));
typedef float f32x4 __attribute__((ext_vector_type(4)));
typedef float f32x2 __attribute__((ext_vector_type(2)));
typedef float f32x16 __attribute__((ext_vector_type(16)));
typedef short bf16x8 __attribute__((ext_vector_type(8)));
typedef short s16x4 __attribute__((ext_vector_type(4)));
typedef GAS unsigned gu32;

typedef __bf16 hwbf16x2 __attribute__((ext_vector_type(2)));
__device__ __forceinline__ unsigned pk2(float lo, float hi) { const f32x2 v = {lo, hi}; return __builtin_bit_cast(unsigned, __builtin_convertvector(v, hwbf16x2)); }
__device__ __forceinline__ unsigned f2bf(float f) { return pk2(f, 0.f) & 0xffffu; }
__device__ __forceinline__ float bflo(unsigned w) { return __builtin_bit_cast(float, w << 16); }
__device__ __forceinline__ float bfhi(unsigned w) { return __builtin_bit_cast(float, w & 0xffff0000u); }
__device__ __forceinline__ float fexp(float x) { return __builtin_amdgcn_exp2f(x * 1.44269504088896f); }
__device__ __forceinline__ float flog(float x) { return __builtin_amdgcn_logf(x) * 0.693147180559945f; }
__device__ __forceinline__ float frcp(float x) { return __builtin_amdgcn_rcpf(x); }
__device__ __forceinline__ float sigmoidf_(float x) { return frcp(1.0f + fexp(-x)); }
__device__ __forceinline__ float softplusf_(float x) { return fmaxf(x, 0.f) + flog(1.0f + fexp(-fabsf(x))); }
__device__ __forceinline__ float wave_sum(float v) {
#pragma unroll
    for (int o = 1; o < 64; o <<= 1) v += __shfl_xor(v, o);
    return v;
}
__device__ __forceinline__ float dpp_f(float x, const int ctrl_sel) {
    return x;
}
#define DPP_ADD(x, ctrl) ((x) + __builtin_bit_cast(float, __builtin_amdgcn_update_dpp(0, __builtin_bit_cast(int, (x)), (ctrl), 0xF, 0xF, true)))
#define DPP_MAX(x, ctrl) fmaxf((x), __builtin_bit_cast(float, __builtin_amdgcn_update_dpp(0, __builtin_bit_cast(int, (x)), (ctrl), 0xF, 0xF, true)))
__device__ __forceinline__ float quad_bcast(float x, int g) {
    const int xi = __builtin_bit_cast(int, x);
    switch (g) {
        case 0: return __builtin_bit_cast(float, __builtin_amdgcn_update_dpp(0, xi, 0x00, 0xF, 0xF, true));
        case 1: return __builtin_bit_cast(float, __builtin_amdgcn_update_dpp(0, xi, 0x55, 0xF, 0xF, true));
        case 2: return __builtin_bit_cast(float, __builtin_amdgcn_update_dpp(0, xi, 0xAA, 0xF, 0xF, true));
        default: return __builtin_bit_cast(float, __builtin_amdgcn_update_dpp(0, xi, 0xFF, 0xF, 0xF, true));
    }
}
__device__ __forceinline__ float red16_sum(float x) {
    x = DPP_ADD(x, 0xB1); x = DPP_ADD(x, 0x4E); x = DPP_ADD(x, 0x141); x = DPP_ADD(x, 0x140); return x;
}
__device__ __forceinline__ float wave_sum_u(float x) {
    x = red16_sum(x);
    x += __builtin_bit_cast(float, __builtin_amdgcn_update_dpp(0, __builtin_bit_cast(int, x), 0x142, 0xA, 0xF, false));
    x += __builtin_bit_cast(float, __builtin_amdgcn_update_dpp(0, __builtin_bit_cast(int, x), 0x143, 0xC, 0xF, false));
    return __builtin_bit_cast(float, __builtin_amdgcn_readlane(__builtin_bit_cast(int, x), 63));
}
__device__ __forceinline__ float red16_max(float x) {
    x = DPP_MAX(x, 0xB1); x = DPP_MAX(x, 0x4E); x = DPP_MAX(x, 0x141); x = DPP_MAX(x, 0x140); return x;
}

namespace pg8 {
#define PG8_LAS __attribute__((address_space(3)))
typedef unsigned short bf16_t;
typedef unsigned u32x4 __attribute__((ext_vector_type(4)));
constexpr int BM = 256, BK = 64, HALF = 128, HTB = HALF * BK * 2, STAGE_BYTES = 8 * HTB, NXCD = 8, WGM = 4;

__host__ __device__ __forceinline__ int lds_byte(int r, int c) { const int st = (r >> 4) * 2 + (c >> 5), rr = r & 15, cc = c & 31, ob = rr * 64 + cc * 2; return st * 1024 + (ob ^ (((ob >> 9) & 1) << 5)); }
__host__ __device__ __forceinline__ void stage_rc(int b, int& R, int& C) { const int st = b / 1024, sb = b % 1024, swz = sb ^ (((sb >> 9) & 1) << 5); R = (st >> 1) * 16 + swz / 64; C = (st & 1) * 32 + (swz % 64) / 2; }
__host__ __device__ __forceinline__ int perm32(int rho) { const int n = rho >> 4, i = rho & 15; return 8 * (i >> 2) + 4 * n + (i & 3); }

struct Unit { const char* A; const char* B; int nt, pm, pn, kind; };

struct TileOrder {
    int nM, nN, nwg;
    __device__ __forceinline__ void init(int nM_, int nN_) { nM = nM_; nN = nN_; nwg = nM_ * nN_; }
    __device__ __forceinline__ void map(int L, int& pm, int& pn) const {
        int wgid = L; { const int q = nwg / NXCD, r = nwg % NXCD, xcd = wgid % NXCD, off = wgid / NXCD; wgid = (xcd < r ? xcd * (q + 1) : r * (q + 1) + (xcd - r) * q) + off; }
        const int nig = WGM * nN, gid = wgid / nig, fm = gid * WGM, gsz = (nM - fm) < WGM ? (nM - fm) : WGM;
        pm = fm + ((wgid % nig) % gsz); pn = (wgid % nig) / gsz;
    }
};

__device__ __forceinline__ unsigned cvt_pk_bf16(float lo, float hi) { unsigned r; asm volatile("v_cvt_pk_bf16_f32 %0, %1, %2" : "=v"(r) : "v"(lo), "v"(hi)); return r; }

template <class Epi, class Sched>
__device__ __forceinline__ void gemm_phase(PG8_LAS unsigned char* lds, const int lda, const int ldb, const Sched& S, const Epi& E) {
    const int tid = threadIdx.x, wid = __builtin_amdgcn_readfirstlane(tid >> 6), lane = tid & 63, wr = wid >> 2, wc = wid & 3, fr = lane & 15, fq = lane >> 4;
    unsigned voffA[2], voffB[2];
#pragma unroll
    for (int i = 0; i < 2; ++i) { int R, C; stage_rc(tid * 16 + i * 8192, R, C); const int Rb = Epi::PERM ? ((R & ~31) + perm32(R & 31)) : R;
        voffA[i] = (unsigned)(R * lda + C) * 2u; voffB[i] = (unsigned)(Rb * ldb + C) * 2u; }
    const size_t kstep = (size_t)(BK * 2);
    const size_t hstepA = (size_t)HALF * lda * 2, hstepB = (size_t)HALF * ldb * 2;
    const unsigned ldsw = (unsigned)wid * 1024u;
    const int aoff = lds_byte(wr * 64 + fr, fq * 8), boff = lds_byte(wc * 32 + fr, fq * 8);
#define PG8_SA(b, h) (((b) * 2 + (h)) * HTB)
#define PG8_SB(b, h) ((4 + (b) * 2 + (h)) * HTB)
#define PG8_STAGE(bufoff, gbase, voff) do { _Pragma("unroll") for (int _i = 0; _i < 2; ++_i) \
        __builtin_amdgcn_global_load_lds((const unsigned*)((const char*)(gbase) + (voff)[_i]), (PG8_LAS unsigned*)(lds + (bufoff) + ldsw + _i * 8192), 16, 0, 0); } while (0)
#define PG8_LDA(dst, b, h) do { _Pragma("unroll") for (int m = 0; m < 4; ++m) _Pragma("unroll") for (int k = 0; k < 2; ++k) dst[m][k] = *(const PG8_LAS bf16x8*)(lds + PG8_SA(b, h) + aoff + m * 2048 + k * 1024); } while (0)
#define PG8_LDB(dst, b, h) do { _Pragma("unroll") for (int n = 0; n < 2; ++n) _Pragma("unroll") for (int k = 0; k < 2; ++k) dst[n][k] = *(const PG8_LAS bf16x8*)(lds + PG8_SB(b, h) + boff + n * 2048 + k * 1024); } while (0)
#define PG8_MMA(ai, bj, At, Bt) do { __builtin_amdgcn_s_setprio(1); _Pragma("unroll") for (int m = 0; m < 4; ++m) _Pragma("unroll") for (int n = 0; n < 2; ++n) _Pragma("unroll") for (int k = 0; k < 2; ++k) \
        acc[ai][bj][m][n] = __builtin_amdgcn_mfma_f32_16x16x32_bf16(Bt[n][k], At[m][k], acc[ai][bj][m][n], 0, 0, 0); __builtin_amdgcn_s_setprio(0); } while (0)
#define PG8_WAIT_V(n) asm volatile("s_waitcnt vmcnt(" #n ")" ::: "memory")
#define PG8_WAIT_L(n) asm volatile("s_waitcnt lgkmcnt(" #n ")" ::: "memory")
#define PG8_BAR __builtin_amdgcn_s_barrier()
#define PG8_SCHED __builtin_amdgcn_sched_barrier(0)
    Unit cur, nxt; int ui = 0;
    if (!S.next(0, cur)) return;
    f32x4 acc[2][2][4][2];
#pragma unroll
    for (int a = 0; a < 2; ++a)
#pragma unroll
        for (int b = 0; b < 2; ++b)
#pragma unroll
            for (int m = 0; m < 4; ++m)
#pragma unroll
                for (int n = 0; n < 2; ++n) acc[a][b][m][n] = (f32x4){0.f, 0.f, 0.f, 0.f};
    bf16x8 At[4][2], B0[2][2], B1[2][2];
    const char* cA = cur.A; const char* cB = cur.B; int nt = cur.nt;
    PG8_STAGE(PG8_SB(0, 0), cB, voffB); PG8_STAGE(PG8_SB(0, 1), cB + hstepB, voffB); PG8_STAGE(PG8_SA(0, 0), cA, voffA); PG8_STAGE(PG8_SA(0, 1), cA + hstepA, voffA);
    if (wr == 1) PG8_BAR;
    PG8_WAIT_V(2); PG8_BAR;
    PG8_STAGE(PG8_SB(1, 0), cB + kstep, voffB); PG8_STAGE(PG8_SA(1, 0), cA + kstep, voffA); PG8_STAGE(PG8_SB(1, 1), cB + hstepB + kstep, voffB);
    PG8_WAIT_V(6); PG8_BAR;
    for (;;) {
        const bool has_next = S.next(ui + 1, nxt);
        const char* nA = has_next ? nxt.A : cA; const char* nB = has_next ? nxt.B : cB;
        for (int t = 0; t < nt; t += 2) {
            const bool last = (t == nt - 2);
            const char* a1 = cA + (size_t)(t + 1) * kstep;
            const char* a2 = last ? nA : cA + (size_t)(t + 2) * kstep; const char* b2 = last ? nB : cB + (size_t)(t + 2) * kstep;
            const char* a3 = a2 + kstep; const char* b3 = b2 + kstep;
            PG8_LDB(B0, 0, 0); PG8_LDB(B1, 0, 1); PG8_SCHED; PG8_LDA(At, 0, 0); PG8_STAGE(PG8_SA(1, 1), a1 + hstepA, voffA);
            PG8_WAIT_V(8); PG8_WAIT_L(0); PG8_BAR; PG8_MMA(0, 0, At, B0); PG8_MMA(0, 1, At, B1); PG8_BAR; PG8_SCHED;
            PG8_LDA(At, 0, 1); PG8_STAGE(PG8_SB(0, 0), b2, voffB); PG8_STAGE(PG8_SB(0, 1), b2 + hstepB, voffB); PG8_STAGE(PG8_SA(0, 0), a2, voffA);
            PG8_WAIT_V(8); PG8_WAIT_L(0); PG8_BAR; PG8_MMA(1, 0, At, B0); PG8_MMA(1, 1, At, B1); PG8_BAR; PG8_SCHED;
            PG8_LDB(B0, 1, 0); PG8_LDB(B1, 1, 1); PG8_SCHED; PG8_LDA(At, 1, 0); PG8_STAGE(PG8_SA(0, 1), a2 + hstepA, voffA);
            PG8_WAIT_V(8); PG8_WAIT_L(0); PG8_BAR; PG8_MMA(0, 0, At, B0); PG8_MMA(0, 1, At, B1); PG8_BAR; PG8_SCHED;
            PG8_LDA(At, 1, 1); PG8_STAGE(PG8_SB(1, 0), b3, voffB); PG8_STAGE(PG8_SB(1, 1), b3 + hstepB, voffB); PG8_STAGE(PG8_SA(1, 0), a3, voffA);
            PG8_WAIT_V(8); PG8_WAIT_L(0); PG8_BAR; PG8_MMA(1, 0, At, B0); PG8_MMA(1, 1, At, B1); PG8_BAR; PG8_SCHED;
        }
        if (wr == 0) PG8_BAR;
        const bool keep = E(acc, cur, wr, wc, fr, fq);
        if (!has_next) break;
        if (!keep) {
#pragma unroll
            for (int a = 0; a < 2; ++a)
#pragma unroll
                for (int b = 0; b < 2; ++b)
#pragma unroll
                    for (int m = 0; m < 4; ++m)
#pragma unroll
                        for (int n = 0; n < 2; ++n) acc[a][b][m][n] = (f32x4){0.f, 0.f, 0.f, 0.f};
        }
        cur = nxt; cA = nA; cB = nB; nt = cur.nt; ++ui;
        if (wr == 1) PG8_BAR;
    }
    PG8_WAIT_V(0);
    PG8_BAR;
#undef PG8_SA
#undef PG8_SB
#undef PG8_STAGE
#undef PG8_LDA
#undef PG8_LDB
#undef PG8_MMA
#undef PG8_WAIT_V
#undef PG8_WAIT_L
#undef PG8_BAR
#undef PG8_SCHED
}

struct SchedPlain {
    TileOrder to; int G, c, nt; const char* A0; const char* B0; size_t sA, sB;
    __device__ __forceinline__ bool next(int i, Unit& u) const {
        const int L = i * G + c; if (L >= to.nwg) return false;
        int pm, pn; to.map(L, pm, pn); u.A = A0 + (size_t)pm * sA; u.B = B0 + (size_t)pn * sB; u.nt = nt; u.pm = pm; u.pn = pn; u.kind = 0; return true;
    }
};
struct SchedGemm1 {
    TileOrder to; int G, c; const char *XN, *WIN, *MEMN, *WKV;
    __device__ __forceinline__ bool next(int i, Unit& u) const {
        const int L = i * G + c; u.nt = 64;
        if (L < to.nwg) { int pm, pn; to.map(L, pm, pn); u.A = XN + (size_t)pm * 256 * 4096 * 2; u.B = WIN + (size_t)pn * 256 * 4096 * 2; u.pm = pm; u.pn = pn; u.kind = 0; return true; }
        const int e = L - to.nwg; if (e >= 8) return false;
        if (e < 4) { u.A = MEMN; u.B = WKV + (size_t)e * 256 * 4096 * 2; u.pm = 0; u.pn = e; u.kind = 1; }
        else { u.A = WKV + (size_t)(1024 + 256 * (e - 4)) * 4096 * 2; u.B = MEMN; u.pm = e - 4; u.pn = 0; u.kind = 2; }
        return true;
    }
};
struct SchedHeads {
    int G, c, nunits, nt; const char* A0; const char* B0; size_t sA, hA, hB;
    __device__ __forceinline__ bool next(int i, Unit& u) const {
        const int L = i * G + c; if (L >= nunits) return false;
        const int pm = L & 31, h = L >> 5; u.A = A0 + (size_t)pm * sA + (size_t)h * hA; u.B = B0 + (size_t)h * hB; u.nt = nt; u.pm = pm; u.pn = 0; u.kind = h; return true;
    }
};
struct SchedMerge {
    TileOrder to; int G, c; const char* OC; const char* WC;
    __device__ __forceinline__ bool next(int i, Unit& u) const {
        const int ti = i / 3, b = i - 3 * ti; const int L = ti * G + c; if (L >= to.nwg) return false;
        int pm, pn; to.map(L, pm, pn); const int koff = b * 1536;
        u.A = OC + ((size_t)pm * 256 * 4096 + koff) * 2; u.B = WC + ((size_t)pn * 256 * 4096 + koff) * 2; u.nt = (b < 2) ? 24 : 16; u.pm = pm; u.pn = pn; u.kind = b; return true;
    }
};

struct EpiGemm1 {
    static constexpr bool PERM = true;
    bf16_t *P, *MK, *MVT;
    __device__ __forceinline__ bool operator()(f32x4 (&acc)[2][2][4][2], const Unit& u, int wr, int wc, int fr, int fq) const {
        bf16_t* base; int ldc;
        if (u.kind == 0) { base = P + (size_t)u.pm * 256 * NINP + u.pn * 256; ldc = NINP; }
        else if (u.kind == 1) { base = MK + u.pn * 256; ldc = 1024; }
        else { base = MVT + (size_t)u.pm * 256 * 1024; ldc = 1024; }
        base += (size_t)(wr * 64 + fr) * ldc + wc * 32 + 8 * fq;
#pragma unroll
        for (int ai = 0; ai < 2; ++ai)
#pragma unroll
            for (int m = 0; m < 4; ++m) { bf16_t* rowp = base + (size_t)(ai * HALF + m * 16) * ldc;
#pragma unroll
                for (int bj = 0; bj < 2; ++bj) { const f32x4 v0 = acc[ai][bj][m][0], v1 = acc[ai][bj][m][1];
                    u32x4 w; w.x = cvt_pk_bf16(v0[0], v0[1]); w.y = cvt_pk_bf16(v0[2], v0[3]); w.z = cvt_pk_bf16(v1[0], v1[1]); w.w = cvt_pk_bf16(v1[2], v1[3]);
                    *(u32x4*)(rowp + bj * HALF) = w; } }
        return false;
    }
};
struct EpiBf16 {
    static constexpr bool PERM = true;
    bf16_t* O; int ldc, coff, kstride;
    __device__ __forceinline__ bool operator()(f32x4 (&acc)[2][2][4][2], const Unit& u, int wr, int wc, int fr, int fq) const {
        bf16_t* base = O + (size_t)(u.pm * 256 + wr * 64 + fr) * ldc + coff + u.kind * kstride + u.pn * 256 + wc * 32 + 8 * fq;
#pragma unroll
        for (int ai = 0; ai < 2; ++ai)
#pragma unroll
            for (int m = 0; m < 4; ++m) { bf16_t* rowp = base + (size_t)(ai * HALF + m * 16) * ldc;
#pragma unroll
                for (int bj = 0; bj < 2; ++bj) { const f32x4 v0 = acc[ai][bj][m][0], v1 = acc[ai][bj][m][1];
                    u32x4 w; w.x = cvt_pk_bf16(v0[0], v0[1]); w.y = cvt_pk_bf16(v0[2], v0[3]); w.z = cvt_pk_bf16(v1[0], v1[1]); w.w = cvt_pk_bf16(v1[2], v1[3]);
                    *(u32x4*)(rowp + bj * HALF) = w; } }
        return false;
    }
};
struct EpiScoreF32 {
    static constexpr bool PERM = false;
    float* S;
    __device__ __forceinline__ bool operator()(f32x4 (&acc)[2][2][4][2], const Unit& u, int wr, int wc, int fr, int fq) const {
        float* base = S + (size_t)(u.pm * 256 + wr * 64 + fr) * 1024 + u.kind * 256 + wc * 32 + 4 * fq;
#pragma unroll
        for (int ai = 0; ai < 2; ++ai)
#pragma unroll
            for (int m = 0; m < 4; ++m) { float* rowp = base + (size_t)(ai * HALF + m * 16) * 1024;
#pragma unroll
                for (int bj = 0; bj < 2; ++bj)
#pragma unroll
                    for (int n = 0; n < 2; ++n) *(f32x4*)(rowp + bj * HALF + n * 16) = acc[ai][bj][m][n]; }
        return false;
    }
};
struct EpiLoraWA {
    static constexpr bool PERM = false;
    const float *w0, *a0; float *RW, *RA;
    __device__ __forceinline__ bool operator()(f32x4 (&acc)[2][2][4][2], const Unit& u, int wr, int wc, int fr, int fq) const {
        const bool isw = u.pn < 6; const int cb = (isw ? u.pn : u.pn - 6) * 256 + wc * 32 + 4 * fq;
        const float* bias = (isw ? w0 : a0) + cb; float* base = (isw ? RW : RA) + (size_t)(u.pm * 256 + wr * 64 + fr) * 1536 + cb;
        f32x4 bv[2][2];
#pragma unroll
        for (int bj = 0; bj < 2; ++bj)
#pragma unroll
            for (int n = 0; n < 2; ++n) bv[bj][n] = *(const f32x4*)(bias + bj * HALF + n * 16);
#pragma unroll
        for (int ai = 0; ai < 2; ++ai)
#pragma unroll
            for (int m = 0; m < 4; ++m) { float* rowp = base + (size_t)(ai * HALF + m * 16) * 1536;
#pragma unroll
                for (int bj = 0; bj < 2; ++bj)
#pragma unroll
                    for (int n = 0; n < 2; ++n) { f32x4 x = acc[ai][bj][m][n] + bv[bj][n]; f32x4 o;
#pragma unroll
                        for (int j = 0; j < 4; ++j) { const float sg = sigmoidf_(x[j]); o[j] = isw ? fexp(-0.6065306597126334f * sg) : sg; }
                        *(f32x4*)(rowp + bj * HALF + n * 16) = o; } }
        return false;
    }
};
struct EpiMerge {
    static constexpr bool PERM = true;
    const bf16_t* P; bf16_t* MG;
    __device__ __forceinline__ bool operator()(f32x4 (&acc)[2][2][4][2], const Unit& u, int wr, int wc, int fr, int fq) const {
        const int b = u.kind; const int row0 = u.pm * 256 + wr * 64 + fr, col0 = u.pn * 256 + wc * 32 + 8 * fq;
        const bf16_t* gbase = P + (size_t)row0 * NINP + PG + 4096 * b + col0;
#pragma unroll
        for (int ai = 0; ai < 2; ++ai) {
            u32x4 g0v[4][2], g1v[4][2];
#pragma unroll
            for (int m = 0; m < 4; ++m)
#pragma unroll
                for (int bj = 0; bj < 2; ++bj) { const bf16_t* gp = gbase + (size_t)(ai * HALF + m * 16) * NINP + bj * HALF; g0v[m][bj] = *(const u32x4*)gp; g1v[m][bj] = (b < 2) ? *(const u32x4*)(gp + 4096) : g0v[m][bj]; }
#pragma unroll
            for (int m = 0; m < 4; ++m) { const size_t row = (size_t)(row0 + ai * HALF + m * 16);
#pragma unroll
                for (int bj = 0; bj < 2; ++bj) { const u32x4 g0 = g0v[m][bj];
                    float e0[8]; const unsigned gw0[4] = {g0.x, g0.y, g0.z, g0.w};
#pragma unroll
                    for (int j = 0; j < 4; ++j) { e0[2 * j] = 1.0f + fexp(-bflo(gw0[j])); e0[2 * j + 1] = 1.0f + fexp(-bfhi(gw0[j])); }
                    if (b < 2) { const u32x4 g1 = g1v[m][bj]; const unsigned gw1[4] = {g1.x, g1.y, g1.z, g1.w};
#pragma unroll
                        for (int j = 0; j < 4; ++j) { const float r0 = (1.0f + fexp(-bflo(gw1[j]))) * frcp(e0[2 * j]), r1 = (1.0f + fexp(-bfhi(gw1[j]))) * frcp(e0[2 * j + 1]);
                            acc[ai][bj][m][j >> 1][(2 * j) & 3] *= r0; acc[ai][bj][m][j >> 1][(2 * j + 1) & 3] *= r1; }
                    } else { float v[8];
#pragma unroll
                        for (int j = 0; j < 8; ++j) v[j] = acc[ai][bj][m][j >> 2][j & 3] * frcp(e0[j]);
                        u32x4 w; w.x = cvt_pk_bf16(v[0], v[1]); w.y = cvt_pk_bf16(v[2], v[3]); w.z = cvt_pk_bf16(v[4], v[5]); w.w = cvt_pk_bf16(v[6], v[7]);
                        *(u32x4*)(MG + row * 4096 + col0 + bj * HALF) = w; } } }
            asm volatile("" ::: "memory");
        }
        return b < 2;
    }
};
struct EpiResF32 {
    static constexpr bool PERM = false;
    const float* res; float* out;
    __device__ __forceinline__ bool operator()(f32x4 (&acc)[2][2][4][2], const Unit& u, int wr, int wc, int fr, int fq) const {
        const size_t off0 = (size_t)(u.pm * 256 + wr * 64 + fr) * 4096 + u.pn * 256 + wc * 32 + 4 * fq;
#pragma unroll
        for (int ai = 0; ai < 2; ++ai)
#pragma unroll
            for (int mp = 0; mp < 2; ++mp) { f32x4 rv[2][2][2];
#pragma unroll
                for (int mm = 0; mm < 2; ++mm)
#pragma unroll
                    for (int bj = 0; bj < 2; ++bj)
#pragma unroll
                        for (int n = 0; n < 2; ++n) rv[mm][bj][n] = *(const f32x4*)(res + off0 + (size_t)(ai * HALF + (2 * mp + mm) * 16) * 4096 + bj * HALF + n * 16);
#pragma unroll
                for (int mm = 0; mm < 2; ++mm) { const size_t off = off0 + (size_t)(ai * HALF + (2 * mp + mm) * 16) * 4096;
#pragma unroll
                    for (int bj = 0; bj < 2; ++bj)
#pragma unroll
                        for (int n = 0; n < 2; ++n) *(f32x4*)(out + off + bj * HALF + n * 16) = rv[mm][bj][n] + acc[ai][bj][2 * mp + mm][n]; }
                asm volatile("" ::: "memory"); }
        return false;
    }
};
struct EpiSwiGLU {
    static constexpr bool PERM = true;
    bf16_t* ACT;
    __device__ __forceinline__ bool operator()(f32x4 (&acc)[2][2][4][2], const Unit& u, int wr, int wc, int fr, int fq) const {
        bf16_t* base = ACT + (size_t)(u.pm * 256 + wr * 64 + fr) * DFF + u.pn * 128 + wc * 32 + 8 * fq;
#pragma unroll
        for (int ai = 0; ai < 2; ++ai)
#pragma unroll
            for (int m = 0; m < 4; ++m) { float v[8];
#pragma unroll
                for (int j = 0; j < 8; ++j) { const float g = acc[ai][0][m][j >> 2][j & 3], up = acc[ai][1][m][j >> 2][j & 3]; v[j] = g * sigmoidf_(g) * up; }
                u32x4 w; w.x = cvt_pk_bf16(v[0], v[1]); w.y = cvt_pk_bf16(v[2], v[3]); w.z = cvt_pk_bf16(v[4], v[5]); w.w = cvt_pk_bf16(v[6], v[7]);
                *(u32x4*)(base + (size_t)(ai * HALF + m * 16) * DFF) = w; }
        return false;
    }
};
}

#define XB_TMO      128
#define XB_XCNT(j)  (256  + 64 * (j))
#define XB_XSUB(j)  (1280 + 64 * (j))
#define XB_XGEN(j)  (2304 + 64 * (j))
#define XB_TOP      3328
#define XB_TOPGEN   3392
#define XCD_BAR_WORDS 3456
#define XB_SPIN_CAP (1u << 18)
__device__ __forceinline__ unsigned xb_ld(unsigned* p)              { return __hip_atomic_load(p, __ATOMIC_RELAXED, __HIP_MEMORY_SCOPE_AGENT); }
__device__ __forceinline__ unsigned xb_add(unsigned* p, unsigned v) { return __hip_atomic_fetch_add(p, v, __ATOMIC_RELAXED, __HIP_MEMORY_SCOPE_AGENT); }
__device__ __forceinline__ unsigned xb_xcc_id() { return (unsigned)__builtin_amdgcn_s_getreg((3 << 11) | 20) & 0xFu; }
#define XB_SPIN(cond, bar) do { unsigned _sp = 0; while (cond) { __builtin_amdgcn_s_sleep(1); \
    if ((++_sp & 255u) == 0u) { if (xb_ld(&(bar)[XB_TMO])) break; if (_sp > XB_SPIN_CAP) { atomicAdd(&(bar)[XB_TMO], 1u); break; } } } } while (0)
struct XcdBarrier { unsigned* bar; unsigned x; volatile LAS unsigned* st; };
__device__ __forceinline__ XcdBarrier xcd_barrier_post(unsigned* bar, volatile LAS unsigned* st) {
    XcdBarrier b; b.bar = bar; b.x = xb_xcc_id(); b.st = st;
    if (threadIdx.x == 0) (void)xb_add(&bar[XB_XCNT(b.x)], 1u);
    return b;
}
__device__ __forceinline__ void xcd_barrier_complete(unsigned* bar, unsigned x, unsigned& nloc, unsigned& nx) {
    const unsigned G = gridDim.x * gridDim.y * gridDim.z;
    unsigned sum, cnt, mine, sp = 0u;
    for (;;) {
        sum = 0u; cnt = 0u; mine = 0u;
#pragma unroll
        for (unsigned j = 0; j < 16; ++j) { const unsigned c = xb_ld(&bar[XB_XCNT(j)]); sum += c; cnt += (c > 0u) ? 1u : 0u; mine = (j == x) ? c : mine; }
        if (sum == G) break;
        __builtin_amdgcn_s_sleep(1);
        if ((++sp & 255u) == 0u) { if (xb_ld(&bar[XB_TMO])) break; if (sp > XB_SPIN_CAP) { atomicAdd(&bar[XB_TMO], 1u); break; } }
    }
    nloc = mine > 0u ? mine : 1u; nx = cnt > 0u ? cnt : 1u;
}
__device__ __forceinline__ void xcd_barrier(const XcdBarrier& b) {
    asm volatile("s_waitcnt vmcnt(0)" ::: "memory");
    __syncthreads();
    if (threadIdx.x == 0) {
        unsigned* bar = b.bar;
        __builtin_amdgcn_s_waitcnt(0);
        unsigned nloc = b.st[0], nx = b.st[1];
        if (nloc == 0u) { xcd_barrier_complete(bar, b.x, nloc, nx); b.st[0] = nloc; b.st[1] = nx; }
        const unsigned old = xb_add(&bar[XB_XSUB(b.x)], 1u);
        const unsigned gen = old / nloc;
        if (old + 1u == (gen + 1u) * nloc) {
            __builtin_amdgcn_fence(__ATOMIC_RELEASE, "agent");
            asm volatile("s_waitcnt vmcnt(0)" ::: "memory");
            const unsigned og = xb_add(&bar[XB_TOP], 1u);
            const unsigned tg = og / nx;
            if (og + 1u == (tg + 1u) * nx) xb_add(&bar[XB_TOPGEN], 1u);
            else XB_SPIN(xb_ld(&bar[XB_TOPGEN]) == tg, bar);
            __builtin_amdgcn_fence(__ATOMIC_ACQUIRE, "agent");
            xb_add(&bar[XB_XGEN(b.x)], 1u);
            asm volatile("s_waitcnt vmcnt(0)" ::: "memory");
        } else {
            XB_SPIN(xb_ld(&bar[XB_XGEN(b.x)]) == gen, bar);
            __builtin_amdgcn_fence(__ATOMIC_ACQUIRE, "agent");
            asm volatile("s_waitcnt vmcnt(0)" ::: "memory");
        }
    }
    __syncthreads();
}

struct Args {
    const float* in[29]; float* out; unsigned char* ws; int ph_lo, ph_hi;
};
enum { I_X = 0, I_MEM, I_ATTN_G, I_MEM_G, I_WIN, I_SBQG, I_SBKG, I_RWMIX, I_RWW0, I_RWWUP, I_RWA0, I_RWAUP, I_RWGUP, I_RWKK, I_RWKA, I_RWRK, I_RWLNG, I_RWLNB,
       I_MEMWKV, I_MEMQG, I_MEMKG, I_WSBO, I_WRWO, I_WMEMO, I_WOUT, I_FFNG, I_WGATE, I_WUP, I_WDOWN };

#define LDS_WAIT() asm volatile("s_waitcnt lgkmcnt(0)" ::: "memory")

__device__ __forceinline__ int rowmap(int mode, int n, int roff) {
    if (mode == 1) return n + (n >= 9952 ? 32 : 0);
    if (mode == 2) return (n >> 7) * 256 + (n & 127);
    if (mode == 3) return (n >> 7) * 256 + 128 + (n & 127);
    return n + roff;
}
__device__ __forceinline__ void transpose_item(const float* W, int N, bf16* WT, int ldk, int koff, int mode, int roff, LAS float* scr, int item, int lane) {
    const int nblk = N / 32, kb = item / nblk, nb = item - kb * nblk, k0 = 64 * kb, n0 = 32 * nb;
    { const int rr = lane >> 3, c4 = (lane & 7) * 4; f32x4 wv[8];
#pragma unroll
      for (int i = 0; i < 8; ++i) wv[i] = *(const GAS f32x4*)(W + (size_t)(k0 + 8 * i + rr) * N + n0 + c4);
#pragma unroll
      for (int i = 0; i < 8; ++i) { LAS float* d = scr + (8 * i + rr) * 33 + c4; d[0] = wv[i].x; d[1] = wv[i].y; d[2] = wv[i].z; d[3] = wv[i].w; } }
    LDS_WAIT(); asm volatile("" ::: "memory");
    const int c = lane & 7;
#pragma unroll
    for (int j = 0; j < 4; ++j) { const int n = (lane >> 3) + 8 * j; const LAS float* s = scr + (8 * c) * 33 + n;
        v4u o; o.x = pk2(s[0 * 33], s[1 * 33]); o.y = pk2(s[2 * 33], s[3 * 33]); o.z = pk2(s[4 * 33], s[5 * 33]); o.w = pk2(s[6 * 33], s[7 * 33]);
        *(GAS v4u*)(WT + (size_t)rowmap(mode, n0 + n, roff) * ldk + koff + k0 + 8 * c) = o; }
    LDS_WAIT(); asm volatile("" ::: "memory");
}
__device__ __forceinline__ void rms_rows4096(const float* x, const float* g, bf16* out, int first, int stride, int nrows, int lane) {
    if (first >= nrows) return;
    f32x4 v[16], nv[16];
    { const GAS f32x4* xr = (const GAS f32x4*)(x + (size_t)first * 4096) + lane;
#pragma unroll
      for (int j = 0; j < 16; ++j) v[j] = xr[64 * j]; }
    const GAS f32x4* gr = (const GAS f32x4*)g + lane;
    for (int m = first; m < nrows; m += stride) {
        const bool more = m + stride < nrows;
        if (more) { const GAS f32x4* xr = (const GAS f32x4*)(x + (size_t)(m + stride) * 4096) + lane;
#pragma unroll
            for (int j = 0; j < 16; ++j) nv[j] = xr[64 * j]; }
        float s = 0.f;
#pragma unroll
        for (int j = 0; j < 16; ++j) s += (v[j].x * v[j].x + v[j].y * v[j].y) + (v[j].z * v[j].z + v[j].w * v[j].w);
        const float rstd = 1.0f / sqrtf(wave_sum(s) * (1.f / 4096.f) + RMS_EPS);
        GAS v2u* o8 = (GAS v2u*)(out + (size_t)m * 4096) + lane;
#pragma unroll
        for (int j = 0; j < 16; ++j) { const f32x4 gv = gr[64 * j]; v2u o; o.x = pk2(v[j].x * rstd * gv.x, v[j].y * rstd * gv.y); o.y = pk2(v[j].z * rstd * gv.z, v[j].w * rstd * gv.w); o8[64 * j] = o; }
        if (more) {
#pragma unroll
            for (int j = 0; j < 16; ++j) v[j] = nv[j]; }
    }
}
#define QB 16
#define QUEUE_PULL(headword, nitems, BODY) do { for (;;) { int it_ = 0; if ((threadIdx.x & 63) == 0) it_ = (int)__hip_atomic_fetch_add((unsigned*)(headword), (unsigned)QB, __ATOMIC_RELAXED, __HIP_MEMORY_SCOPE_AGENT); \
        it_ = __builtin_amdgcn_readfirstlane(it_); if (it_ >= (nitems)) break; const int qe_ = (it_ + QB < (nitems)) ? it_ + QB : (nitems); \
        for (int qi = it_; qi < qe_; ++qi) { BODY; } } } while (0)
constexpr int NPHASES = 12;
__global__ void __launch_bounds__(NWAVES * 64, 2) hybrid_fwd(Args args) {
    extern __shared__ __attribute__((aligned(16))) unsigned char lds_raw[];
    LAS unsigned char* lds = (LAS unsigned char*)lds_raw;
    volatile LAS unsigned* MISC = (volatile LAS unsigned*)(lds + MISC_OFF);
    const int G = gridDim.x, bx = blockIdx.x, NGW = G * NWAVES;
    unsigned char* ws = args.ws;
    gu32* ctl = (gu32*)(ws + WS_CTL);
    for (int u = threadIdx.x; u < (LDS_BYTES - LDSCTL_OFF) / 4; u += NWAVES * 64) ((LAS unsigned*)(lds + LDSCTL_OFF))[u] = 0u;
#define PHASE_IDS() int tid = threadIdx.x; asm volatile("" : "+v"(tid)); const int lane = tid & 63, wave = __builtin_amdgcn_readfirstlane(tid >> 6), gw = bx * NWAVES + wave; (void)lane; (void)gw
    __syncthreads();
#if MK_PER_PHASE
    XcdBarrier bar; bar.bar = (unsigned*)(ctl + CW_BAR); bar.x = 0; bar.st = nullptr;
#define GRID_BAR() do { } while (0)
#else
    XcdBarrier bar = xcd_barrier_post((unsigned*)(ctl + CW_BAR), MISC + 8);
#define GRID_BAR() xcd_barrier(bar)
#endif
    const int lo = args.ph_lo, hi = args.ph_hi;
#define IN(k) (lo <= (k) && (k) < hi)
#define BOTH(k) (IN(k) && IN((k) + 1))

    bf16* WIN_T = (bf16*)(ws + WS_WIN_T); bf16* WCAT_T = (bf16*)(ws + WS_WCAT_T); bf16* WOUT_T = (bf16*)(ws + WS_WOUT_T); bf16* WKV_T = (bf16*)(ws + WS_WKV_T);
    bf16* LBWA = (bf16*)(ws + WS_LBWA); bf16* LBG = (bf16*)(ws + WS_LBG); bf16* XN = (bf16*)(ws + WS_XN); bf16* MEMN = (bf16*)(ws + WS_MEMN); bf16* P = (bf16*)(ws + WS_P);
    float* R_R = (float*)(ws + WS_R); float* R_W = (float*)(ws + WS_R + RSZ); float* R_KP = (float*)(ws + WS_R + 2 * RSZ); float* R_V = (float*)(ws + WS_R + 3 * RSZ);
    float* R_KK = (float*)(ws + WS_R + 4 * RSZ); float* R_NB = (float*)(ws + WS_R + 5 * RSZ);
    bf16* GB = (bf16*)(ws + WS_G); float* Y = (float*)(ws + WS_Y); bf16* OCAT = (bf16*)(ws + WS_OCAT);
    bf16* QN = (bf16*)(ws + WS_QN); bf16* KN = (bf16*)(ws + WS_KN); bf16* VT = (bf16*)(ws + WS_VT); bf16* MQN = (bf16*)(ws + WS_MQN);
    bf16* MKRAW = (bf16*)(ws + WS_MKRAW); bf16* MKN = (bf16*)(ws + WS_MKN); bf16* MVT = (bf16*)(ws + WS_MVT);
    float* SM = (float*)(ws + WS_SM); bf16* PM = (bf16*)(ws + WS_PM); bf16* LA1 = (bf16*)(ws + WS_LA1); bf16* LA2 = (bf16*)(ws + WS_LA2);
    bf16* S0ALL = (bf16*)R_R;     float* BONUS = (float*)(ws + WS_BONUS);
    bf16* PHIT = (bf16*)(ws + WS_PHIT);   float* PCT = (float*)(ws + WS_PCT); float* SLOCT = (float*)(ws + WS_SLOCT);
    bf16* WGU_T = (bf16*)(ws + WS_WGU_T); bf16* WD_T = (bf16*)(ws + WS_WD_T); bf16* MERGED = (bf16*)(ws + WS_MERGED); float* H1 = (float*)(ws + WS_H1); bf16* ACT = (bf16*)(ws + WS_ACT);

#define Q1_ITEMS (24 * 128 + 24 * 128 + 16 * 128 + 64 * 128 + 172 * 128)
#define Q1_BODY { int r = qi; LAS float* scr = (LAS float*)(lds + wave * 16384); \
        if (r < 24 * 128) transpose_item(args.in[I_WSBO], 4096, WCAT_T, 4096, 0, 0, 0, scr, r, lane); \
        else if ((r -= 24 * 128) < 24 * 128) transpose_item(args.in[I_WRWO], 4096, WCAT_T, 4096, 1536, 0, 0, scr, r, lane); \
        else if ((r -= 24 * 128) < 16 * 128) transpose_item(args.in[I_WMEMO], 4096, WCAT_T, 4096, 3072, 0, 0, scr, r, lane); \
        else if ((r -= 16 * 128) < 64 * 128) transpose_item(args.in[I_WOUT], 4096, WOUT_T, 4096, 0, 0, 0, scr, r, lane); \
        else { r -= 64 * 128; transpose_item(args.in[I_WDOWN], 4096, WD_T, DFF, 0, 0, 0, scr, r, lane); } }
#define Q2_ITEMS (2 * 64 * 344)
#define Q2_BODY { int r = qi; LAS float* scr2 = (LAS float*)(lds + wave * 16384); \
        if (r < 64 * 344) transpose_item(args.in[I_WGATE], DFF, WGU_T, 4096, 0, 2, 0, scr2, r, lane); \
        else transpose_item(args.in[I_WUP], DFF, WGU_T, 4096, 0, 3, 0, scr2, r - 64 * 344, lane); }
    if (IN(0)) {
        PHASE_IDS();
        LAS float* scr = (LAS float*)(lds + wave * 16384);
        constexpr int I_IN = 64 * 727, I_KV = 64 * 64;
        constexpr int NITEMS = I_IN + I_KV;
        for (int it = gw; it < NITEMS; it += NGW) {
            int r = it;
            if (r < I_IN) { transpose_item(args.in[I_WIN], NIN_ORIG, WIN_T, 4096, 0, 1, 0, scr, r, lane); continue; } r -= I_IN;
            transpose_item(args.in[I_MEMWKV], 2048, WKV_T, 4096, 0, 0, 0, scr, r, lane);
        }
        for (int i = bx * 512 + tid; i < 32 * 4096 / 8; i += G * 512) ((GAS v4u*)(WIN_T + (size_t)9952 * 4096))[i] = (v4u){0u, 0u, 0u, 0u};
        for (int i = bx * 512 + tid; i < 3072 * 256; i += G * 512) { const int n = i >> 8, k = i & 255; float v = 0.f;
            if (n < 1536) { if (k < 128) v = args.in[I_RWWUP][(size_t)k * 1536 + n]; } else { if (k >= 128) v = args.in[I_RWAUP][(size_t)(k - 128) * 1536 + (n - 1536)]; }
            LBWA[i] = (bf16)f2bf(v); }
        for (int i = bx * 512 + tid; i < 1536 * 512; i += G * 512) { const int n = i >> 9, k = i & 511; const float v = (k < 480) ? args.in[I_RWGUP][(size_t)k * 1536 + n] : 0.f; LBG[i] = (bf16)f2bf(v); }
        rms_rows4096(args.in[I_X], args.in[I_ATTN_G], XN, gw, NGW, T, lane);
        rms_rows4096(args.in[I_MEM], args.in[I_MEM_G], MEMN, gw, NGW, NMEM, lane);
        if (BOTH(0)) GRID_BAR();
    }

    if (IN(1)) {
        PHASE_IDS();
        pg8::SchedGemm1 S; S.to.init(32, 91); S.G = G; S.c = bx; S.XN = (const char*)XN; S.WIN = (const char*)WIN_T; S.MEMN = (const char*)MEMN; S.WKV = (const char*)WKV_T;
        pg8::EpiGemm1 E{P, MKRAW, MVT};
        pg8::gemm_phase(lds, 4096, 4096, S, E);
        QUEUE_PULL(ctl + CW_Q1, Q1_ITEMS, Q1_BODY);
        if (BOTH(1)) GRID_BAR();
    }

    if (IN(2)) {
        PHASE_IDS();
        QUEUE_PULL(ctl + CW_Q1, Q1_ITEMS, Q1_BODY);
        __syncthreads();
        {
            const float qscale = 0.08838834764831845f * 1.4426950408889634f;
            for (int t = gw; t < T; t += NGW) {
                const bf16* prow = P + (size_t)t * NINP;
#pragma unroll
                for (int which = 0; which < 2; ++which) {
                    const float* gain = args.in[which ? I_SBKG : I_SBQG]; bf16* dst = (which ? KN : QN) + (size_t)t * 1536; const int cb = which ? PK : PQ;
                    const f32x4 g0 = *(const GAS f32x4*)(gain + (8 * lane & 127)), g1 = *(const GAS f32x4*)(gain + (8 * lane & 127) + 4);
#pragma unroll
                    for (int p = 0; p < 3; ++p) {
                        const v4u raw = *(const GAS v4u*)(prow + cb + 512 * p + 8 * lane);
                        float v[8] = {bflo(raw.x), bfhi(raw.x), bflo(raw.y), bfhi(raw.y), bflo(raw.z), bfhi(raw.z), bflo(raw.w), bfhi(raw.w)};
                        float ss = 0.f;
#pragma unroll
                        for (int j = 0; j < 8; ++j) ss += v[j] * v[j];
                        ss = red16_sum(ss);
                        const float rstd = (which ? 1.0f : qscale) / sqrtf(ss * (1.f / 128.f) + RMS_EPS);
                        v4u o; o.x = pk2(v[0] * rstd * g0.x, v[1] * rstd * g0.y); o.y = pk2(v[2] * rstd * g0.z, v[3] * rstd * g0.w);
                        o.z = pk2(v[4] * rstd * g1.x, v[5] * rstd * g1.y); o.w = pk2(v[6] * rstd * g1.z, v[7] * rstd * g1.w);
                        *(GAS v4u*)(dst + 512 * p + 8 * lane) = o;
                    }
                }
                {
                    const float* gain = args.in[I_MEMQG] + ((16 * lane) & 255);
                    const v4u r0 = *(const GAS v4u*)(prow + PMQ + 16 * lane), r1 = *(const GAS v4u*)(prow + PMQ + 16 * lane + 8);
                    float v[16] = {bflo(r0.x), bfhi(r0.x), bflo(r0.y), bfhi(r0.y), bflo(r0.z), bfhi(r0.z), bflo(r0.w), bfhi(r0.w), bflo(r1.x), bfhi(r1.x), bflo(r1.y), bfhi(r1.y), bflo(r1.z), bfhi(r1.z), bflo(r1.w), bfhi(r1.w)};
                    float ss = 0.f;
#pragma unroll
                    for (int j = 0; j < 16; ++j) ss += v[j] * v[j];
                    ss = red16_sum(ss);
                    const float rstd = 0.0625f / sqrtf(ss * (1.f / 256.f) + RMS_EPS);
                    unsigned o[8];
#pragma unroll
                    for (int j = 0; j < 8; ++j) o[j] = pk2(v[2 * j] * rstd * gain[2 * j], v[2 * j + 1] * rstd * gain[2 * j + 1]);
                    *(GAS v4u*)(MQN + (size_t)t * 1024 + 16 * lane) = (v4u){o[0], o[1], o[2], o[3]};
                    *(GAS v4u*)(MQN + (size_t)t * 1024 + 16 * lane + 8) = (v4u){o[4], o[5], o[6], o[7]};
                }
            }
            for (int m = gw; m < NMEM; m += NGW) {
                const float* gain = args.in[I_MEMKG] + ((16 * lane) & 255);
                const v4u r0 = *(const GAS v4u*)(MKRAW + (size_t)m * 1024 + 16 * lane), r1 = *(const GAS v4u*)(MKRAW + (size_t)m * 1024 + 16 * lane + 8);
                float v[16] = {bflo(r0.x), bfhi(r0.x), bflo(r0.y), bfhi(r0.y), bflo(r0.z), bfhi(r0.z), bflo(r0.w), bfhi(r0.w), bflo(r1.x), bfhi(r1.x), bflo(r1.y), bfhi(r1.y), bflo(r1.z), bfhi(r1.z), bflo(r1.w), bfhi(r1.w)};
                float ss = 0.f;
#pragma unroll
                for (int j = 0; j < 16; ++j) ss += v[j] * v[j];
                ss = red16_sum(ss);
                const float rstd = 1.0f / sqrtf(ss * (1.f / 256.f) + RMS_EPS);
                unsigned o[8];
#pragma unroll
                for (int j = 0; j < 8; ++j) o[j] = pk2(v[2 * j] * rstd * gain[2 * j], v[2 * j + 1] * rstd * gain[2 * j + 1]);
                *(GAS v4u*)(MKN + (size_t)m * 1024 + 16 * lane) = (v4u){o[0], o[1], o[2], o[3]};
                *(GAS v4u*)(MKN + (size_t)m * 1024 + 16 * lane + 8) = (v4u){o[4], o[5], o[6], o[7]};
            }
        }
        {
            LAS unsigned char* scr = lds + wave * 16640;
            for (int it = gw; it < 12 * 128; it += NGW) {
                const int h = it >> 7, t0 = (it & 127) * 64;
#pragma unroll
                for (int i = 0; i < 16; ++i) { const int tt = 4 * i + (lane >> 4), c = lane & 15;
                    const v4u raw = *(const GAS v4u*)(P + (size_t)(t0 + tt) * NINP + PV + 128 * h + 8 * c);
                    LAS unsigned* d = (LAS unsigned*)(scr + tt * 260 + c * 16); d[0] = raw.x; d[1] = raw.y; d[2] = raw.z; d[3] = raw.w; }
                LDS_WAIT(); asm volatile("" ::: "memory");
#pragma unroll
                for (int i = 0; i < 16; ++i) { const int d = 8 * i + (lane >> 3), tc = lane & 7;
                    unsigned short e[8];
#pragma unroll
                    for (int j = 0; j < 8; ++j) e[j] = *(const LAS unsigned short*)(scr + (8 * tc + j) * 260 + d * 2);
                    v4u o; o.x = e[0] | ((unsigned)e[1] << 16); o.y = e[2] | ((unsigned)e[3] << 16); o.z = e[4] | ((unsigned)e[5] << 16); o.w = e[6] | ((unsigned)e[7] << 16);
                    *(GAS v4u*)(VT + ((size_t)h * 128 + d) * T + t0 + 8 * tc) = o; }
                LDS_WAIT(); asm volatile("" ::: "memory");
            }
        }
        {
            const float* mix = args.in[I_RWMIX];
            for (int t = gw; t < T; t += NGW) {
                const bf16* cur = P + (size_t)t * NINP + PRW; const bf16* prv = cur - NINP;
                for (int c8 = 576 + lane; c8 < RWSEG / 8; c8 += 64) {
                    const int c0 = 8 * c8;
                    const v4u rc = *(const GAS v4u*)(cur + c0); v4u rp = (v4u){0u, 0u, 0u, 0u}; if (t > 0) rp = *(const GAS v4u*)(prv + c0);
                    const f32x4 m0 = *(const GAS f32x4*)(mix + c0), m1 = *(const GAS f32x4*)(mix + c0 + 4);
                    const float cv[8] = {bflo(rc.x), bfhi(rc.x), bflo(rc.y), bfhi(rc.y), bflo(rc.z), bfhi(rc.z), bflo(rc.w), bfhi(rc.w)};
                    const float pv[8] = {bflo(rp.x), bfhi(rp.x), bflo(rp.y), bfhi(rp.y), bflo(rp.z), bfhi(rp.z), bflo(rp.w), bfhi(rp.w)};
                    const float mv[8] = {m0.x, m0.y, m0.z, m0.w, m1.x, m1.y, m1.z, m1.w};
                    float s[8];
#pragma unroll
                    for (int j = 0; j < 8; ++j) s[j] = cv[j] + (pv[j] - cv[j]) * mv[j];
                    if (c0 < 4864) { const bool isw = c0 < 4736;
                        if (isw) {
#pragma unroll
                            for (int j = 0; j < 8; ++j) { const float e = fexp(2.f * s[j]); s[j] = 1.f - 2.f * frcp(e + 1.f); } }
                        *(GAS v4u*)(LA1 + (size_t)t * 256 + (c0 - 4608)) = (v4u){pk2(s[0], s[1]), pk2(s[2], s[3]), pk2(s[4], s[5]), pk2(s[6], s[7])}; }
                    else {
#pragma unroll
                        for (int j = 0; j < 8; ++j) s[j] = sigmoidf_(s[j]);
                        *(GAS v4u*)(LA2 + (size_t)t * 512 + (c0 - 4864)) = (v4u){pk2(s[0], s[1]), pk2(s[2], s[3]), pk2(s[4], s[5]), pk2(s[6], s[7])}; }
                }
                if (lane < 4) *(GAS v4u*)(LA2 + (size_t)t * 512 + 480 + 8 * lane) = (v4u){0u, 0u, 0u, 0u};
            }
        }
        if (BOTH(2)) GRID_BAR();
    }

    if (IN(3)) {
        PHASE_IDS();
        int nt4 = 4, nt8 = 8; asm volatile("" : "+s"(nt4), "+s"(nt8));
        { pg8::SchedPlain S; S.to.init(32, 12); S.G = G; S.c = bx; S.nt = nt4; S.A0 = (const char*)LA1; S.B0 = (const char*)LBWA; S.sA = 256 * 256 * 2; S.sB = 256 * 256 * 2;
          pg8::EpiLoraWA E{args.in[I_RWW0], args.in[I_RWA0], R_W, R_NB};
          pg8::gemm_phase(lds, 256, 256, S, E); }
        { pg8::SchedPlain S; S.to.init(32, 6); S.G = G; S.c = (bx + G - 64) % G; S.nt = nt8; S.A0 = (const char*)LA2; S.B0 = (const char*)LBG; S.sA = 256 * 512 * 2; S.sB = 256 * 512 * 2;
          pg8::EpiBf16 E{GB, 1536, 0, 0};
          pg8::gemm_phase(lds, 512, 512, S, E); }
        { pg8::SchedHeads S; S.G = G; S.c = (bx + G - 128) % G; S.nunits = 128; S.nt = nt4; S.A0 = (const char*)MQN; S.B0 = (const char*)MKN; S.sA = 256 * 1024 * 2; S.hA = 512; S.hB = 512;
          pg8::EpiScoreF32 E{SM};
          pg8::gemm_phase(lds, 1024, 1024, S, E); }
        if (BOTH(3)) GRID_BAR();
    }

    if (IN(4)) {
        PHASE_IDS();
        constexpr int RP = 260, SLOT = 64 * RP, NP = 272;
        constexpr int S_AT = 0, S_BT = SLOT, S_KT = 2 * SLOT, S_RT = 3 * SLOT, S_NABT = 4 * SLOT, S_NAK = S_NABT + 64 * NP, S_MBR = S_NAK + SLOT, S_MKR = S_MBR + SLOT, S_SEG = S_MKR + SLOT, S_GC = S_SEG + 2048;
        static_assert(S_GC + 256 <= LDSCTL_OFF, "chunk-prep LDS map");
        constexpr int HP = 144, HSL = 64 * HP, H_AT = S_NABT, H_BT = H_AT + HSL, H_KT = H_BT + HSL, H_RT = H_KT + HSL;
        static_assert(H_RT + HSL <= S_SEG, "bf16 operand copies inside the Gram output slots");
        constexpr int H_PSIT = S_GC + 256, H_QCT = H_PSIT + HSL;
        static_assert(H_QCT + HSL <= LDSCTL_OFF, "chunk-prep LDS map (bf16 step-F operands)");
        const int l31 = lane & 31, lh = lane >> 5;
        float nwv[8], nkrv[8], nav[8], nrv[8], nvv[8];
        unsigned short pr_[9], pk_[9], pv_[9];
        float cmr, cmk, cmv, ckk, cka, crk;
#define S1_FETCH(it_) do { const int t0_ = ((it_) & 127) * 64 + 8 * wave, hc_ = ((it_) >> 7) * 64 + lane; const unsigned gb_ = (unsigned)(t0_ * 1536 + hc_) * 4u; \
            cmr = args.in[I_RWMIX][hc_]; cmk = args.in[I_RWMIX][1536 + hc_]; cmv = args.in[I_RWMIX][3072 + hc_]; ckk = args.in[I_RWKK][hc_]; cka = args.in[I_RWKA][hc_]; crk = args.in[I_RWRK][hc_]; \
            _Pragma("unroll") for (int i = 0; i < 8; ++i) { const unsigned o_ = gb_ + (unsigned)i * 6144u; nwv[i] = *(const GAS float*)((const GAS char*)R_W + o_); nav[i] = *(const GAS float*)((const GAS char*)R_NB + o_); } \
            _Pragma("unroll") for (int i = 0; i < 9; ++i) { const int row_ = (t0_ + i - 1) > 0 ? (t0_ + i - 1) : 0; const unsigned po_ = (unsigned)(row_ * NINP + PRW + hc_) * 2u;     \
                pr_[i] = *(const GAS unsigned short*)((const GAS char*)P + po_); pk_[i] = *(const GAS unsigned short*)((const GAS char*)P + po_ + 3072u); pv_[i] = *(const GAS unsigned short*)((const GAS char*)P + po_ + 6144u); } \
            if (t0_ == 0) { pr_[0] = 0; pk_[0] = 0; pv_[0] = 0; }     } while (0)
#define S1_SHIFT() do { const float mr_ = cmr, mk_ = cmk, mv_ = cmv; \
            _Pragma("unroll") for (int i = 0; i < 8; ++i) { const float cr_ = bflo(pr_[i + 1]), ck_ = bflo(pk_[i + 1]), cv_ = bflo(pv_[i + 1]); \
                nrv[i] = cr_ + (bflo(pr_[i]) - cr_) * mr_; nkrv[i] = ck_ + (bflo(pk_[i]) - ck_) * mk_; nvv[i] = cv_ + (bflo(pv_[i]) - cv_) * mv_; } } while (0)
#define S1_MAP(u_) ((((u_) % 24) << 7) + (u_) / 24)
        if (bx < 24 * 128) S1_FETCH(S1_MAP(bx));
        for (int unit = bx; unit < 24 * 128; unit += G) {
            const int item = S1_MAP(unit);
            const int head = item >> 7, chunk = item & 127;
            unsigned vvp[4];
            {
                S1_SHIFT();
                float nkkv[8], nnbv[8], nkpv[8];
                { const float kkc = ckk, kac = cka;
#pragma unroll
                  for (int i = 0; i < 8; ++i) { const float kq = nkrv[i] * kkc; const float ss = wave_sum_u(kq * kq);
                      const float kn = kq * fminf(__builtin_amdgcn_rsqf(ss), 1e12f);     nkkv[i] = kn; nnbv[i] = -(kn * nav[i]); nkpv[i] = nkrv[i] * (1.0f + (nav[i] - 1.0f) * kac); } }
                float g[8]; g[0] = nwv[0];
#pragma unroll
                for (int i = 1; i < 8; ++i) g[i] = g[i - 1] * nwv[i];
                *(LAS float*)(lds + S_SEG + (wave * 64 + lane) * 4) = g[7];
                __syncthreads();
                float pre = 1.0f;
#pragma unroll
                for (int w2 = 0; w2 < 7; ++w2) { const float gw2 = *(LAS const float*)(lds + S_SEG + (w2 * 64 + lane) * 4); pre *= (w2 < wave) ? gw2 : 1.0f; }
                float avs[8];
#pragma unroll
                for (int i = 0; i < 8; ++i) { const float gt = pre * g[i], gp = (i == 0) ? pre : pre * g[i - 1], inv = frcp(gt); const int o = (8 * wave + i) * RP + lane * 4;
                    const float av = nkkv[i] * gp, bv = nnbv[i] * inv, kv = nkpv[i] * inv, rvv = nrv[i] * gt;
                    avs[i] = av; *(LAS float*)(lds + S_BT + o) = bv; *(LAS float*)(lds + S_KT + o) = kv; *(LAS float*)(lds + S_RT + o) = rvv;
                    const int ob = (8 * wave + i) * HP + lane * 2;
                    *(LAS unsigned short*)(lds + H_AT + ob) = (unsigned short)f2bf(av); *(LAS unsigned short*)(lds + H_BT + ob) = (unsigned short)f2bf(bv);
                    *(LAS unsigned short*)(lds + H_KT + ob) = (unsigned short)f2bf(kv); *(LAS unsigned short*)(lds + H_RT + ob) = (unsigned short)f2bf(rvv); }
                *(LAS v4u*)(lds + S_AT + lane * HP + wave * 16) = (v4u){pk2(avs[0], avs[1]), pk2(avs[2], avs[3]), pk2(avs[4], avs[5]), pk2(avs[6], avs[7])};
                vvp[0] = pk2(nvv[0], nvv[1]); vvp[1] = pk2(nvv[2], nvv[3]); vvp[2] = pk2(nvv[4], nvv[5]); vvp[3] = pk2(nvv[6], nvv[7]);
                if (wave == 7) *(LAS float*)(lds + S_GC + lane * 4) = pre * g[7];
                { const float rkl = crk;
                  float bsv = 0.f;
#pragma unroll
                  for (int i = 0; i < 8; ++i) { const float bsum = wave_sum_u(nrv[i] * nkpv[i] * rkl); bsv = (lane == i) ? bsum : bsv; }
                  if (lane < 8) BONUS[(size_t)(chunk * 64 + 8 * wave + lane) * 24 + head] = bsv; }
                if (unit + G < 24 * 128) S1_FETCH(S1_MAP(unit + G));
                __syncthreads();
            }
            {
                const int Ls = (wave >> 2) ? H_KT : H_BT, Rs = ((wave >> 1) & 1) ? H_RT : H_AT, hm = wave & 1, which = wave >> 1;
                LAS const unsigned char* Lp = lds + Ls + (32 * hm + l31) * HP + lh * 16;
                LAS const unsigned char* Rp = lds + Rs + l31 * HP + lh * 16;
                f32x16 acc0, acc1;
#pragma unroll
                for (int r = 0; r < 16; ++r) { acc0[r] = 0.f; acc1[r] = 0.f; }
#pragma unroll
                for (int ks = 0; ks < 4; ++ks) { const bf16x8 a = *(LAS const bf16x8*)(Lp + ks * 32), b0 = *(LAS const bf16x8*)(Rp + ks * 32), b1 = *(LAS const bf16x8*)(Rp + 32 * HP + ks * 32);
                    acc0 = __builtin_amdgcn_mfma_f32_32x32x16_bf16(a, b0, acc0, 0, 0, 0); acc1 = __builtin_amdgcn_mfma_f32_32x32x16_bf16(a, b1, acc1, 0, 0, 0); }
                __syncthreads();
#define S1_GVAL(strict_) const int j = 32 * hm + (r & 3) + 8 * (r >> 2) + 4 * lh, t = 32 * nt + l31; float val = nt ? acc1[r] : acc0[r]; val = ((strict_) ? (j < t) : (j <= t)) ? val : 0.f
                if (which == 0) {
#pragma unroll
                    for (int nt = 0; nt < 2; ++nt)
#pragma unroll
                        for (int r = 0; r < 16; ++r) { S1_GVAL(true); *(LAS float*)(lds + S_NABT + t * NP + ((j & 3) * 16 + (j >> 2)) * 4) = val; }
                } else if (which == 2) {
#pragma unroll
                    for (int nt = 0; nt < 2; ++nt)
#pragma unroll
                        for (int r = 0; r < 16; ++r) { S1_GVAL(true); *(LAS unsigned short*)(lds + S_NAK + j * HP + t * 2) = (unsigned short)f2bf(val); }
                } else {
                    const int mslot = (which == 1) ? S_MBR : S_MKR;
#pragma unroll
                    for (int nt = 0; nt < 2; ++nt)
#pragma unroll
                        for (int r = 0; r < 16; ++r) { S1_GVAL(false); *(LAS float*)(lds + mslot + j * RP + t * 4) = val; }
                }
                __syncthreads();
            }
            {
                const int ci = lane >> 2, g = lane & 3, c = 16 * (wave & 3) + ci; const int slot = (wave < 4) ? S_MBR : S_BT;
                f32x2 xr[8];
#pragma unroll
                for (int q = 0; q < 16; ++q) xr[q >> 1][q & 1] = *(LAS const float*)(lds + slot + (4 * q + g) * RP + c * 4);
                __syncthreads();
                f32x4 ca[4], cb[4], cc[4];
#define S1_CF(t_, dst_) do { if ((t_) >= 1) { _Pragma("unroll") for (int qg = 0; qg < 4; ++qg) if (4 * qg < ((t_) >> 2) + 1) dst_[qg] = *(LAS const f32x4*)(lds + S_NABT + (t_) * NP + (g * 16 + 4 * qg) * 4); } } while (0)
#define S1_STEP(t_, cur_, nxt_) do { S1_CF((t_) - 2, nxt_); __builtin_amdgcn_sched_barrier(0); \
                    const float xt = quad_bcast(xr[(t_) >> 3][((t_) >> 2) & 1], (t_) & 3);     \
                    const f32x2 xt2 = {xt, xt}; \
                    _Pragma("unroll") for (int qp = 0; qp < 8; ++qp) if (2 * qp < ((t_) >> 2) + 1) { const f32x2 cf2 = {cur_[qp >> 1][2 * (qp & 1)], cur_[qp >> 1][2 * (qp & 1) + 1]}; \
                        xr[qp] = __builtin_elementwise_fma(cf2, xt2, xr[qp]); }     \
                    __builtin_amdgcn_sched_barrier(0); } while (0)
                S1_CF(63, ca); S1_CF(62, cb);
#pragma unroll
                for (int tb = 63; tb >= 1; tb -= 3) { S1_STEP(tb, ca, cc); S1_STEP(tb - 1, cb, ca); S1_STEP(tb - 2, cc, cb); }
#pragma unroll
                for (int q = 0; q < 16; ++q) *(LAS unsigned short*)(lds + slot + c * HP + (4 * q + g) * 2) = (unsigned short)f2bf(xr[q >> 1][q & 1]);
                __syncthreads();
            }
            {
                const int which = wave >> 2, hm = (wave >> 1) & 1, ch = wave & 1; const int Xs = ch ? S_BT : S_MBR;
                LAS const unsigned char* Ap = lds + (which ? S_NAK : S_AT) + (32 * hm + l31) * HP + lh * 16;
                LAS const unsigned char* Bp = lds + Xs + l31 * HP + lh * 16;
                f32x16 acc0, acc1;
                int l31e = l31, lhe = lh; asm volatile("" : "+v"(l31e), "+v"(lhe));
                {
                    const int ibase = (which == 0) ? S_RT : (ch ? S_KT : S_MKR), sm = (which == 0) ? 4 : RP, sn = (which == 0) ? RP : 4;
                    const int tb = ibase + (32 * hm + 4 * lhe) * sm + l31e * sn;
#pragma unroll
                    for (int r = 0; r < 16; ++r) { const int om = ((r & 3) + 8 * (r >> 2)) * sm; acc0[r] = *(LAS const float*)(lds + tb + om); acc1[r] = *(LAS const float*)(lds + tb + om + 32 * sn); }
                    if (which == 0 && ch) {
#pragma unroll
                        for (int r = 0; r < 16; ++r) { const int m = 32 * hm + (r & 3) + 8 * (r >> 2) + 4 * lhe; acc0[r] = (m == l31e) ? 1.0f : 0.0f; acc1[r] = (m == 32 + l31e) ? 1.0f : 0.0f; }
                    }
                }
#pragma unroll
                for (int ks = 0; ks < 4; ++ks) { const bf16x8 a = *(LAS const bf16x8*)(Ap + ks * 32), b0 = *(LAS const bf16x8*)(Bp + ks * 32), b1 = *(LAS const bf16x8*)(Bp + 32 * HP + ks * 32);
                    acc0 = __builtin_amdgcn_mfma_f32_32x32x16_bf16(a, b0, acc0, 0, 0, 0); acc1 = __builtin_amdgcn_mfma_f32_32x32x16_bf16(a, b1, acc1, 0, 0, 0); }
#pragma unroll
                for (int nt = 0; nt < 2; ++nt) { const int n = 32 * nt + l31; const float gcn = ch ? *(LAS const float*)(lds + S_GC + n * 4) : 1.0f;
                    if (which == 0) { const size_t eo = ((size_t)item * 64 + n) * 64 + 32 * hm + 4 * lh;
                        if (ch) {
#pragma unroll
                            for (int i = 0; i < 4; ++i) { f32x4 o;
#pragma unroll
                                for (int e = 0; e < 4; ++e) o[e] = (nt ? acc1[4 * i + e] : acc0[4 * i + e]) * gcn;
                                *(GAS f32x4*)(PCT + eo + 8 * i) = o; }
                        } else {
#pragma unroll
                            for (int i = 0; i < 4; ++i) { const int q = 4 * i;
                                *(GAS v2u*)(PHIT + eo + 8 * i) = nt ? (v2u){pk2(acc1[q], acc1[q + 1]), pk2(acc1[q + 2], acc1[q + 3])} : (v2u){pk2(acc0[q], acc0[q + 1]), pk2(acc0[q + 2], acc0[q + 3])}; }
                        } }
                    else {
#pragma unroll
                        for (int i = 0; i < 4; ++i) { const int j0 = 32 * hm + 8 * i + 4 * lh; float o[4];
#pragma unroll
                            for (int e = 0; e < 4; ++e) o[e] = (nt ? acc1[4 * i + e] : acc0[4 * i + e]) * gcn;
                            *(LAS v2u*)(lds + (ch ? H_QCT : H_PSIT) + n * HP + j0 * 2) = (v2u){pk2(o[0], o[1]), pk2(o[2], o[3])}; } } }
                *(LAS v4u*)(lds + S_NABT + lane * HP + wave * 16) = (v4u){vvp[0], vvp[1], vvp[2], vvp[3]};
                __syncthreads();
            }
            {
                const int hm = wave >> 2, ct = wave & 3, nt = ct & 1; const int Bs = (ct < 2) ? H_PSIT : H_QCT;
                LAS const unsigned char* Ap = lds + S_NABT + (32 * hm + l31) * HP + lh * 16;
                LAS const unsigned char* Bp = lds + Bs + (32 * nt + l31) * HP + lh * 16;
                f32x16 acc;
#pragma unroll
                for (int r = 0; r < 16; ++r) acc[r] = 0.f;
#pragma unroll
                for (int ks = 0; ks < 4; ++ks) acc = __builtin_amdgcn_mfma_f32_32x32x16_bf16(*(LAS const bf16x8*)(Ap + ks * 32), *(LAS const bf16x8*)(Bp + ks * 32), acc, 0, 0, 0);
                const int n = 32 * nt + l31;
                float* dst = (ct < 2) ? (Y + (size_t)(chunk * 64 + n) * 1536 + head * 64 + 32 * hm + 4 * lh) : (SLOCT + ((size_t)item * 64 + n) * 64 + 32 * hm + 4 * lh);
#pragma unroll
                for (int i = 0; i < 4; ++i) *(GAS f32x4*)(dst + 8 * i) = (f32x4){acc[4 * i], acc[4 * i + 1], acc[4 * i + 2], acc[4 * i + 3]};
                __syncthreads();
            }
        }
        for (int t = gw; t < T; t += NGW) {
            {
                const float* srow = SM + (size_t)t * 1024 + 16 * lane; f32x4 s[4]; float mx = -3.0e38f;
#pragma unroll
                for (int j = 0; j < 4; ++j) { s[j] = *(const GAS f32x4*)(srow + 4 * j); mx = fmaxf(mx, fmaxf(fmaxf(s[j].x, s[j].y), fmaxf(s[j].z, s[j].w))); }
                mx = red16_max(mx); float sum = 0.f;
#pragma unroll
                for (int j = 0; j < 4; ++j) { s[j].x = fexp(s[j].x - mx); s[j].y = fexp(s[j].y - mx); s[j].z = fexp(s[j].z - mx); s[j].w = fexp(s[j].w - mx); sum += (s[j].x + s[j].y) + (s[j].z + s[j].w); }
                sum = red16_sum(sum); const float inv = 1.0f / sum;
                unsigned o[8];
#pragma unroll
                for (int j = 0; j < 4; ++j) { o[2 * j] = pk2(s[j].x * inv, s[j].y * inv); o[2 * j + 1] = pk2(s[j].z * inv, s[j].w * inv); }
                *(GAS v4u*)(PM + (size_t)t * 1024 + 16 * lane) = (v4u){o[0], o[1], o[2], o[3]};
                *(GAS v4u*)(PM + (size_t)t * 1024 + 16 * lane + 8) = (v4u){o[4], o[5], o[6], o[7]};
            }
        }
        if (BOTH(4)) GRID_BAR();
    }

    if (IN(5)) {
        PHASE_IDS();
        constexpr int NSCAN = 96;
        if (bx < NSCAN) {
            const int head = 3 * (bx & 7) + (bx >> 5), rb = (bx >> 3) & 3, gk = lane >> 4, j = lane & 15, n0 = 16 * (wave & 3);
            constexpr int SP = 272, SBUF = 16 * SP;
            for (int i = tid; i < 2 * SBUF / 4; i += 512) *(LAS float*)(lds + i * 4) = 0.f;
            __syncthreads();
            int cur = 0;
            if (wave < 4) {
                const float* bsrc = PCT + ((size_t)head * 128 * 64 + n0 + j) * 64 + 16 * gk;
                const float* xsrc = SLOCT + ((size_t)head * 128 * 64 + n0 + j) * 64 + 16 * rb + 4 * gk;
                f32x4 bqs[3][4], xqs[3];
#define S2_LOAD(set, cc) do { const int cl_ = (cc) < 127 ? (cc) : 127; _Pragma("unroll") for (int q4 = 0; q4 < 4; ++q4) bqs[set][q4] = *(const GAS f32x4*)(bsrc + (size_t)cl_ * 4096 + 4 * q4); \
                    xqs[set] = *(const GAS f32x4*)(xsrc + (size_t)cl_ * 4096); } while (0)
#define S2_STEP(set, cc) do { f32x4 a4[4]; _Pragma("unroll") for (int q4 = 0; q4 < 4; ++q4) a4[q4] = *(LAS const f32x4*)(lds + cur * SBUF + j * SP + (16 * gk + 4 * q4) * 4); \
                    f32x4 acc[4]; _Pragma("unroll") for (int e = 0; e < 4; ++e) acc[e] = (f32x4){0.f, 0.f, 0.f, 0.f}; \
                    _Pragma("unroll") for (int q4 = 0; q4 < 4; ++q4) _Pragma("unroll") for (int e = 0; e < 4; ++e) acc[e] = __builtin_amdgcn_mfma_f32_16x16x4f32(a4[q4][e], bqs[set][q4][e], acc[e], 0, 0, 0); \
                    const f32x4 sum = (acc[0] + acc[1]) + (acc[2] + acc[3]) + xqs[set]; \
                    _Pragma("unroll") for (int r = 0; r < 4; ++r) *(LAS float*)(lds + (cur ^ 1) * SBUF + (4 * gk + r) * SP + (n0 + j) * 4) = sum[r]; \
                    S2_LOAD(set, (cc) + 3); __syncthreads(); cur ^= 1; } while (0)
                S2_LOAD(0, 0); S2_LOAD(1, 1); S2_LOAD(2, 2);
                for (int c = 0; c < 126; c += 3) { S2_STEP(0, c); S2_STEP(1, c + 1); S2_STEP(2, c + 2); } S2_STEP(0, 126); S2_STEP(1, 127);
#undef S2_LOAD
#undef S2_STEP
            } else {
                const int srow = 4 * (wave - 4) + (lane >> 4), sk = 4 * (lane & 15);
                bf16* dst = S0ALL + ((size_t)head * 128 * 64 + 16 * rb + srow) * 64 + sk;
                for (int c = 0; c < 128; ++c) { const f32x4 sv = *(LAS const f32x4*)(lds + cur * SBUF + srow * SP + sk * 4); *(GAS v2u*)(dst + (size_t)c * 4096) = (v2u){pk2(sv[0], sv[1]), pk2(sv[2], sv[3])}; __syncthreads(); cur ^= 1; }
            }
        }
        {
            const int GA = G - NSCAN, ca = bx - NSCAN;
            float thr;
            {
                const float* gq = args.in[I_SBQG]; const float* gk = args.in[I_SBKG];
                float mq = fmaxf(fabsf(gq[lane]), fabsf(gq[lane + 64])), mk = fmaxf(fabsf(gk[lane]), fabsf(gk[lane + 64]));
#pragma unroll
                for (int o = 1; o < 64; o <<= 1) { mq = fmaxf(mq, __shfl_xor(mq, o)); mk = fmaxf(mk, __shfl_xor(mk, o)); }
                thr = (11.3137085f * 1.02f * mq * mk + 104.0f) * 1.4426950408889634f;
            }
            constexpr int KPITCH = 272, VPITCH = 136, KBUF = 64 * KPITCH, VBUF = 128 * VPITCH, VOFF = 2 * KBUF, FLAGOFF = VOFF + 2 * VBUF, UQOFF = FLAGOFF + 64;
            const int hh = lane >> 5, l31 = lane & 31;
            __syncthreads();
            for (;;) {
                if (tid == 0) *(LAS int*)(lds + UQOFF) = (int)__hip_atomic_fetch_add((unsigned*)(ctl + CW_Q2), 1u, __ATOMIC_RELAXED, __HIP_MEMORY_SCOPE_AGENT);
                __syncthreads();
                const int uidx = *(LAS const int*)(lds + UQOFF);
                if (uidx >= 12 * 32) break;
                const int head = uidx % 12, qb = 31 - uidx / 12;
                const int q0 = qb * 256 + wave * 32, qi = q0 + l31;
                bf16x8 qf[8];
                { const bf16* qp = QN + (size_t)qi * 1536 + head * 128 + 8 * hh;
#pragma unroll
                  for (int s = 0; s < 8; ++s) qf[s] = *(const GAS bf16x8*)(qp + 16 * s); }
                f32x16 o[4];
#pragma unroll
                for (int c = 0; c < 4; ++c)
#pragma unroll
                    for (int r = 0; r < 16; ++r) o[c][r] = 0.f;
                float carry = 0.f; bool mydone = false;
                const int kkey = tid >> 3, kc = (tid & 7) * 2, vhd = tid >> 2, vp = tid & 3;
                const unsigned kofs = (unsigned)(kkey * 1536 + kc * 8) * 2u, vofs = (unsigned)(vhd * T + vp * 16) * 2u;
                const char* kgb = (const char*)KN + (size_t)head * 256; const char* vgb = (const char*)VT + (size_t)head * 128 * T * 2;
                v4u kr0, kr1, vr0, vr1;
#define SB_LOAD(kt_) do { const char* kb_ = kgb + (size_t)(kt_) * 64 * 1536 * 2; const char* vb_ = vgb + (size_t)(kt_) * 128; \
                          kr0 = *(const GAS v4u*)(kb_ + kofs); kr1 = *(const GAS v4u*)(kb_ + kofs + 16); vr0 = *(const GAS v4u*)(vb_ + vofs); vr1 = *(const GAS v4u*)(vb_ + vofs + 16); } while (0)
#define SB_STORE(buf_) do { LAS unsigned char* kd = lds + (buf_) * KBUF + kkey * KPITCH + kc * 16; *(LAS v4u*)kd = kr0; *(LAS v4u*)(kd + 16) = kr1; \
                          LAS unsigned char* vd = lds + VOFF + (buf_) * VBUF + vhd * VPITCH + vp * 32; *(LAS v2u*)vd = (v2u){vr0.x, vr0.y}; *(LAS v2u*)(vd + 8) = (v2u){vr0.z, vr0.w}; \
                          *(LAS v2u*)(vd + 16) = (v2u){vr1.x, vr1.y}; *(LAS v2u*)(vd + 24) = (v2u){vr1.z, vr1.w}; } while (0)
                int kt = 4 * qb + 3, cur = 0, it = 0;
                SB_LOAD(kt); SB_STORE(0); __syncthreads();
                for (;;) {
                    const bool more = kt > 0;
                    if (more) SB_LOAD(kt - 1);
                    const int k0 = kt * 64;
                    if (!mydone && k0 < q0 + 31) {
                        LAS const unsigned char* Kb = lds + cur * KBUF; LAS const unsigned char* Vb = lds + VOFF + cur * VBUF;
                        bf16x8 wf[2][2];
#pragma unroll
                        for (int b = 1; b >= 0; --b) {
                            f32x16 z;
#pragma unroll
                            for (int r = 0; r < 16; ++r) z[r] = 0.f;
#pragma unroll
                            for (int s = 0; s < 8; ++s) { const bf16x8 kf = *(LAS const bf16x8*)(Kb + (32 * b + l31) * KPITCH + (16 * s + 8 * hh) * 2);
                                z = __builtin_amdgcn_mfma_f32_32x32x16_bf16(kf, qf[s], z, 0, 0, 0); }
                            float sp[16];
                            const int lim = qi - k0 - 32 * b - 4 * hh;
#pragma unroll
                            for (int r = 0; r < 16; ++r) { const float zz = z[r];
                                const float v = fmaxf(zz, 0.f) + __builtin_amdgcn_logf(1.0f + __builtin_amdgcn_exp2f(-fabsf(zz))); sp[r] = (((r & 3) + 8 * (r >> 2)) < lim) ? v : 0.f; }
                            float Gs[4], Gp[4], Tt[4];
#pragma unroll
                            for (int i = 0; i < 4; ++i) { Gs[i] = (sp[4 * i] + sp[4 * i + 1]) + (sp[4 * i + 2] + sp[4 * i + 3]); Gp[i] = __shfl_xor(Gs[i], 32); Tt[i] = Gs[i] + Gp[i]; }
                            float X[4]; X[3] = 0.f; X[2] = Tt[3]; X[1] = X[2] + Tt[2]; X[0] = X[1] + Tt[1];
                            unsigned wp[8];
#pragma unroll
                            for (int i = 0; i < 4; ++i) {
                                const float newer = carry + X[i] + (hh == 0 ? Gp[i] : 0.f);
                                const float t3 = newer + sp[4 * i + 3], t2 = t3 + sp[4 * i + 2], t1 = t2 + sp[4 * i + 1], t0 = t1 + sp[4 * i];
                                const float tl[4] = {t0, t1, t2, t3}; float w[4];
#pragma unroll
                                for (int j = 0; j < 4; ++j) { const float e = __builtin_amdgcn_exp2f(z[4 * i + j] - tl[j]); w[j] = ((j + 8 * i) < lim) ? e : 0.f; }
                                wp[2 * i] = pk2(w[0], w[1]); wp[2 * i + 1] = pk2(w[2], w[3]);
                            }
                            carry += X[0] + Tt[0];
                            wf[b][0] = __builtin_bit_cast(bf16x8, (v4u){wp[0], wp[1], wp[2], wp[3]}); wf[b][1] = __builtin_bit_cast(bf16x8, (v4u){wp[4], wp[5], wp[6], wp[7]});
                        }
#pragma unroll
                        for (int b = 0; b < 2; ++b)
#pragma unroll
                            for (int s = 0; s < 2; ++s)
#pragma unroll
                                for (int c = 0; c < 4; ++c) { LAS const unsigned char* vpz = Vb + (32 * c + l31) * VPITCH + (32 * b + 16 * s + 4 * hh) * 2;
                                    const v2u va = *(LAS const v2u*)vpz, vb2 = *(LAS const v2u*)(vpz + 16);
                                    const bf16x8 vf = __builtin_bit_cast(bf16x8, (v4u){va.x, va.y, vb2.x, vb2.y});
                                    o[c] = __builtin_amdgcn_mfma_f32_32x32x16_bf16(vf, wf[b][s], o[c], 0, 0, 0); }
                        mydone = __all(carry > thr);
                    }
                    if (more) SB_STORE(cur ^ 1);
                    if (lane == 0) *(LAS unsigned*)(lds + FLAGOFF + ((it & 1) * 8 + wave) * 4) = mydone ? 1u : 0u;
                    __syncthreads();
                    if (!more) break;
                    { const v4u f0 = *(LAS const v4u*)(lds + FLAGOFF + (it & 1) * 32), f1 = *(LAS const v4u*)(lds + FLAGOFF + (it & 1) * 32 + 16);
                      if ((f0.x & f0.y & f0.z & f0.w & f1.x & f1.y & f1.z & f1.w) != 0u) break; }
                    --kt; cur ^= 1; ++it;
                }
#undef SB_LOAD
#undef SB_STORE
                bf16* op = OCAT + (size_t)qi * 4096 + head * 128 + 4 * hh;
#pragma unroll
                for (int c = 0; c < 4; ++c)
#pragma unroll
                    for (int i = 0; i < 4; ++i) *(GAS v2u*)(op + 32 * c + 8 * i) = (v2u){pk2(o[c][4 * i], o[c][4 * i + 1]), pk2(o[c][4 * i + 2], o[c][4 * i + 3])};
                __syncthreads();
            }
            if (bx >= NSCAN) { int nt4 = 4; asm volatile("" : "+s"(nt4)); pg8::SchedHeads S; S.G = GA; S.c = ca; S.nunits = 128; S.nt = nt4; S.A0 = (const char*)PM; S.B0 = (const char*)MVT; S.sA = 256 * 1024 * 2; S.hA = 512; S.hB = 256 * 1024 * 2;
              pg8::EpiBf16 E{OCAT, 4096, 3072, 256};
              pg8::gemm_phase(lds, 1024, 1024, S, E); }
        }
        if (BOTH(4)) GRID_BAR();
    }

    if (IN(6)) {
        PHASE_IDS();
        {
            const float* lng = args.in[I_RWLNG]; const float* lnb = args.in[I_RWLNB];
            const int l31 = lane & 31, lh = lane >> 5, sub = wave >> 2, mt = (wave >> 1) & 1, nt = wave & 1;
            LAS float* xch = (LAS float*)lds;
            for (int it0 = 2 * bx; it0 < 24 * 128; it0 += 2 * G) {
                const int unit = it0 + sub, item = ((unit % 24) << 7) + unit / 24, head = item >> 7, chunk = item & 127;
                const int tq = 32 * nt + l31; const size_t trow = (size_t)(chunk * 64 + tq);
                const bf16* ap = S0ALL + ((size_t)item * 64 + 32 * mt + l31) * 64 + 8 * lh;
                const bf16* bp = PHIT + ((size_t)item * 64 + tq) * 64 + 8 * lh;
                v4u af[4], bfv[4];
#pragma unroll
                for (int ks = 0; ks < 4; ++ks) { af[ks] = *(const GAS v4u*)(ap + 16 * ks); bfv[ks] = *(const GAS v4u*)(bp + 16 * ks); }
                f32x4 yl[4], vv4[4]; v2u gg[4];
                { const int vc = head * 64 + 32 * mt + 4 * lh; const float* yp = Y + trow * 1536 + vc; const bf16* gp = GB + trow * 1536 + vc;
                  const bf16* pc = P + trow * NINP + PRW + 3072 + vc; const float* mxp = args.in[I_RWMIX] + 3072 + vc;
#pragma unroll
                  for (int i = 0; i < 4; ++i) { yl[i] = *(const GAS f32x4*)(yp + 8 * i); gg[i] = *(const GAS v2u*)(gp + 8 * i);
                      const v2u c2 = *(const GAS v2u*)(pc + 8 * i); v2u p2 = (v2u){0u, 0u}; if (trow > 0) p2 = *(const GAS v2u*)(pc - NINP + 8 * i); const f32x4 mx = *(const GAS f32x4*)(mxp + 8 * i);
                      const float cv4[4] = {bflo(c2.x), bfhi(c2.x), bflo(c2.y), bfhi(c2.y)}, pv4[4] = {bflo(p2.x), bfhi(p2.x), bflo(p2.y), bfhi(p2.y)};
#pragma unroll
                      for (int e = 0; e < 4; ++e) vv4[i][e] = cv4[e] + (pv4[e] - cv4[e]) * mx[e]; } }
                const float bon = BONUS[trow * 24 + head];
                f32x16 acc;
#pragma unroll
                for (int r = 0; r < 16; ++r) acc[r] = 0.f;
#pragma unroll
                for (int ks = 0; ks < 4; ++ks) {
                    acc = __builtin_amdgcn_mfma_f32_32x32x16_bf16(__builtin_bit_cast(bf16x8, af[ks]), __builtin_bit_cast(bf16x8, bfv[ks]), acc, 0, 0, 0); }
                float yv[16]; float s1 = 0.f, s2 = 0.f;
#pragma unroll
                for (int i = 0; i < 4; ++i)
#pragma unroll
                    for (int e = 0; e < 4; ++e) { const float y = acc[4 * i + e] + yl[i][e]; yv[4 * i + e] = y; s1 += y; s2 += y * y; }
                s1 += __shfl_xor(s1, 32); s2 += __shfl_xor(s2, 32);
                if (lh == 0) { xch[((sub * 2 + mt) * 64 + tq) * 2] = s1; xch[((sub * 2 + mt) * 64 + tq) * 2 + 1] = s2; }
                __syncthreads();
                { const float o1 = xch[((sub * 2 + (mt ^ 1)) * 64 + tq) * 2], o2 = xch[((sub * 2 + (mt ^ 1)) * 64 + tq) * 2 + 1]; s1 += o1; s2 += o2; }
                const float mu = s1 * (1.f / 64.f), var = fmaxf(s2 * (1.f / 64.f) - mu * mu, 0.f), rstd = 1.0f / sqrtf(var + GN_EPS);
                bf16* op = OCAT + trow * 4096 + 1536 + head * 64 + 32 * mt + 4 * lh;
#pragma unroll
                for (int i = 0; i < 4; ++i) { const int vb = head * 64 + 32 * mt + 8 * i + 4 * lh; const f32x4 gv = *(const GAS f32x4*)(lng + vb), bv = *(const GAS f32x4*)(lnb + vb);
                    const float g4[4] = {bflo(gg[i].x), bfhi(gg[i].x), bflo(gg[i].y), bfhi(gg[i].y)}; float o[4];
#pragma unroll
                    for (int e = 0; e < 4; ++e) o[e] = ((yv[4 * i + e] - mu) * rstd * gv[e] + bv[e] + bon * vv4[i][e]) * g4[e];
                    *(GAS v2u*)(op + 8 * i) = (v2u){pk2(o[0], o[1]), pk2(o[2], o[3])}; }
                __syncthreads();
            }
        }
        {
            LAS float* scr = (LAS float*)(lds + wave * 16384);
            for (int qi = gw; qi < Q2_ITEMS; qi += NGW) Q2_BODY;
        }
        if (BOTH(6)) GRID_BAR();
    }

    if (IN(7)) {
        PHASE_IDS();
        pg8::SchedMerge S; S.to.init(32, 16); S.G = G; S.c = bx; S.OC = (const char*)OCAT; S.WC = (const char*)WCAT_T;
        pg8::EpiMerge E{P, MERGED};
        pg8::gemm_phase(lds, 4096, 4096, S, E);
        if (BOTH(7)) GRID_BAR();
    }

    if (IN(8)) {
        PHASE_IDS();
        pg8::SchedPlain S; S.to.init(32, 16); S.G = G; S.c = bx; S.nt = 64; S.A0 = (const char*)MERGED; S.B0 = (const char*)WOUT_T; S.sA = (size_t)256 * 4096 * 2; S.sB = (size_t)256 * 4096 * 2;
        pg8::EpiResF32 E{args.in[I_X], H1};
        pg8::gemm_phase(lds, 4096, 4096, S, E);
        if (BOTH(8)) GRID_BAR();
    }

    if (IN(9)) {
        PHASE_IDS();
        rms_rows4096(H1, args.in[I_FFNG], XN, gw, NGW, T, lane);
        if (BOTH(9)) GRID_BAR();
    }

    if (IN(10)) {
        PHASE_IDS();
        pg8::SchedPlain S; S.to.init(32, 86); S.G = G; S.c = bx; S.nt = 64; S.A0 = (const char*)XN; S.B0 = (const char*)WGU_T; S.sA = (size_t)256 * 4096 * 2; S.sB = (size_t)256 * 4096 * 2;
        pg8::EpiSwiGLU E{ACT};
        pg8::gemm_phase(lds, 4096, 4096, S, E);
        if (BOTH(10)) GRID_BAR();
    }

    if (IN(11)) {
        PHASE_IDS();
        pg8::SchedPlain S; S.to.init(32, 16); S.G = G; S.c = bx; S.nt = 172; S.A0 = (const char*)ACT; S.B0 = (const char*)WD_T; S.sA = (size_t)256 * DFF * 2; S.sB = (size_t)256 * DFF * 2;
        pg8::EpiResF32 E{H1, args.out};
        pg8::gemm_phase(lds, DFF, DFF, S, E);
    }
#undef IN
#undef BOTH
}

extern "C" void kernel_launch(void* const* d_in, const int* in_sizes, int n_in, void* d_out, int out_size, void* d_ws, size_t ws_size, hipStream_t stream) {
    static int grid = 0;
    if (grid == 0) {
        if (n_in != 29 || in_sizes[0] != T * D || out_size != T * D || ws_size < WS_END) {
            fprintf(stderr, "kernel_launch: unexpected problem (n_in %d, in0 %d, out %d, ws %zu, need %zu); nothing launched\n", n_in, n_in > 0 ? in_sizes[0] : -1, out_size, ws_size, (size_t)WS_END); grid = -1; return; }
        int dev = 0, cus = 0, per_cu = 0;
        if (hipGetDevice(&dev) != hipSuccess || hipDeviceGetAttribute(&cus, hipDeviceAttributeMultiprocessorCount, dev) != hipSuccess) { grid = -1; return; }
        if (hipFuncSetAttribute((const void*)hybrid_fwd, hipFuncAttributeMaxDynamicSharedMemorySize, LDS_BYTES) != hipSuccess) { fprintf(stderr, "kernel_launch: hipFuncSetAttribute failed\n"); grid = -1; return; }
        if (hipOccupancyMaxActiveBlocksPerMultiprocessor(&per_cu, (const void*)hybrid_fwd, NWAVES * 64, LDS_BYTES) != hipSuccess || per_cu < 1)
            fprintf(stderr, "kernel_launch: note: occupancy query reports %d workgroups per CU\n", per_cu);
        (void)hipGetLastError();
        grid = cus;
    }
    if (grid < 0) return;
    if (hipMemsetAsync((char*)d_ws + WS_CTL, 0, CTL_ZERO_BYTES, stream) != hipSuccess) return;
    Args a{};
    for (int i = 0; i < 29; ++i) a.in[i] = (const float*)d_in[i];
    a.out = (float*)d_out; a.ws = (unsigned char*)d_ws;
#if MK_PER_PHASE
    for (int p = 0; p < NPHASES; ++p) { a.ph_lo = p; a.ph_hi = p + 1; hipLaunchKernelGGL(hybrid_fwd, dim3(grid), dim3(NWAVES * 64), LDS_BYTES, stream, a); }
#else
    a.ph_lo = 0; a.ph_hi = NPHASES;
    hipLaunchKernelGGL(hybrid_fwd, dim3(grid), dim3(NWAVES * 64), LDS_BYTES, stream, a);
#endif
}
```

```cpp
#include <hip/hip_runtime.h>
#include <cstdio>
#include <cstdint>

#ifndef MK_PER_PHASE
#define MK_PER_PHASE 0
#endif

constexpr int T = 8192, D = 4096, NMEM = 256;
constexpr int SBW = 1536, RWW = 1536, MEMW = 1024, RWSEG = 5344, DFF = 11008;
constexpr int NIN_ORIG = 23264, NINP = 23296;
constexpr int PQ = 0, PK = 1536, PV = 3072, PRW = 4608, PMQ = 9984, PG = 11008;
constexpr float RMS_EPS = 1e-6f, GN_EPS = 64e-5f;

constexpr size_t MiB = 1u << 20;
constexpr size_t WS_CTL = 0, CTL_ZERO_BYTES = 256 * 1024;
constexpr size_t WS_WIN_T = 1 * MiB;
constexpr size_t WS_WCAT_T = WS_WIN_T + 182 * MiB;
constexpr size_t WS_WOUT_T = WS_WCAT_T + 32 * MiB;
constexpr size_t WS_WKV_T = WS_WOUT_T + 32 * MiB;
constexpr size_t WS_LBWA = WS_WKV_T + 16 * MiB;
constexpr size_t WS_LBG = WS_LBWA + 2 * MiB;
constexpr size_t WS_XN = WS_LBG + 2 * MiB;
constexpr size_t WS_MEMN = WS_XN + 64 * MiB;
constexpr size_t WS_P = WS_MEMN + 2 * MiB;
constexpr size_t WS_R = WS_P + 364 * MiB;
constexpr size_t RSZ = 48 * MiB;
constexpr size_t WS_G = WS_R + 6 * RSZ;
constexpr size_t WS_Y = WS_G + 24 * MiB;
constexpr size_t WS_OCAT = WS_Y + 48 * MiB;
constexpr size_t WS_LATE = WS_OCAT + 64 * MiB;
constexpr size_t WS_QN = WS_LATE;
constexpr size_t WS_KN = WS_QN + 24 * MiB;
constexpr size_t WS_VT = WS_KN + 24 * MiB;
constexpr size_t WS_MQN = WS_VT + 24 * MiB;
constexpr size_t WS_MKRAW = WS_MQN + 16 * MiB;
constexpr size_t WS_MKN = WS_MKRAW + 1 * MiB;
constexpr size_t WS_MVT = WS_MKN + 1 * MiB;
constexpr size_t WS_SM = WS_MVT + 2 * MiB;
constexpr size_t WS_PM = WS_SM + 32 * MiB;
constexpr size_t WS_LA1 = WS_PM + 16 * MiB;
constexpr size_t WS_LA2 = WS_LA1 + 4 * MiB;
constexpr size_t WS_EARLY_END = WS_LA2 + 8 * MiB;
constexpr size_t WS_PHIT = WS_EARLY_END;
constexpr size_t WS_PCT = WS_PHIT + 48 * MiB;
constexpr size_t WS_SLOCT = WS_PCT + 48 * MiB;
constexpr size_t WS_BONUS = WS_SLOCT + 48 * MiB;
constexpr size_t WS_RWKV_END = WS_BONUS + 1 * MiB;
constexpr size_t WS_WGU_T = WS_WIN_T;
constexpr size_t WS_WD_T = WS_R + 2 * RSZ;
constexpr size_t WS_END = WS_RWKV_END;
constexpr size_t WS_MERGED = WS_R;
constexpr size_t WS_H1 = WS_LATE;
constexpr size_t WS_ACT = WS_P;
static_assert(WS_H1 + 128 * MiB <= WS_EARLY_END && WS_WD_T + 86 * MiB <= WS_R + 4 * RSZ, "H1 / W_down copy homes");
static_assert(WS_END <= 1454ull * MiB, "workspace map exceeds the guaranteed 4x largest tensor");

constexpr int CW_TMO = 0, CW_CODE = 1, CW_BAR = 4096, CW_Q1 = 32768, CW_Q2 = 32768 + 64;

constexpr int RING_BYTES = 131072, LDSCTL_OFF = 159744, MISC_OFF = LDSCTL_OFF + 320, LDS_BYTES = 163840;
constexpr int NWAVES = 8;

#define GAS __attribute__((address_space(1)))
#define LAS __attribute__((address_space(3)))
typedef unsigned short bf16;
typedef unsigned v4u __attribute__((ext_vector_type(4)));
typedef unsigned v2u __attribute__((ext_vector_type(2)));
typedef float f32x4 __attribute__((ext_vector_type(4)));
typedef float f32x2 __attribute__((ext_vector_type(2)));
typedef float f32x16 __attribute__((ext_vector_type(16)));
typedef short bf16x8 __attribute__((ext_vector_type(8)));
typedef short s16x4 __attribute__((ext_vector_type(4)));
typedef GAS unsigned gu32;

typedef __bf16 hwbf16x2 __attribute__((ext_vector_type(2)));
__device__ __forceinline__ unsigned pk2(float lo, float hi) { const f32x2 v = {lo, hi}; return __builtin_bit_cast(unsigned, __builtin_convertvector(v, hwbf16x2)); }
__device__ __forceinline__ unsigned f2bf(float f) { return pk2(f, 0.f) & 0xffffu; }
__device__ __forceinline__ float bflo(unsigned w) { return __builtin_bit_cast(float, w << 16); }
__device__ __forceinline__ float bfhi(unsigned w) { return __builtin_bit_cast(float, w & 0xffff0000u); }
__device__ __forceinline__ float fexp(float x) { return __builtin_amdgcn_exp2f(x * 1.44269504088896f); }
__device__ __forceinline__ float flog(float x) { return __builtin_amdgcn_logf(x) * 0.693147180559945f; }
__device__ __forceinline__ float frcp(float x) { return __builtin_amdgcn_rcpf(x); }
__device__ __forceinline__ float sigmoidf_(float x) { return frcp(1.0f + fexp(-x)); }
__device__ __forceinline__ float softplusf_(float x) { return fmaxf(x, 0.f) + flog(1.0f + fexp(-fabsf(x))); }
__device__ __forceinline__ float wave_sum(float v) {
#pragma unroll
    for (int o = 1; o < 64; o <<= 1) v += __shfl_xor(v, o);
    return v;
}
__device__ __forceinline__ float dpp_f(float x, const int ctrl_sel) {
    return x;
}
#define DPP_ADD(x, ctrl) ((x) + __builtin_bit_cast(float, __builtin_amdgcn_update_dpp(0, __builtin_bit_cast(int, (x)), (ctrl), 0xF, 0xF, true)))
#define DPP_MAX(x, ctrl) fmaxf((x), __builtin_bit_cast(float, __builtin_amdgcn_update_dpp(0, __builtin_bit_cast(int, (x)), (ctrl), 0xF, 0xF, true)))
__device__ __forceinline__ float quad_bcast(float x, int g) {
    const int xi = __builtin_bit_cast(int, x);
    switch (g) {
        case 0: return __builtin_bit_cast(float, __builtin_amdgcn_update_dpp(0, xi, 0x00, 0xF, 0xF, true));
        case 1: return __builtin_bit_cast(float, __builtin_amdgcn_update_dpp(0, xi, 0x55, 0xF, 0xF, true));
        case 2: return __builtin_bit_cast(float, __builtin_amdgcn_update_dpp(0, xi, 0xAA, 0xF, 0xF, true));
        default: return __builtin_bit_cast(float, __builtin_amdgcn_update_dpp(0, xi, 0xFF, 0xF, 0xF, true));
    }
}
__device__ __forceinline__ float red16_sum(float x) {
    x = DPP_ADD(x, 0xB1); x = DPP_ADD(x, 0x4E); x = DPP_ADD(x, 0x141); x = DPP_ADD(x, 0x140); return x;
}
__device__ __forceinline__ float wave_sum_u(float x) {
    x = red16_sum(x);
    x += __builtin_bit_cast(float, __builtin_amdgcn_update_dpp(0, __builtin_bit_cast(int, x), 0x142, 0xA, 0xF, false));
    x += __builtin_bit_cast(float, __builtin_amdgcn_update_dpp(0, __builtin_bit_cast(int, x), 0x143, 0xC, 0xF, false));
    return __builtin_bit_cast(float, __builtin_amdgcn_readlane(__builtin_bit_cast(int, x), 63));
}
__device__ __forceinline__ float red16_max(float x) {
    x = DPP_MAX(x, 0xB1); x = DPP_MAX(x, 0x4E); x = DPP_MAX(x, 0x141); x = DPP_MAX(x, 0x140); return x;
}

namespace pg8 {
#define PG8_LAS __attribute__((address_space(3)))
typedef unsigned short bf16_t;
typedef unsigned u32x4 __attribute__((ext_vector_type(4)));
constexpr int BM = 256, BK = 64, HALF = 128, HTB = HALF * BK * 2, STAGE_BYTES = 8 * HTB, NXCD = 8, WGM = 4;

__host__ __device__ __forceinline__ int lds_byte(int r, int c) { const int st = (r >> 4) * 2 + (c >> 5), rr = r & 15, cc = c & 31, ob = rr * 64 + cc * 2; return st * 1024 + (ob ^ (((ob >> 9) & 1) << 5)); }
__host__ __device__ __forceinline__ void stage_rc(int b, int& R, int& C) { const int st = b / 1024, sb = b % 1024, swz = sb ^ (((sb >> 9) & 1) << 5); R = (st >> 1) * 16 + swz / 64; C = (st & 1) * 32 + (swz % 64) / 2; }
__host__ __device__ __forceinline__ int perm32(int rho) { const int n = rho >> 4, i = rho & 15; return 8 * (i >> 2) + 4 * n + (i & 3); }

struct Unit { const char* A; const char* B; int nt, pm, pn, kind; };

struct TileOrder {
    int nM, nN, nwg;
    __device__ __forceinline__ void init(int nM_, int nN_) { nM = nM_; nN = nN_; nwg = nM_ * nN_; }
    __device__ __forceinline__ void map(int L, int& pm, int& pn) const {
        int wgid = L; { const int q = nwg / NXCD, r = nwg % NXCD, xcd = wgid % NXCD, off = wgid / NXCD; wgid = (xcd < r ? xcd * (q + 1) : r * (q + 1) + (xcd - r) * q) + off; }
        const int nig = WGM * nN, gid = wgid / nig, fm = gid * WGM, gsz = (nM - fm) < WGM ? (nM - fm) : WGM;
        pm = fm + ((wgid % nig) % gsz); pn = (wgid % nig) / gsz;
    }
};

__device__ __forceinline__ unsigned cvt_pk_bf16(float lo, float hi) { unsigned r; asm volatile("v_cvt_pk_bf16_f32 %0, %1, %2" : "=v"(r) : "v"(lo), "v"(hi)); return r; }

template <class Epi, class Sched>
__device__ __forceinline__ void gemm_phase(PG8_LAS unsigned char* lds, const int lda, const int ldb, const Sched& S, const Epi& E) {
    const int tid = threadIdx.x, wid = __builtin_amdgcn_readfirstlane(tid >> 6), lane = tid & 63, wr = wid >> 2, wc = wid & 3, fr = lane & 15, fq = lane >> 4;
    unsigned voffA[2], voffB[2];
#pragma unroll
    for (int i = 0; i < 2; ++i) { int R, C; stage_rc(tid * 16 + i * 8192, R, C); const int Rb = Epi::PERM ? ((R & ~31) + perm32(R & 31)) : R;
        voffA[i] = (unsigned)(R * lda + C) * 2u; voffB[i] = (unsigned)(Rb * ldb + C) * 2u; }
    const size_t kstep = (size_t)(BK * 2);
    const size_t hstepA = (size_t)HALF * lda * 2, hstepB = (size_t)HALF * ldb * 2;
    const unsigned ldsw = (unsigned)wid * 1024u;
    const int aoff = lds_byte(wr * 64 + fr, fq * 8), boff = lds_byte(wc * 32 + fr, fq * 8);
#define PG8_SA(b, h) (((b) * 2 + (h)) * HTB)
#define PG8_SB(b, h) ((4 + (b) * 2 + (h)) * HTB)
#define PG8_STAGE(bufoff, gbase, voff) do { _Pragma("unroll") for (int _i = 0; _i < 2; ++_i) \
        __builtin_amdgcn_global_load_lds((const unsigned*)((const char*)(gbase) + (voff)[_i]), (PG8_LAS unsigned*)(lds + (bufoff) + ldsw + _i * 8192), 16, 0, 0); } while (0)
#define PG8_LDA(dst, b, h) do { _Pragma("unroll") for (int m = 0; m < 4; ++m) _Pragma("unroll") for (int k = 0; k < 2; ++k) dst[m][k] = *(const PG8_LAS bf16x8*)(lds + PG8_SA(b, h) + aoff + m * 2048 + k * 1024); } while (0)
#define PG8_LDB(dst, b, h) do { _Pragma("unroll") for (int n = 0; n < 2; ++n) _Pragma("unroll") for (int k = 0; k < 2; ++k) dst[n][k] = *(const PG8_LAS bf16x8*)(lds + PG8_SB(b, h) + boff + n * 2048 + k * 1024); } while (0)
#define PG8_MMA(ai, bj, At, Bt) do { __builtin_amdgcn_s_setprio(1); _Pragma("unroll") for (int m = 0; m < 4; ++m) _Pragma("unroll") for (int n = 0; n < 2; ++n) _Pragma("unroll") for (int k = 0; k < 2; ++k) \
        acc[ai][bj][m][n] = __builtin_amdgcn_mfma_f32_16x16x32_bf16(Bt[n][k], At[m][k], acc[ai][bj][m][n], 0, 0, 0); __builtin_amdgcn_s_setprio(0); } while (0)
#define PG8_WAIT_V(n) asm volatile("s_waitcnt vmcnt(" #n ")" ::: "memory")
#define PG8_WAIT_L(n) asm volatile("s_waitcnt lgkmcnt(" #n ")" ::: "memory")
#define PG8_BAR __builtin_amdgcn_s_barrier()
#define PG8_SCHED __builtin_amdgcn_sched_barrier(0)
    Unit cur, nxt; int ui = 0;
    if (!S.next(0, cur)) return;
    f32x4 acc[2][2][4][2];
#pragma unroll
    for (int a = 0; a < 2; ++a)
#pragma unroll
        for (int b = 0; b < 2; ++b)
#pragma unroll
            for (int m = 0; m < 4; ++m)
#pragma unroll
                for (int n = 0; n < 2; ++n) acc[a][b][m][n] = (f32x4){0.f, 0.f, 0.f, 0.f};
    bf16x8 At[4][2], B0[2][2], B1[2][2];
    const char* cA = cur.A; const char* cB = cur.B; int nt = cur.nt;
    PG8_STAGE(PG8_SB(0, 0), cB, voffB); PG8_STAGE(PG8_SB(0, 1), cB + hstepB, voffB); PG8_STAGE(PG8_SA(0, 0), cA, voffA); PG8_STAGE(PG8_SA(0, 1), cA + hstepA, voffA);
    if (wr == 1) PG8_BAR;
    PG8_WAIT_V(2); PG8_BAR;
    PG8_STAGE(PG8_SB(1, 0), cB + kstep, voffB); PG8_STAGE(PG8_SA(1, 0), cA + kstep, voffA); PG8_STAGE(PG8_SB(1, 1), cB + hstepB + kstep, voffB);
    PG8_WAIT_V(6); PG8_BAR;
    for (;;) {
        const bool has_next = S.next(ui + 1, nxt);
        const char* nA = has_next ? nxt.A : cA; const char* nB = has_next ? nxt.B : cB;
        for (int t = 0; t < nt; t += 2) {
            const bool last = (t == nt - 2);
            const char* a1 = cA + (size_t)(t + 1) * kstep;
            const char* a2 = last ? nA : cA + (size_t)(t + 2) * kstep; const char* b2 = last ? nB : cB + (size_t)(t + 2) * kstep;
            const char* a3 = a2 + kstep; const char* b3 = b2 + kstep;
            PG8_LDB(B0, 0, 0); PG8_LDB(B1, 0, 1); PG8_SCHED; PG8_LDA(At, 0, 0); PG8_STAGE(PG8_SA(1, 1), a1 + hstepA, voffA);
            PG8_WAIT_V(8); PG8_WAIT_L(0); PG8_BAR; PG8_MMA(0, 0, At, B0); PG8_MMA(0, 1, At, B1); PG8_BAR; PG8_SCHED;
            PG8_LDA(At, 0, 1); PG8_STAGE(PG8_SB(0, 0), b2, voffB); PG8_STAGE(PG8_SB(0, 1), b2 + hstepB, voffB); PG8_STAGE(PG8_SA(0, 0), a2, voffA);
            PG8_WAIT_V(8); PG8_WAIT_L(0); PG8_BAR; PG8_MMA(1, 0, At, B0); PG8_MMA(1, 1, At, B1); PG8_BAR; PG8_SCHED;
            PG8_LDB(B0, 1, 0); PG8_LDB(B1, 1, 1); PG8_SCHED; PG8_LDA(At, 1, 0); PG8_STAGE(PG8_SA(0, 1), a2 + hstepA, voffA);
            PG8_WAIT_V(8); PG8_WAIT_L(0); PG8_BAR; PG8_MMA(0, 0, At, B0); PG8_MMA(0, 1, At, B1); PG8_BAR; PG8_SCHED;
            PG8_LDA(At, 1, 1); PG8_STAGE(PG8_SB(1, 0), b3, voffB); PG8_STAGE(PG8_SB(1, 1), b3 + hstepB, voffB); PG8_STAGE(PG8_SA(1, 0), a3, voffA);
            PG8_WAIT_V(8); PG8_WAIT_L(0); PG8_BAR; PG8_MMA(1, 0, At, B0); PG8_MMA(1, 1, At, B1); PG8_BAR; PG8_SCHED;
        }
        if (wr == 0) PG8_BAR;
        const bool keep = E(acc, cur, wr, wc, fr, fq);
        if (!has_next) break;
        if (!keep) {
#pragma unroll
            for (int a = 0; a < 2; ++a)
#pragma unroll
                for (int b = 0; b < 2; ++b)
#pragma unroll
                    for (int m = 0; m < 4; ++m)
#pragma unroll
                        for (int n = 0; n < 2; ++n) acc[a][b][m][n] = (f32x4){0.f, 0.f, 0.f, 0.f};
        }
        cur = nxt; cA = nA; cB = nB; nt = cur.nt; ++ui;
        if (wr == 1) PG8_BAR;
    }
    PG8_WAIT_V(0);
    PG8_BAR;
#undef PG8_SA
#undef PG8_SB
#undef PG8_STAGE
#undef PG8_LDA
#undef PG8_LDB
#undef PG8_MMA
#undef PG8_WAIT_V
#undef PG8_WAIT_L
#undef PG8_BAR
#undef PG8_SCHED
}

struct SchedPlain {
    TileOrder to; int G, c, nt; const char* A0; const char* B0; size_t sA, sB;
    __device__ __forceinline__ bool next(int i, Unit& u) const {
        const int L = i * G + c; if (L >= to.nwg) return false;
        int pm, pn; to.map(L, pm, pn); u.A = A0 + (size_t)pm * sA; u.B = B0 + (size_t)pn * sB; u.nt = nt; u.pm = pm; u.pn = pn; u.kind = 0; return true;
    }
};
struct SchedGemm1 {
    TileOrder to; int G, c; const char *XN, *WIN, *MEMN, *WKV;
    __device__ __forceinline__ bool next(int i, Unit& u) const {
        const int L = i * G + c; u.nt = 64;
        if (L < to.nwg) { int pm, pn; to.map(L, pm, pn); u.A = XN + (size_t)pm * 256 * 4096 * 2; u.B = WIN + (size_t)pn * 256 * 4096 * 2; u.pm = pm; u.pn = pn; u.kind = 0; return true; }
        const int e = L - to.nwg; if (e >= 8) return false;
        if (e < 4) { u.A = MEMN; u.B = WKV + (size_t)e * 256 * 4096 * 2; u.pm = 0; u.pn = e; u.kind = 1; }
        else { u.A = WKV + (size_t)(1024 + 256 * (e - 4)) * 4096 * 2; u.B = MEMN; u.pm = e - 4; u.pn = 0; u.kind = 2; }
        return true;
    }
};
struct SchedHeads {
    int G, c, nunits, nt; const char* A0; const char* B0; size_t sA, hA, hB;
    __device__ __forceinline__ bool next(int i, Unit& u) const {
        const int L = i * G + c; if (L >= nunits) return false;
        const int pm = L & 31, h = L >> 5; u.A = A0 + (size_t)pm * sA + (size_t)h * hA; u.B = B0 + (size_t)h * hB; u.nt = nt; u.pm = pm; u.pn = 0; u.kind = h; return true;
    }
};
struct SchedMerge {
    TileOrder to; int G, c; const char* OC; const char* WC;
    __device__ __forceinline__ bool next(int i, Unit& u) const {
        const int ti = i / 3, b = i - 3 * ti; const int L = ti * G + c; if (L >= to.nwg) return false;
        int pm, pn; to.map(L, pm, pn); const int koff = b * 1536;
        u.A = OC + ((size_t)pm * 256 * 4096 + koff) * 2; u.B = WC + ((size_t)pn * 256 * 4096 + koff) * 2; u.nt = (b < 2) ? 24 : 16; u.pm = pm; u.pn = pn; u.kind = b; return true;
    }
};

struct EpiGemm1 {
    static constexpr bool PERM = true;
    bf16_t *P, *MK, *MVT;
    __device__ __forceinline__ bool operator()(f32x4 (&acc)[2][2][4][2], const Unit& u, int wr, int wc, int fr, int fq) const {
        bf16_t* base; int ldc;
        if (u.kind == 0) { base = P + (size_t)u.pm * 256 * NINP + u.pn * 256; ldc = NINP; }
        else if (u.kind == 1) { base = MK + u.pn * 256; ldc = 1024; }
        else { base = MVT + (size_t)u.pm * 256 * 1024; ldc = 1024; }
        base += (size_t)(wr * 64 + fr) * ldc + wc * 32 + 8 * fq;
#pragma unroll
        for (int ai = 0; ai < 2; ++ai)
#pragma unroll
            for (int m = 0; m < 4; ++m) { bf16_t* rowp = base + (size_t)(ai * HALF + m * 16) * ldc;
#pragma unroll
                for (int bj = 0; bj < 2; ++bj) { const f32x4 v0 = acc[ai][bj][m][0], v1 = acc[ai][bj][m][1];
                    u32x4 w; w.x = cvt_pk_bf16(v0[0], v0[1]); w.y = cvt_pk_bf16(v0[2], v0[3]); w.z = cvt_pk_bf16(v1[0], v1[1]); w.w = cvt_pk_bf16(v1[2], v1[3]);
                    *(u32x4*)(rowp + bj * HALF) = w; } }
        return false;
    }
};
struct EpiBf16 {
    static constexpr bool PERM = true;
    bf16_t* O; int ldc, coff, kstride;
    __device__ __forceinline__ bool operator()(f32x4 (&acc)[2][2][4][2], const Unit& u, int wr, int wc, int fr, int fq) const {
        bf16_t* base = O + (size_t)(u.pm * 256 + wr * 64 + fr) * ldc + coff + u.kind * kstride + u.pn * 256 + wc * 32 + 8 * fq;
#pragma unroll
        for (int ai = 0; ai < 2; ++ai)
#pragma unroll
            for (int m = 0; m < 4; ++m) { bf16_t* rowp = base + (size_t)(ai * HALF + m * 16) * ldc;
#pragma unroll
                for (int bj = 0; bj < 2; ++bj) { const f32x4 v0 = acc[ai][bj][m][0], v1 = acc[ai][bj][m][1];
                    u32x4 w; w.x = cvt_pk_bf16(v0[0], v0[1]); w.y = cvt_pk_bf16(v0[2], v0[3]); w.z = cvt_pk_bf16(v1[0], v1[1]); w.w = cvt_pk_bf16(v1[2], v1[3]);
                    *(u32x4*)(rowp + bj * HALF) = w; } }
        return false;
    }
};
struct EpiScoreF32 {
    static constexpr bool PERM = false;
    float* S;
    __device__ __forceinline__ bool operator()(f32x4 (&acc)[2][2][4][2], const Unit& u, int wr, int wc, int fr, int fq) const {
        float* base = S + (size_t)(u.pm * 256 + wr * 64 + fr) * 1024 + u.kind * 256 + wc * 32 + 4 * fq;
#pragma unroll
        for (int ai = 0; ai < 2; ++ai)
#pragma unroll
            for (int m = 0; m < 4; ++m) { float* rowp = base + (size_t)(ai * HALF + m * 16) * 1024;
#pragma unroll
                for (int bj = 0; bj < 2; ++bj)
#pragma unroll
                    for (int n = 0; n < 2; ++n) *(f32x4*)(rowp + bj * HALF + n * 16) = acc[ai][bj][m][n]; }
        return false;
    }
};
struct EpiLoraWA {
    static constexpr bool PERM = false;
    const float *w0, *a0; float *RW; bf16_t *RA;
    __device__ __forceinline__ bool operator()(f32x4 (&acc)[2][2][4][2], const Unit& u, int wr, int wc, int fr, int fq) const {
        const bool isw = u.pn < 6; const int cb = (isw ? u.pn : u.pn - 6) * 256 + wc * 32 + 4 * fq;
        const float* bias = (isw ? w0 : a0) + cb; const size_t eb = (size_t)(u.pm * 256 + wr * 64 + fr) * 1536 + cb;
        f32x4 bv[2][2];
#pragma unroll
        for (int bj = 0; bj < 2; ++bj)
#pragma unroll
            for (int n = 0; n < 2; ++n) bv[bj][n] = *(const f32x4*)(bias + bj * HALF + n * 16);
#pragma unroll
        for (int ai = 0; ai < 2; ++ai)
#pragma unroll
            for (int m = 0; m < 4; ++m) { const size_t ro = eb + (size_t)(ai * HALF + m * 16) * 1536;
#pragma unroll
                for (int bj = 0; bj < 2; ++bj)
#pragma unroll
                    for (int n = 0; n < 2; ++n) { f32x4 x = acc[ai][bj][m][n] + bv[bj][n]; f32x4 o;
#pragma unroll
                        for (int j = 0; j < 4; ++j) { const float sg = sigmoidf_(x[j]); o[j] = isw ? fexp(-0.6065306597126334f * sg) : sg; }
                        if (isw) *(f32x4*)(RW + ro + bj * HALF + n * 16) = o;
                        else { v2u ob; ob[0] = cvt_pk_bf16(o[0], o[1]); ob[1] = cvt_pk_bf16(o[2], o[3]); *(v2u*)(RA + ro + bj * HALF + n * 16) = ob; } } }
        return false;
    }
};
struct EpiMerge {
    static constexpr bool PERM = true;
    const bf16_t* P; bf16_t* MG;
    __device__ __forceinline__ bool operator()(f32x4 (&acc)[2][2][4][2], const Unit& u, int wr, int wc, int fr, int fq) const {
        const int b = u.kind; const int row0 = u.pm * 256 + wr * 64 + fr, col0 = u.pn * 256 + wc * 32 + 8 * fq;
        const bf16_t* gbase = P + (size_t)row0 * NINP + PG + 4096 * b + col0;
#pragma unroll
        for (int ai = 0; ai < 2; ++ai) {
            u32x4 g0v[4][2], g1v[4][2];
#pragma unroll
            for (int m = 0; m < 4; ++m)
#pragma unroll
                for (int bj = 0; bj < 2; ++bj) { const bf16_t* gp = gbase + (size_t)(ai * HALF + m * 16) * NINP + bj * HALF; g0v[m][bj] = *(const u32x4*)gp; g1v[m][bj] = (b < 2) ? *(const u32x4*)(gp + 4096) : g0v[m][bj]; }
#pragma unroll
            for (int m = 0; m < 4; ++m) { const size_t row = (size_t)(row0 + ai * HALF + m * 16);
#pragma unroll
                for (int bj = 0; bj < 2; ++bj) { const u32x4 g0 = g0v[m][bj];
                    float e0[8]; const unsigned gw0[4] = {g0.x, g0.y, g0.z, g0.w};
#pragma unroll
                    for (int j = 0; j < 4; ++j) { e0[2 * j] = 1.0f + fexp(-bflo(gw0[j])); e0[2 * j + 1] = 1.0f + fexp(-bfhi(gw0[j])); }
                    if (b < 2) { const u32x4 g1 = g1v[m][bj]; const unsigned gw1[4] = {g1.x, g1.y, g1.z, g1.w};
#pragma unroll
                        for (int j = 0; j < 4; ++j) { const float r0 = (1.0f + fexp(-bflo(gw1[j]))) * frcp(e0[2 * j]), r1 = (1.0f + fexp(-bfhi(gw1[j]))) * frcp(e0[2 * j + 1]);
                            acc[ai][bj][m][j >> 1][(2 * j) & 3] *= r0; acc[ai][bj][m][j >> 1][(2 * j + 1) & 3] *= r1; }
                    } else { float v[8];
#pragma unroll
                        for (int j = 0; j < 8; ++j) v[j] = acc[ai][bj][m][j >> 2][j & 3] * frcp(e0[j]);
                        u32x4 w; w.x = cvt_pk_bf16(v[0], v[1]); w.y = cvt_pk_bf16(v[2], v[3]); w.z = cvt_pk_bf16(v[4], v[5]); w.w = cvt_pk_bf16(v[6], v[7]);
                        *(u32x4*)(MG + row * 4096 + col0 + bj * HALF) = w; } } }
            asm volatile("" ::: "memory");
        }
        return b < 2;
    }
};
struct EpiResF32 {
    static constexpr bool PERM = false;
    const float* res; float* out;
    __device__ __forceinline__ bool operator()(f32x4 (&acc)[2][2][4][2], const Unit& u, int wr, int wc, int fr, int fq) const {
        const size_t off0 = (size_t)(u.pm * 256 + wr * 64 + fr) * 4096 + u.pn * 256 + wc * 32 + 4 * fq;
#pragma unroll
        for (int ai = 0; ai < 2; ++ai)
#pragma unroll
            for (int mp = 0; mp < 2; ++mp) { f32x4 rv[2][2][2];
#pragma unroll
                for (int mm = 0; mm < 2; ++mm)
#pragma unroll
                    for (int bj = 0; bj < 2; ++bj)
#pragma unroll
                        for (int n = 0; n < 2; ++n) rv[mm][bj][n] = *(const f32x4*)(res + off0 + (size_t)(ai * HALF + (2 * mp + mm) * 16) * 4096 + bj * HALF + n * 16);
#pragma unroll
                for (int mm = 0; mm < 2; ++mm) { const size_t off = off0 + (size_t)(ai * HALF + (2 * mp + mm) * 16) * 4096;
#pragma unroll
                    for (int bj = 0; bj < 2; ++bj)
#pragma unroll
                        for (int n = 0; n < 2; ++n) *(f32x4*)(out + off + bj * HALF + n * 16) = rv[mm][bj][n] + acc[ai][bj][2 * mp + mm][n]; }
                asm volatile("" ::: "memory"); }
        return false;
    }
};
struct EpiSwiGLU {
    static constexpr bool PERM = true;
    bf16_t* ACT;
    __device__ __forceinline__ bool operator()(f32x4 (&acc)[2][2][4][2], const Unit& u, int wr, int wc, int fr, int fq) const {
        bf16_t* base = ACT + (size_t)(u.pm * 256 + wr * 64 + fr) * DFF + u.pn * 128 + wc * 32 + 8 * fq;
#pragma unroll
        for (int ai = 0; ai < 2; ++ai)
#pragma unroll
            for (int m = 0; m < 4; ++m) { float v[8];
#pragma unroll
                for (int j = 0; j < 8; ++j) { const float g = acc[ai][0][m][j >> 2][j & 3], up = acc[ai][1][m][j >> 2][j & 3]; v[j] = g * sigmoidf_(g) * up; }
                u32x4 w; w.x = cvt_pk_bf16(v[0], v[1]); w.y = cvt_pk_bf16(v[2], v[3]); w.z = cvt_pk_bf16(v[4], v[5]); w.w = cvt_pk_bf16(v[6], v[7]);
                *(u32x4*)(base + (size_t)(ai * HALF + m * 16) * DFF) = w; }
        return false;
    }
};
}

#define XB_TMO      128
#define XB_XCNT(j)  (256  + 64 * (j))
#define XB_XSUB(j)  (1280 + 64 * (j))
#define XB_XGEN(j)  (2304 + 64 * (j))
#define XB_TOP      3328
#define XB_TOPGEN   3392
#define XCD_BAR_WORDS 3456
#define XB_SPIN_CAP (1u << 18)
__device__ __forceinline__ unsigned xb_ld(unsigned* p)              { return __hip_atomic_load(p, __ATOMIC_RELAXED, __HIP_MEMORY_SCOPE_AGENT); }
__device__ __forceinline__ unsigned xb_add(unsigned* p, unsigned v) { return __hip_atomic_fetch_add(p, v, __ATOMIC_RELAXED, __HIP_MEMORY_SCOPE_AGENT); }
__device__ __forceinline__ unsigned xb_xcc_id() { return (unsigned)__builtin_amdgcn_s_getreg((3 << 11) | 20) & 0xFu; }
#define XB_SPIN(cond, bar) do { unsigned _sp = 0; while (cond) { __builtin_amdgcn_s_sleep(1); \
    if ((++_sp & 255u) == 0u) { if (xb_ld(&(bar)[XB_TMO])) break; if (_sp > XB_SPIN_CAP) { atomicAdd(&(bar)[XB_TMO], 1u); break; } } } } while (0)
struct XcdBarrier { unsigned* bar; unsigned x; volatile LAS unsigned* st; };
__device__ __forceinline__ XcdBarrier xcd_barrier_post(unsigned* bar, volatile LAS unsigned* st) {
    XcdBarrier b; b.bar = bar; b.x = xb_xcc_id(); b.st = st;
    if (threadIdx.x == 0) (void)xb_add(&bar[XB_XCNT(b.x)], 1u);
    return b;
}
__device__ __forceinline__ void xcd_barrier_complete(unsigned* bar, unsigned x, unsigned& nloc, unsigned& nx) {
    const unsigned G = gridDim.x * gridDim.y * gridDim.z;
    unsigned sum, cnt, mine, sp = 0u;
    for (;;) {
        sum = 0u; cnt = 0u; mine = 0u;
#pragma unroll
        for (unsigned j = 0; j < 16; ++j) { const unsigned c = xb_ld(&bar[XB_XCNT(j)]); sum += c; cnt += (c > 0u) ? 1u : 0u; mine = (j == x) ? c : mine; }
        if (sum == G) break;
        __builtin_amdgcn_s_sleep(1);
        if ((++sp & 255u) == 0u) { if (xb_ld(&bar[XB_TMO])) break; if (sp > XB_SPIN_CAP) { atomicAdd(&bar[XB_TMO], 1u); break; } }
    }
    nloc = mine > 0u ? mine : 1u; nx = cnt > 0u ? cnt : 1u;
}
__device__ __forceinline__ void xcd_barrier(const XcdBarrier& b) {
    asm volatile("s_waitcnt vmcnt(0)" ::: "memory");
    __syncthreads();
    if (threadIdx.x == 0) {
        unsigned* bar = b.bar;
        __builtin_amdgcn_s_waitcnt(0);
        unsigned nloc = b.st[0], nx = b.st[1];
        if (nloc == 0u) { xcd_barrier_complete(bar, b.x, nloc, nx); b.st[0] = nloc; b.st[1] = nx; }
        const unsigned old = xb_add(&bar[XB_XSUB(b.x)], 1u);
        const unsigned gen = old / nloc;
        if (old + 1u == (gen + 1u) * nloc) {
            __builtin_amdgcn_fence(__ATOMIC_RELEASE, "agent");
            asm volatile("s_waitcnt vmcnt(0)" ::: "memory");
            const unsigned og = xb_add(&bar[XB_TOP], 1u);
            const unsigned tg = og / nx;
            if (og + 1u == (tg + 1u) * nx) xb_add(&bar[XB_TOPGEN], 1u);
            else XB_SPIN(xb_ld(&bar[XB_TOPGEN]) == tg, bar);
            __builtin_amdgcn_fence(__ATOMIC_ACQUIRE, "agent");
            xb_add(&bar[XB_XGEN(b.x)], 1u);
            asm volatile("s_waitcnt vmcnt(0)" ::: "memory");
        } else {
            XB_SPIN(xb_ld(&bar[XB_XGEN(b.x)]) == gen, bar);
            __builtin_amdgcn_fence(__ATOMIC_ACQUIRE, "agent");
            asm volatile("s_waitcnt vmcnt(0)" ::: "memory");
        }
    }
    __syncthreads();
}

struct Args {
    const float* in[29]; float* out; unsigned char* ws; int ph_lo, ph_hi;
};
enum { I_X = 0, I_MEM, I_ATTN_G, I_MEM_G, I_WIN, I_SBQG, I_SBKG, I_RWMIX, I_RWW0, I_RWWUP, I_RWA0, I_RWAUP, I_RWGUP, I_RWKK, I_RWKA, I_RWRK, I_RWLNG, I_RWLNB,
       I_MEMWKV, I_MEMQG, I_MEMKG, I_WSBO, I_WRWO, I_WMEMO, I_WOUT, I_FFNG, I_WGATE, I_WUP, I_WDOWN };

#define LDS_WAIT() asm volatile("s_waitcnt lgkmcnt(0)" ::: "memory")

__device__ __forceinline__ int rowmap(int mode, int n, int roff) {
    if (mode == 1) return n + (n >= 9952 ? 32 : 0);
    if (mode == 2) return (n >> 7) * 256 + (n & 127);
    if (mode == 3) return (n >> 7) * 256 + 128 + (n & 127);
    return n + roff;
}
__device__ __forceinline__ void transpose_item(const float* W, int N, bf16* WT, int ldk, int koff, int mode, int roff, LAS float* scr, int item, int lane) {
    const int nblk = N / 32, kb = item / nblk, nb = item - kb * nblk, k0 = 64 * kb, n0 = 32 * nb;
    { const int rr = lane >> 3, c4 = (lane & 7) * 4; f32x4 wv[8];
#pragma unroll
      for (int i = 0; i < 8; ++i) wv[i] = *(const GAS f32x4*)(W + (size_t)(k0 + 8 * i + rr) * N + n0 + c4);
#pragma unroll
      for (int i = 0; i < 8; ++i) { LAS float* d = scr + (8 * i + rr) * 33 + c4; d[0] = wv[i].x; d[1] = wv[i].y; d[2] = wv[i].z; d[3] = wv[i].w; } }
    LDS_WAIT(); asm volatile("" ::: "memory");
    const int c = lane & 7;
#pragma unroll
    for (int j = 0; j < 4; ++j) { const int n = (lane >> 3) + 8 * j; const LAS float* s = scr + (8 * c) * 33 + n;
        v4u o; o.x = pk2(s[0 * 33], s[1 * 33]); o.y = pk2(s[2 * 33], s[3 * 33]); o.z = pk2(s[4 * 33], s[5 * 33]); o.w = pk2(s[6 * 33], s[7 * 33]);
        *(GAS v4u*)(WT + (size_t)rowmap(mode, n0 + n, roff) * ldk + koff + k0 + 8 * c) = o; }
    LDS_WAIT(); asm volatile("" ::: "memory");
}
__device__ __forceinline__ void rms_rows4096(const float* x, const float* g, bf16* out, int first, int stride, int nrows, int lane) {
    if (first >= nrows) return;
    f32x4 v[16], nv[16];
    { const GAS f32x4* xr = (const GAS f32x4*)(x + (size_t)first * 4096) + lane;
#pragma unroll
      for (int j = 0; j < 16; ++j) v[j] = xr[64 * j]; }
    const GAS f32x4* gr = (const GAS f32x4*)g + lane;
    for (int m = first; m < nrows; m += stride) {
        const bool more = m + stride < nrows;
        if (more) { const GAS f32x4* xr = (const GAS f32x4*)(x + (size_t)(m + stride) * 4096) + lane;
#pragma unroll
            for (int j = 0; j < 16; ++j) nv[j] = xr[64 * j]; }
        float s = 0.f;
#pragma unroll
        for (int j = 0; j < 16; ++j) s += (v[j].x * v[j].x + v[j].y * v[j].y) + (v[j].z * v[j].z + v[j].w * v[j].w);
        const float rstd = 1.0f / sqrtf(wave_sum(s) * (1.f / 4096.f) + RMS_EPS);
        GAS v2u* o8 = (GAS v2u*)(out + (size_t)m * 4096) + lane;
#pragma unroll
        for (int j = 0; j < 16; ++j) { const f32x4 gv = gr[64 * j]; v2u o; o.x = pk2(v[j].x * rstd * gv.x, v[j].y * rstd * gv.y); o.y = pk2(v[j].z * rstd * gv.z, v[j].w * rstd * gv.w); o8[64 * j] = o; }
        if (more) {
#pragma unroll
            for (int j = 0; j < 16; ++j) v[j] = nv[j]; }
    }
}
#define QB 16
#define QUEUE_PULL(headword, nitems, BODY) do { for (;;) { int it_ = 0; if ((threadIdx.x & 63) == 0) it_ = (int)__hip_atomic_fetch_add((unsigned*)(headword), (unsigned)QB, __ATOMIC_RELAXED, __HIP_MEMORY_SCOPE_AGENT); \
        it_ = __builtin_amdgcn_readfirstlane(it_); if (it_ >= (nitems)) break; const int qe_ = (it_ + QB < (nitems)) ? it_ + QB : (nitems); \
        for (int qi = it_; qi < qe_; ++qi) { BODY; } } } while (0)
constexpr int NPHASES = 12;
__global__ void __launch_bounds__(NWAVES * 64, 2) hybrid_fwd(Args args) {
    extern __shared__ __attribute__((aligned(16))) unsigned char lds_raw[];
    LAS unsigned char* lds = (LAS unsigned char*)lds_raw;
    volatile LAS unsigned* MISC = (volatile LAS unsigned*)(lds + MISC_OFF);
    const int G = gridDim.x, bx = blockIdx.x, NGW = G * NWAVES;
    unsigned char* ws = args.ws;
    gu32* ctl = (gu32*)(ws + WS_CTL);
    for (int u = threadIdx.x; u < (LDS_BYTES - LDSCTL_OFF) / 4; u += NWAVES * 64) ((LAS unsigned*)(lds + LDSCTL_OFF))[u] = 0u;
#define PHASE_IDS() int tid = threadIdx.x; asm volatile("" : "+v"(tid)); const int lane = tid & 63, wave = __builtin_amdgcn_readfirstlane(tid >> 6), gw = bx * NWAVES + wave; (void)lane; (void)gw
    __syncthreads();
#if MK_PER_PHASE
    XcdBarrier bar; bar.bar = (unsigned*)(ctl + CW_BAR); bar.x = 0; bar.st = nullptr;
#define GRID_BAR() do { } while (0)
#else
    XcdBarrier bar = xcd_barrier_post((unsigned*)(ctl + CW_BAR), MISC + 8);
#define GRID_BAR() xcd_barrier(bar)
#endif
    const int lo = args.ph_lo, hi = args.ph_hi;
#define IN(k) (lo <= (k) && (k) < hi)
#define BOTH(k) (IN(k) && IN((k) + 1))

    bf16* WIN_T = (bf16*)(ws + WS_WIN_T); bf16* WCAT_T = (bf16*)(ws + WS_WCAT_T); bf16* WOUT_T = (bf16*)(ws + WS_WOUT_T); bf16* WKV_T = (bf16*)(ws + WS_WKV_T);
    bf16* LBWA = (bf16*)(ws + WS_LBWA); bf16* LBG = (bf16*)(ws + WS_LBG); bf16* XN = (bf16*)(ws + WS_XN); bf16* MEMN = (bf16*)(ws + WS_MEMN); bf16* P = (bf16*)(ws + WS_P);
    float* R_R = (float*)(ws + WS_R); float* R_W = (float*)(ws + WS_R + RSZ); float* R_KP = (float*)(ws + WS_R + 2 * RSZ); float* R_V = (float*)(ws + WS_R + 3 * RSZ);
    float* R_KK = (float*)(ws + WS_R + 4 * RSZ); bf16* R_NB = (bf16*)(ws + WS_R + 5 * RSZ);
    bf16* GB = (bf16*)(ws + WS_G); bf16* Y = (bf16*)(ws + WS_Y);     bf16* OCAT = (bf16*)(ws + WS_OCAT);
    bf16* QN = (bf16*)(ws + WS_QN); bf16* KN = (bf16*)(ws + WS_KN); bf16* VT = (bf16*)(ws + WS_VT); bf16* MQN = (bf16*)(ws + WS_MQN);
    bf16* MKRAW = (bf16*)(ws + WS_MKRAW); bf16* MKN = (bf16*)(ws + WS_MKN); bf16* MVT = (bf16*)(ws + WS_MVT);
    float* SM = (float*)(ws + WS_SM); bf16* PM = (bf16*)(ws + WS_PM); bf16* LA1 = (bf16*)(ws + WS_LA1); bf16* LA2 = (bf16*)(ws + WS_LA2);
    bf16* S0ALL = (bf16*)R_R;     float* BONUS = (float*)(ws + WS_BONUS);
    bf16* PHIT = (bf16*)(ws + WS_PHIT);   float* PCT = (float*)(ws + WS_PCT); bf16* SLOCT = (bf16*)(ws + WS_SLOCT);
    bf16* WGU_T = (bf16*)(ws + WS_WGU_T); bf16* WD_T = (bf16*)(ws + WS_WD_T); bf16* MERGED = (bf16*)(ws + WS_MERGED); float* H1 = (float*)(ws + WS_H1); bf16* ACT = (bf16*)(ws + WS_ACT);

#define Q1_ITEMS (24 * 128 + 24 * 128 + 16 * 128 + 64 * 128 + 172 * 128)
#define Q1_BODY { int r = qi; LAS float* scr = (LAS float*)(lds + wave * 16384); \
        if (r < 24 * 128) transpose_item(args.in[I_WSBO], 4096, WCAT_T, 4096, 0, 0, 0, scr, r, lane); \
        else if ((r -= 24 * 128) < 24 * 128) transpose_item(args.in[I_WRWO], 4096, WCAT_T, 4096, 1536, 0, 0, scr, r, lane); \
        else if ((r -= 24 * 128) < 16 * 128) transpose_item(args.in[I_WMEMO], 4096, WCAT_T, 4096, 3072, 0, 0, scr, r, lane); \
        else if ((r -= 16 * 128) < 64 * 128) transpose_item(args.in[I_WOUT], 4096, WOUT_T, 4096, 0, 0, 0, scr, r, lane); \
        else { r -= 64 * 128; transpose_item(args.in[I_WDOWN], 4096, WD_T, DFF, 0, 0, 0, scr, r, lane); } }
#define Q2_ITEMS (2 * 64 * 344)
#define Q2_BODY { int r = qi; LAS float* scr2 = (LAS float*)(lds + wave * 16384); \
        if (r < 64 * 344) transpose_item(args.in[I_WGATE], DFF, WGU_T, 4096, 0, 2, 0, scr2, r, lane); \
        else transpose_item(args.in[I_WUP], DFF, WGU_T, 4096, 0, 3, 0, scr2, r - 64 * 344, lane); }
    if (IN(0)) {
        PHASE_IDS();
        LAS float* scr = (LAS float*)(lds + wave * 16384);
        constexpr int I_IN = 64 * 727, I_KV = 64 * 64;
        constexpr int NITEMS = I_IN + I_KV;
        for (int it = gw; it < NITEMS; it += NGW) {
            int r = it;
            if (r < I_IN) { transpose_item(args.in[I_WIN], NIN_ORIG, WIN_T, 4096, 0, 1, 0, scr, r, lane); continue; } r -= I_IN;
            transpose_item(args.in[I_MEMWKV], 2048, WKV_T, 4096, 0, 0, 0, scr, r, lane);
        }
        for (int i = bx * 512 + tid; i < 32 * 4096 / 8; i += G * 512) ((GAS v4u*)(WIN_T + (size_t)9952 * 4096))[i] = (v4u){0u, 0u, 0u, 0u};
        for (int i = bx * 512 + tid; i < 3072 * 256; i += G * 512) { const int n = i >> 8, k = i & 255; float v = 0.f;
            if (n < 1536) { if (k < 128) v = args.in[I_RWWUP][(size_t)k * 1536 + n]; } else { if (k >= 128) v = args.in[I_RWAUP][(size_t)(k - 128) * 1536 + (n - 1536)]; }
            LBWA[i] = (bf16)f2bf(v); }
        for (int i = bx * 512 + tid; i < 1536 * 512; i += G * 512) { const int n = i >> 9, k = i & 511; const float v = (k < 480) ? args.in[I_RWGUP][(size_t)k * 1536 + n] : 0.f; LBG[i] = (bf16)f2bf(v); }
        rms_rows4096(args.in[I_X], args.in[I_ATTN_G], XN, gw, NGW, T, lane);
        rms_rows4096(args.in[I_MEM], args.in[I_MEM_G], MEMN, gw, NGW, NMEM, lane);
        if (BOTH(0)) GRID_BAR();
    }

    if (IN(1)) {
        PHASE_IDS();
        pg8::SchedGemm1 S; S.to.init(32, 91); S.G = G; S.c = bx; S.XN = (const char*)XN; S.WIN = (const char*)WIN_T; S.MEMN = (const char*)MEMN; S.WKV = (const char*)WKV_T;
        pg8::EpiGemm1 E{P, MKRAW, MVT};
        pg8::gemm_phase(lds, 4096, 4096, S, E);
        QUEUE_PULL(ctl + CW_Q1, Q1_ITEMS, Q1_BODY);
        if (BOTH(1)) GRID_BAR();
    }

    if (IN(2)) {
        PHASE_IDS();
        QUEUE_PULL(ctl + CW_Q1, Q1_ITEMS, Q1_BODY);
        __syncthreads();
        {
            const float qscale = 0.08838834764831845f * 1.4426950408889634f;
            for (int t = gw; t < T; t += NGW) {
                const bf16* prow = P + (size_t)t * NINP;
#pragma unroll
                for (int which = 0; which < 2; ++which) {
                    const float* gain = args.in[which ? I_SBKG : I_SBQG]; bf16* dst = (which ? KN : QN) + (size_t)t * 1536; const int cb = which ? PK : PQ;
                    const f32x4 g0 = *(const GAS f32x4*)(gain + (8 * lane & 127)), g1 = *(const GAS f32x4*)(gain + (8 * lane & 127) + 4);
#pragma unroll
                    for (int p = 0; p < 3; ++p) {
                        const v4u raw = *(const GAS v4u*)(prow + cb + 512 * p + 8 * lane);
                        float v[8] = {bflo(raw.x), bfhi(raw.x), bflo(raw.y), bfhi(raw.y), bflo(raw.z), bfhi(raw.z), bflo(raw.w), bfhi(raw.w)};
                        float ss = 0.f;
#pragma unroll
                        for (int j = 0; j < 8; ++j) ss += v[j] * v[j];
                        ss = red16_sum(ss);
                        const float rstd = (which ? 1.0f : qscale) / sqrtf(ss * (1.f / 128.f) + RMS_EPS);
                        v4u o; o.x = pk2(v[0] * rstd * g0.x, v[1] * rstd * g0.y); o.y = pk2(v[2] * rstd * g0.z, v[3] * rstd * g0.w);
                        o.z = pk2(v[4] * rstd * g1.x, v[5] * rstd * g1.y); o.w = pk2(v[6] * rstd * g1.z, v[7] * rstd * g1.w);
                        *(GAS v4u*)(dst + 512 * p + 8 * lane) = o;
                    }
                }
                {
                    const float* gain = args.in[I_MEMQG] + ((16 * lane) & 255);
                    const v4u r0 = *(const GAS v4u*)(prow + PMQ + 16 * lane), r1 = *(const GAS v4u*)(prow + PMQ + 16 * lane + 8);
                    float v[16] = {bflo(r0.x), bfhi(r0.x), bflo(r0.y), bfhi(r0.y), bflo(r0.z), bfhi(r0.z), bflo(r0.w), bfhi(r0.w), bflo(r1.x), bfhi(r1.x), bflo(r1.y), bfhi(r1.y), bflo(r1.z), bfhi(r1.z), bflo(r1.w), bfhi(r1.w)};
                    float ss = 0.f;
#pragma unroll
                    for (int j = 0; j < 16; ++j) ss += v[j] * v[j];
                    ss = red16_sum(ss);
                    const float rstd = 0.0625f / sqrtf(ss * (1.f / 256.f) + RMS_EPS);
                    unsigned o[8];
#pragma unroll
                    for (int j = 0; j < 8; ++j) o[j] = pk2(v[2 * j] * rstd * gain[2 * j], v[2 * j + 1] * rstd * gain[2 * j + 1]);
                    *(GAS v4u*)(MQN + (size_t)t * 1024 + 16 * lane) = (v4u){o[0], o[1], o[2], o[3]};
                    *(GAS v4u*)(MQN + (size_t)t * 1024 + 16 * lane + 8) = (v4u){o[4], o[5], o[6], o[7]};
                }
            }
            for (int m = gw; m < NMEM; m += NGW) {
                const float* gain = args.in[I_MEMKG] + ((16 * lane) & 255);
                const v4u r0 = *(const GAS v4u*)(MKRAW + (size_t)m * 1024 + 16 * lane), r1 = *(const GAS v4u*)(MKRAW + (size_t)m * 1024 + 16 * lane + 8);
                float v[16] = {bflo(r0.x), bfhi(r0.x), bflo(r0.y), bfhi(r0.y), bflo(r0.z), bfhi(r0.z), bflo(r0.w), bfhi(r0.w), bflo(r1.x), bfhi(r1.x), bflo(r1.y), bfhi(r1.y), bflo(r1.z), bfhi(r1.z), bflo(r1.w), bfhi(r1.w)};
                float ss = 0.f;
#pragma unroll
                for (int j = 0; j < 16; ++j) ss += v[j] * v[j];
                ss = red16_sum(ss);
                const float rstd = 1.0f / sqrtf(ss * (1.f / 256.f) + RMS_EPS);
                unsigned o[8];
#pragma unroll
                for (int j = 0; j < 8; ++j) o[j] = pk2(v[2 * j] * rstd * gain[2 * j], v[2 * j + 1] * rstd * gain[2 * j + 1]);
                *(GAS v4u*)(MKN + (size_t)m * 1024 + 16 * lane) = (v4u){o[0], o[1], o[2], o[3]};
                *(GAS v4u*)(MKN + (size_t)m * 1024 + 16 * lane + 8) = (v4u){o[4], o[5], o[6], o[7]};
            }
        }
        {
            LAS unsigned char* scr = lds + wave * 16640;
            for (int it = gw; it < 12 * 128; it += NGW) {
                const int h = it >> 7, t0 = (it & 127) * 64;
#pragma unroll
                for (int i = 0; i < 16; ++i) { const int tt = 4 * i + (lane >> 4), c = lane & 15;
                    const v4u raw = *(const GAS v4u*)(P + (size_t)(t0 + tt) * NINP + PV + 128 * h + 8 * c);
                    LAS unsigned* d = (LAS unsigned*)(scr + tt * 260 + c * 16); d[0] = raw.x; d[1] = raw.y; d[2] = raw.z; d[3] = raw.w; }
                LDS_WAIT(); asm volatile("" ::: "memory");
#pragma unroll
                for (int i = 0; i < 16; ++i) { const int d = 8 * i + (lane >> 3), tc = lane & 7;
                    unsigned short e[8];
#pragma unroll
                    for (int j = 0; j < 8; ++j) e[j] = *(const LAS unsigned short*)(scr + (8 * tc + j) * 260 + d * 2);
                    v4u o; o.x = e[0] | ((unsigned)e[1] << 16); o.y = e[2] | ((unsigned)e[3] << 16); o.z = e[4] | ((unsigned)e[5] << 16); o.w = e[6] | ((unsigned)e[7] << 16);
                    *(GAS v4u*)(VT + ((size_t)h * 128 + d) * T + t0 + 8 * tc) = o; }
                LDS_WAIT(); asm volatile("" ::: "memory");
            }
        }
        {
            const float* mix = args.in[I_RWMIX];
            for (int t = gw; t < T; t += NGW) {
                const bf16* cur = P + (size_t)t * NINP + PRW; const bf16* prv = cur - NINP;
                for (int c8 = 576 + lane; c8 < RWSEG / 8; c8 += 64) {
                    const int c0 = 8 * c8;
                    const v4u rc = *(const GAS v4u*)(cur + c0); v4u rp = (v4u){0u, 0u, 0u, 0u}; if (t > 0) rp = *(const GAS v4u*)(prv + c0);
                    const f32x4 m0 = *(const GAS f32x4*)(mix + c0), m1 = *(const GAS f32x4*)(mix + c0 + 4);
                    const float cv[8] = {bflo(rc.x), bfhi(rc.x), bflo(rc.y), bfhi(rc.y), bflo(rc.z), bfhi(rc.z), bflo(rc.w), bfhi(rc.w)};
                    const float pv[8] = {bflo(rp.x), bfhi(rp.x), bflo(rp.y), bfhi(rp.y), bflo(rp.z), bfhi(rp.z), bflo(rp.w), bfhi(rp.w)};
                    const float mv[8] = {m0.x, m0.y, m0.z, m0.w, m1.x, m1.y, m1.z, m1.w};
                    float s[8];
#pragma unroll
                    for (int j = 0; j < 8; ++j) s[j] = cv[j] + (pv[j] - cv[j]) * mv[j];
                    if (c0 < 4864) { const bool isw = c0 < 4736;
                        if (isw) {
#pragma unroll
                            for (int j = 0; j < 8; ++j) { const float e = fexp(2.f * s[j]); s[j] = 1.f - 2.f * frcp(e + 1.f); } }
                        *(GAS v4u*)(LA1 + (size_t)t * 256 + (c0 - 4608)) = (v4u){pk2(s[0], s[1]), pk2(s[2], s[3]), pk2(s[4], s[5]), pk2(s[6], s[7])}; }
                    else {
#pragma unroll
                        for (int j = 0; j < 8; ++j) s[j] = sigmoidf_(s[j]);
                        *(GAS v4u*)(LA2 + (size_t)t * 512 + (c0 - 4864)) = (v4u){pk2(s[0], s[1]), pk2(s[2], s[3]), pk2(s[4], s[5]), pk2(s[6], s[7])}; }
                }
                if (lane < 4) *(GAS v4u*)(LA2 + (size_t)t * 512 + 480 + 8 * lane) = (v4u){0u, 0u, 0u, 0u};
            }
        }
        if (BOTH(2)) GRID_BAR();
    }

    if (IN(3)) {
        PHASE_IDS();
        int nt4 = 4, nt8 = 8; asm volatile("" : "+s"(nt4), "+s"(nt8));
        { pg8::SchedPlain S; S.to.init(32, 12); S.G = G; S.c = bx; S.nt = nt4; S.A0 = (const char*)LA1; S.B0 = (const char*)LBWA; S.sA = 256 * 256 * 2; S.sB = 256 * 256 * 2;
          pg8::EpiLoraWA E{args.in[I_RWW0], args.in[I_RWA0], R_W, R_NB};
          pg8::gemm_phase(lds, 256, 256, S, E); }
        { pg8::SchedPlain S; S.to.init(32, 6); S.G = G; S.c = (bx + G - 64) % G; S.nt = nt8; S.A0 = (const char*)LA2; S.B0 = (const char*)LBG; S.sA = 256 * 512 * 2; S.sB = 256 * 512 * 2;
          pg8::EpiBf16 E{GB, 1536, 0, 0};
          pg8::gemm_phase(lds, 512, 512, S, E); }
        { pg8::SchedHeads S; S.G = G; S.c = (bx + G - 128) % G; S.nunits = 128; S.nt = nt4; S.A0 = (const char*)MQN; S.B0 = (const char*)MKN; S.sA = 256 * 1024 * 2; S.hA = 512; S.hB = 512;
          pg8::EpiScoreF32 E{SM};
          pg8::gemm_phase(lds, 1024, 1024, S, E); }
        if (BOTH(3)) GRID_BAR();
    }

    if (IN(4)) {
        PHASE_IDS();
        constexpr int RP = 260, SLOT = 64 * RP, NP = 272;
        constexpr int S_AT = 0, S_BT = SLOT, S_KT = 2 * SLOT, S_RT = 3 * SLOT, S_NABT = 4 * SLOT, S_NAK = S_NABT + 64 * NP, S_MBR = S_NAK + SLOT, S_MKR = S_MBR + SLOT, S_SEG = S_MKR + SLOT, S_GC = S_SEG + 2048;
        static_assert(S_GC + 256 <= LDSCTL_OFF, "chunk-prep LDS map");
        constexpr int HP = 144, HSL = 64 * HP, H_AT = S_NABT, H_BT = H_AT + HSL, H_KT = H_BT + HSL, H_RT = H_KT + HSL;
        static_assert(H_RT + HSL <= S_SEG, "bf16 operand copies inside the Gram output slots");
        constexpr int H_PSIT = S_GC + 256, H_QCT = H_PSIT + HSL;
        static_assert(H_QCT + HSL <= LDSCTL_OFF, "chunk-prep LDS map (bf16 step-F operands)");
        const int l31 = lane & 31, lh = lane >> 5;
        float nwv[8], nkrv[8], nav[8], nrv[8], nvv[8];
        unsigned short pr_[9], pk_[9], pv_[9];
        float cmr, cmk, cmv, ckk, cka, crk;
#define S1_FETCH(it_) do { const int t0_ = ((it_) & 127) * 64 + 8 * wave, hc_ = ((it_) >> 7) * 64 + lane; const unsigned gb_ = (unsigned)(t0_ * 1536 + hc_) * 4u; \
            cmr = args.in[I_RWMIX][hc_]; cmk = args.in[I_RWMIX][1536 + hc_]; cmv = args.in[I_RWMIX][3072 + hc_]; ckk = args.in[I_RWKK][hc_]; cka = args.in[I_RWKA][hc_]; crk = args.in[I_RWRK][hc_]; \
            _Pragma("unroll") for (int i = 0; i < 8; ++i) { const unsigned o_ = gb_ + (unsigned)i * 6144u; nwv[i] = *(const GAS float*)((const GAS char*)R_W + o_); nav[i] = bflo(*(const GAS unsigned short*)((const GAS char*)R_NB + (o_ >> 1))); } \
            _Pragma("unroll") for (int i = 0; i < 9; ++i) { const int row_ = (t0_ + i - 1) > 0 ? (t0_ + i - 1) : 0; const unsigned po_ = (unsigned)(row_ * NINP + PRW + hc_) * 2u;     \
                pr_[i] = *(const GAS unsigned short*)((const GAS char*)P + po_); pk_[i] = *(const GAS unsigned short*)((const GAS char*)P + po_ + 3072u); pv_[i] = *(const GAS unsigned short*)((const GAS char*)P + po_ + 6144u); } \
            if (t0_ == 0) { pr_[0] = 0; pk_[0] = 0; pv_[0] = 0; }     } while (0)
#define S1_SHIFT() do { const float mr_ = cmr, mk_ = cmk, mv_ = cmv; \
            _Pragma("unroll") for (int i = 0; i < 8; ++i) { const float cr_ = bflo(pr_[i + 1]), ck_ = bflo(pk_[i + 1]), cv_ = bflo(pv_[i + 1]); \
                nrv[i] = cr_ + (bflo(pr_[i]) - cr_) * mr_; nkrv[i] = ck_ + (bflo(pk_[i]) - ck_) * mk_; nvv[i] = cv_ + (bflo(pv_[i]) - cv_) * mv_; } } while (0)
#define S1_MAP(u_) ((((u_) % 24) << 7) + (u_) / 24)
        if (bx < 24 * 128) S1_FETCH(S1_MAP(bx));
        for (int unit = bx; unit < 24 * 128; unit += G) {
            const int item = S1_MAP(unit);
            const int head = item >> 7, chunk = item & 127;
            unsigned vvp[4];
            {
                S1_SHIFT();
                float nkkv[8], nnbv[8], nkpv[8];
                { const float kkc = ckk, kac = cka;
#pragma unroll
                  for (int i = 0; i < 8; ++i) { const float kq = nkrv[i] * kkc; const float ss = wave_sum_u(kq * kq);
                      const float kn = kq * fminf(__builtin_amdgcn_rsqf(ss), 1e12f);     nkkv[i] = kn; nnbv[i] = -(kn * nav[i]); nkpv[i] = nkrv[i] * (1.0f + (nav[i] - 1.0f) * kac); } }
                float g[8]; g[0] = nwv[0];
#pragma unroll
                for (int i = 1; i < 8; ++i) g[i] = g[i - 1] * nwv[i];
                *(LAS float*)(lds + S_SEG + (wave * 64 + lane) * 4) = g[7];
                __syncthreads();
                float pre = 1.0f;
#pragma unroll
                for (int w2 = 0; w2 < 7; ++w2) { const float gw2 = *(LAS const float*)(lds + S_SEG + (w2 * 64 + lane) * 4); pre *= (w2 < wave) ? gw2 : 1.0f; }
                float avs[8];
#pragma unroll
                for (int i = 0; i < 8; ++i) { const float gt = pre * g[i], gp = (i == 0) ? pre : pre * g[i - 1], inv = frcp(gt); const int o = (8 * wave + i) * RP + lane * 4;
                    const float av = nkkv[i] * gp, bv = nnbv[i] * inv, kv = nkpv[i] * inv, rvv = nrv[i] * gt;
                    avs[i] = av; *(LAS float*)(lds + S_BT + o) = bv; *(LAS float*)(lds + S_KT + o) = kv; *(LAS float*)(lds + S_RT + o) = rvv;
                    const int ob = (8 * wave + i) * HP + lane * 2;
                    *(LAS unsigned short*)(lds + H_AT + ob) = (unsigned short)f2bf(av); *(LAS unsigned short*)(lds + H_BT + ob) = (unsigned short)f2bf(bv);
                    *(LAS unsigned short*)(lds + H_KT + ob) = (unsigned short)f2bf(kv); *(LAS unsigned short*)(lds + H_RT + ob) = (unsigned short)f2bf(rvv); }
                *(LAS v4u*)(lds + S_AT + lane * HP + wave * 16) = (v4u){pk2(avs[0], avs[1]), pk2(avs[2], avs[3]), pk2(avs[4], avs[5]), pk2(avs[6], avs[7])};
                vvp[0] = pk2(nvv[0], nvv[1]); vvp[1] = pk2(nvv[2], nvv[3]); vvp[2] = pk2(nvv[4], nvv[5]); vvp[3] = pk2(nvv[6], nvv[7]);
                if (wave == 7) *(LAS float*)(lds + S_GC + lane * 4) = pre * g[7];
                { const float rkl = crk;
                  float bsv = 0.f;
#pragma unroll
                  for (int i = 0; i < 8; ++i) { const float bsum = wave_sum_u(nrv[i] * nkpv[i] * rkl); bsv = (lane == i) ? bsum : bsv; }
                  if (lane < 8) BONUS[(size_t)(chunk * 64 + 8 * wave + lane) * 24 + head] = bsv; }
                if (unit + G < 24 * 128) S1_FETCH(S1_MAP(unit + G));
                __syncthreads();
            }
            {
                const int Ls = (wave >> 2) ? H_KT : H_BT, Rs = ((wave >> 1) & 1) ? H_RT : H_AT, hm = wave & 1, which = wave >> 1;
                LAS const unsigned char* Lp = lds + Ls + (32 * hm + l31) * HP + lh * 16;
                LAS const unsigned char* Rp = lds + Rs + l31 * HP + lh * 16;
                f32x16 acc0, acc1;
#pragma unroll
                for (int r = 0; r < 16; ++r) { acc0[r] = 0.f; acc1[r] = 0.f; }
#pragma unroll
                for (int ks = 0; ks < 4; ++ks) { const bf16x8 a = *(LAS const bf16x8*)(Lp + ks * 32), b0 = *(LAS const bf16x8*)(Rp + ks * 32), b1 = *(LAS const bf16x8*)(Rp + 32 * HP + ks * 32);
                    acc0 = __builtin_amdgcn_mfma_f32_32x32x16_bf16(a, b0, acc0, 0, 0, 0); acc1 = __builtin_amdgcn_mfma_f32_32x32x16_bf16(a, b1, acc1, 0, 0, 0); }
                __syncthreads();
#define S1_GVAL(strict_) const int j = 32 * hm + (r & 3) + 8 * (r >> 2) + 4 * lh, t = 32 * nt + l31; float val = nt ? acc1[r] : acc0[r]; val = ((strict_) ? (j < t) : (j <= t)) ? val : 0.f
                if (which == 0) {
#pragma unroll
                    for (int nt = 0; nt < 2; ++nt)
#pragma unroll
                        for (int r = 0; r < 16; ++r) { S1_GVAL(true); *(LAS float*)(lds + S_NABT + t * NP + ((j & 3) * 16 + (j >> 2)) * 4) = val; }
                } else if (which == 2) {
#pragma unroll
                    for (int nt = 0; nt < 2; ++nt)
#pragma unroll
                        for (int r = 0; r < 16; ++r) { S1_GVAL(true); *(LAS unsigned short*)(lds + S_NAK + j * HP + t * 2) = (unsigned short)f2bf(val); }
                } else {
                    const int mslot = (which == 1) ? S_MBR : S_MKR;
#pragma unroll
                    for (int nt = 0; nt < 2; ++nt)
#pragma unroll
                        for (int r = 0; r < 16; ++r) { S1_GVAL(false); *(LAS float*)(lds + mslot + j * RP + t * 4) = val; }
                }
                __syncthreads();
            }
            {
                const int ci = lane >> 2, g = lane & 3, c = 16 * (wave & 3) + ci; const int slot = (wave < 4) ? S_MBR : S_BT;
                f32x2 xr[8];
#pragma unroll
                for (int q = 0; q < 16; ++q) xr[q >> 1][q & 1] = *(LAS const float*)(lds + slot + (4 * q + g) * RP + c * 4);
                __syncthreads();
                f32x4 ca[4], cb[4], cc[4];
#define S1_CF(t_, dst_) do { if ((t_) >= 1) { _Pragma("unroll") for (int qg = 0; qg < 4; ++qg) if (4 * qg < ((t_) >> 2) + 1) dst_[qg] = *(LAS const f32x4*)(lds + S_NABT + (t_) * NP + (g * 16 + 4 * qg) * 4); } } while (0)
#define S1_STEP(t_, cur_, nxt_) do { S1_CF((t_) - 2, nxt_); __builtin_amdgcn_sched_barrier(0); \
                    const float xt = quad_bcast(xr[(t_) >> 3][((t_) >> 2) & 1], (t_) & 3);     \
                    const f32x2 xt2 = {xt, xt}; \
                    _Pragma("unroll") for (int qp = 0; qp < 8; ++qp) if (2 * qp < ((t_) >> 2) + 1) { const f32x2 cf2 = {cur_[qp >> 1][2 * (qp & 1)], cur_[qp >> 1][2 * (qp & 1) + 1]}; \
                        xr[qp] = __builtin_elementwise_fma(cf2, xt2, xr[qp]); }     \
                    __builtin_amdgcn_sched_barrier(0); } while (0)
                S1_CF(63, ca); S1_CF(62, cb);
#pragma unroll
                for (int tb = 63; tb >= 1; tb -= 3) { S1_STEP(tb, ca, cc); S1_STEP(tb - 1, cb, ca); S1_STEP(tb - 2, cc, cb); }
#pragma unroll
                for (int q = 0; q < 16; ++q) *(LAS unsigned short*)(lds + slot + c * HP + (4 * q + g) * 2) = (unsigned short)f2bf(xr[q >> 1][q & 1]);
                __syncthreads();
            }
            {
                const int which = wave >> 2, hm = (wave >> 1) & 1, ch = wave & 1; const int Xs = ch ? S_BT : S_MBR;
                LAS const unsigned char* Ap = lds + (which ? S_NAK : S_AT) + (32 * hm + l31) * HP + lh * 16;
                LAS const unsigned char* Bp = lds + Xs + l31 * HP + lh * 16;
                f32x16 acc0, acc1;
                int l31e = l31, lhe = lh; asm volatile("" : "+v"(l31e), "+v"(lhe));
                {
                    const int ibase = (which == 0) ? S_RT : (ch ? S_KT : S_MKR), sm = (which == 0) ? 4 : RP, sn = (which == 0) ? RP : 4;
                    const int tb = ibase + (32 * hm + 4 * lhe) * sm + l31e * sn;
#pragma unroll
                    for (int r = 0; r < 16; ++r) { const int om = ((r & 3) + 8 * (r >> 2)) * sm; acc0[r] = *(LAS const float*)(lds + tb + om); acc1[r] = *(LAS const float*)(lds + tb + om + 32 * sn); }
                    if (which == 0 && ch) {
#pragma unroll
                        for (int r = 0; r < 16; ++r) { const int m = 32 * hm + (r & 3) + 8 * (r >> 2) + 4 * lhe; acc0[r] = (m == l31e) ? 1.0f : 0.0f; acc1[r] = (m == 32 + l31e) ? 1.0f : 0.0f; }
                    }
                }
#pragma unroll
                for (int ks = 0; ks < 4; ++ks) { const bf16x8 a = *(LAS const bf16x8*)(Ap + ks * 32), b0 = *(LAS const bf16x8*)(Bp + ks * 32), b1 = *(LAS const bf16x8*)(Bp + 32 * HP + ks * 32);
                    acc0 = __builtin_amdgcn_mfma_f32_32x32x16_bf16(a, b0, acc0, 0, 0, 0); acc1 = __builtin_amdgcn_mfma_f32_32x32x16_bf16(a, b1, acc1, 0, 0, 0); }
#pragma unroll
                for (int nt = 0; nt < 2; ++nt) { const int n = 32 * nt + l31; const float gcn = ch ? *(LAS const float*)(lds + S_GC + n * 4) : 1.0f;
                    if (which == 0) { const size_t eo = ((size_t)item * 64 + n) * 64 + 32 * hm + 4 * lh;
                        if (ch) {
#pragma unroll
                            for (int i = 0; i < 4; ++i) { f32x4 o;
#pragma unroll
                                for (int e = 0; e < 4; ++e) o[e] = (nt ? acc1[4 * i + e] : acc0[4 * i + e]) * gcn;
                                *(GAS f32x4*)(PCT + eo + 8 * i) = o; }
                        } else {
#pragma unroll
                            for (int i = 0; i < 4; ++i) { const int q = 4 * i;
                                *(GAS v2u*)(PHIT + eo + 8 * i) = nt ? (v2u){pk2(acc1[q], acc1[q + 1]), pk2(acc1[q + 2], acc1[q + 3])} : (v2u){pk2(acc0[q], acc0[q + 1]), pk2(acc0[q + 2], acc0[q + 3])}; }
                        } }
                    else {
#pragma unroll
                        for (int i = 0; i < 4; ++i) { const int j0 = 32 * hm + 8 * i + 4 * lh; float o[4];
#pragma unroll
                            for (int e = 0; e < 4; ++e) o[e] = (nt ? acc1[4 * i + e] : acc0[4 * i + e]) * gcn;
                            *(LAS v2u*)(lds + (ch ? H_QCT : H_PSIT) + n * HP + j0 * 2) = (v2u){pk2(o[0], o[1]), pk2(o[2], o[3])}; } } }
                *(LAS v4u*)(lds + S_NABT + lane * HP + wave * 16) = (v4u){vvp[0], vvp[1], vvp[2], vvp[3]};
                __syncthreads();
            }
            {
                const int hm = wave >> 2, ct = wave & 3, nt = ct & 1; const int Bs = (ct < 2) ? H_PSIT : H_QCT;
                LAS const unsigned char* Ap = lds + S_NABT + (32 * hm + l31) * HP + lh * 16;
                LAS const unsigned char* Bp = lds + Bs + (32 * nt + l31) * HP + lh * 16;
                f32x16 acc;
#pragma unroll
                for (int r = 0; r < 16; ++r) acc[r] = 0.f;
#pragma unroll
                for (int ks = 0; ks < 4; ++ks) acc = __builtin_amdgcn_mfma_f32_32x32x16_bf16(*(LAS const bf16x8*)(Ap + ks * 32), *(LAS const bf16x8*)(Bp + ks * 32), acc, 0, 0, 0);
                const int n = 32 * nt + l31;
                bf16* dst = (ct < 2) ? (Y + (size_t)(chunk * 64 + n) * 1536 + head * 64 + 32 * hm + 4 * lh) : (SLOCT + ((size_t)item * 64 + n) * 64 + 32 * hm + 4 * lh);
#pragma unroll
                for (int i = 0; i < 4; ++i) *(GAS v2u*)(dst + 8 * i) = (v2u){pk2(acc[4 * i], acc[4 * i + 1]), pk2(acc[4 * i + 2], acc[4 * i + 3])};
                __syncthreads();
            }
        }
        for (int t = gw; t < T; t += NGW) {
            {
                const float* srow = SM + (size_t)t * 1024 + 16 * lane; f32x4 s[4]; float mx = -3.0e38f;
#pragma unroll
                for (int j = 0; j < 4; ++j) { s[j] = *(const GAS f32x4*)(srow + 4 * j); mx = fmaxf(mx, fmaxf(fmaxf(s[j].x, s[j].y), fmaxf(s[j].z, s[j].w))); }
                mx = red16_max(mx); float sum = 0.f;
#pragma unroll
                for (int j = 0; j < 4; ++j) { s[j].x = fexp(s[j].x - mx); s[j].y = fexp(s[j].y - mx); s[j].z = fexp(s[j].z - mx); s[j].w = fexp(s[j].w - mx); sum += (s[j].x + s[j].y) + (s[j].z + s[j].w); }
                sum = red16_sum(sum); const float inv = 1.0f / sum;
                unsigned o[8];
#pragma unroll
                for (int j = 0; j < 4; ++j) { o[2 * j] = pk2(s[j].x * inv, s[j].y * inv); o[2 * j + 1] = pk2(s[j].z * inv, s[j].w * inv); }
                *(GAS v4u*)(PM + (size_t)t * 1024 + 16 * lane) = (v4u){o[0], o[1], o[2], o[3]};
                *(GAS v4u*)(PM + (size_t)t * 1024 + 16 * lane + 8) = (v4u){o[4], o[5], o[6], o[7]};
            }
        }
        if (BOTH(4)) GRID_BAR();
    }

    if (IN(5)) {
        PHASE_IDS();
        constexpr int NSCAN = 96;
        if (bx < NSCAN) {
            const int head = 3 * (bx & 7) + (bx >> 5), rb = (bx >> 3) & 3, gk = lane >> 4, j = lane & 15, n0 = 16 * (wave & 3);
            constexpr int SP = 272, SBUF = 16 * SP;
            for (int i = tid; i < 2 * SBUF / 4; i += 512) *(LAS float*)(lds + i * 4) = 0.f;
            __syncthreads();
            int cur = 0;
            if (wave < 4) {
                const float* bsrc = PCT + ((size_t)head * 128 * 64 + n0 + j) * 64 + 16 * gk;
                const bf16* xsrc = SLOCT + ((size_t)head * 128 * 64 + n0 + j) * 64 + 16 * rb + 4 * gk;
                f32x4 bqs[3][4]; v2u xqs[3];
#define S2_LOAD(set, cc) do { const int cl_ = (cc) < 127 ? (cc) : 127; _Pragma("unroll") for (int q4 = 0; q4 < 4; ++q4) bqs[set][q4] = *(const GAS f32x4*)(bsrc + (size_t)cl_ * 4096 + 4 * q4); \
                    xqs[set] = *(const GAS v2u*)(xsrc + (size_t)cl_ * 4096); } while (0)
#define S2_STEP(set, cc) do { f32x4 a4[4]; _Pragma("unroll") for (int q4 = 0; q4 < 4; ++q4) a4[q4] = *(LAS const f32x4*)(lds + cur * SBUF + j * SP + (16 * gk + 4 * q4) * 4); \
                    f32x4 acc[4]; _Pragma("unroll") for (int e = 0; e < 4; ++e) acc[e] = (f32x4){0.f, 0.f, 0.f, 0.f}; \
                    _Pragma("unroll") for (int q4 = 0; q4 < 4; ++q4) _Pragma("unroll") for (int e = 0; e < 4; ++e) acc[e] = __builtin_amdgcn_mfma_f32_16x16x4f32(a4[q4][e], bqs[set][q4][e], acc[e], 0, 0, 0); \
                    const f32x4 sum = (acc[0] + acc[1]) + (acc[2] + acc[3]) + (f32x4){bflo(xqs[set].x), bfhi(xqs[set].x), bflo(xqs[set].y), bfhi(xqs[set].y)}; \
                    _Pragma("unroll") for (int r = 0; r < 4; ++r) *(LAS float*)(lds + (cur ^ 1) * SBUF + (4 * gk + r) * SP + (n0 + j) * 4) = sum[r]; \
                    S2_LOAD(set, (cc) + 3); __syncthreads(); cur ^= 1; } while (0)
                S2_LOAD(0, 0); S2_LOAD(1, 1); S2_LOAD(2, 2);
                for (int c = 0; c < 126; c += 3) { S2_STEP(0, c); S2_STEP(1, c + 1); S2_STEP(2, c + 2); } S2_STEP(0, 126); S2_STEP(1, 127);
#undef S2_LOAD
#undef S2_STEP
            } else {
                const int srow = 4 * (wave - 4) + (lane >> 4), sk = 4 * (lane & 15);
                bf16* dst = S0ALL + ((size_t)head * 128 * 64 + 16 * rb + srow) * 64 + sk;
                for (int c = 0; c < 128; ++c) { const f32x4 sv = *(LAS const f32x4*)(lds + cur * SBUF + srow * SP + sk * 4); *(GAS v2u*)(dst + (size_t)c * 4096) = (v2u){pk2(sv[0], sv[1]), pk2(sv[2], sv[3])}; __syncthreads(); cur ^= 1; }
            }
        }
        {
            const int GA = G - NSCAN, ca = bx - NSCAN;
            float thr;
            {
                const float* gq = args.in[I_SBQG]; const float* gk = args.in[I_SBKG];
                float mq = fmaxf(fabsf(gq[lane]), fabsf(gq[lane + 64])), mk = fmaxf(fabsf(gk[lane]), fabsf(gk[lane + 64]));
#pragma unroll
                for (int o = 1; o < 64; o <<= 1) { mq = fmaxf(mq, __shfl_xor(mq, o)); mk = fmaxf(mk, __shfl_xor(mk, o)); }
                thr = (11.3137085f * 1.02f * mq * mk + 104.0f) * 1.4426950408889634f;
            }
            constexpr int KPITCH = 272, VPITCH = 136, KBUF = 64 * KPITCH, VBUF = 128 * VPITCH, VOFF = 2 * KBUF, FLAGOFF = VOFF + 2 * VBUF, UQOFF = FLAGOFF + 64;
            const int hh = lane >> 5, l31 = lane & 31;
            __syncthreads();
            for (;;) {
                if (tid == 0) *(LAS int*)(lds + UQOFF) = (int)__hip_atomic_fetch_add((unsigned*)(ctl + CW_Q2), 1u, __ATOMIC_RELAXED, __HIP_MEMORY_SCOPE_AGENT);
                __syncthreads();
                const int uidx = *(LAS const int*)(lds + UQOFF);
                if (uidx >= 12 * 32) break;
                const int head = uidx % 12, qb = 31 - uidx / 12;
                const int q0 = qb * 256 + wave * 32, qi = q0 + l31;
                bf16x8 qf[8];
                { const bf16* qp = QN + (size_t)qi * 1536 + head * 128 + 8 * hh;
#pragma unroll
                  for (int s = 0; s < 8; ++s) qf[s] = *(const GAS bf16x8*)(qp + 16 * s); }
                f32x16 o[4];
#pragma unroll
                for (int c = 0; c < 4; ++c)
#pragma unroll
                    for (int r = 0; r < 16; ++r) o[c][r] = 0.f;
                float carry = 0.f; bool mydone = false;
                const int kkey = tid >> 3, kc = (tid & 7) * 2, vhd = tid >> 2, vp = tid & 3;
                const unsigned kofs = (unsigned)(kkey * 1536 + kc * 8) * 2u, vofs = (unsigned)(vhd * T + vp * 16) * 2u;
                const char* kgb = (const char*)KN + (size_t)head * 256; const char* vgb = (const char*)VT + (size_t)head * 128 * T * 2;
                v4u kr0, kr1, vr0, vr1;
#define SB_LOAD(kt_) do { const char* kb_ = kgb + (size_t)(kt_) * 64 * 1536 * 2; const char* vb_ = vgb + (size_t)(kt_) * 128; \
                          kr0 = *(const GAS v4u*)(kb_ + kofs); kr1 = *(const GAS v4u*)(kb_ + kofs + 16); vr0 = *(const GAS v4u*)(vb_ + vofs); vr1 = *(const GAS v4u*)(vb_ + vofs + 16); } while (0)
#define SB_STORE(buf_) do { LAS unsigned char* kd = lds + (buf_) * KBUF + kkey * KPITCH + kc * 16; *(LAS v4u*)kd = kr0; *(LAS v4u*)(kd + 16) = kr1; \
                          LAS unsigned char* vd = lds + VOFF + (buf_) * VBUF + vhd * VPITCH + vp * 32; *(LAS v2u*)vd = (v2u){vr0.x, vr0.y}; *(LAS v2u*)(vd + 8) = (v2u){vr0.z, vr0.w}; \
                          *(LAS v2u*)(vd + 16) = (v2u){vr1.x, vr1.y}; *(LAS v2u*)(vd + 24) = (v2u){vr1.z, vr1.w}; } while (0)
                int kt = 4 * qb + 3, cur = 0, it = 0;
                SB_LOAD(kt); SB_STORE(0); __syncthreads();
                for (;;) {
                    const bool more = kt > 0;
                    if (more) SB_LOAD(kt - 1);
                    const int k0 = kt * 64;
                    if (!mydone && k0 < q0 + 31) {
                        LAS const unsigned char* Kb = lds + cur * KBUF; LAS const unsigned char* Vb = lds + VOFF + cur * VBUF;
                        bf16x8 wf[2][2];
#pragma unroll
                        for (int b = 1; b >= 0; --b) {
                            f32x16 z;
#pragma unroll
                            for (int r = 0; r < 16; ++r) z[r] = 0.f;
#pragma unroll
                            for (int s = 0; s < 8; ++s) { const bf16x8 kf = *(LAS const bf16x8*)(Kb + (32 * b + l31) * KPITCH + (16 * s + 8 * hh) * 2);
                                z = __builtin_amdgcn_mfma_f32_32x32x16_bf16(kf, qf[s], z, 0, 0, 0); }
                            float sp[16];
                            const int lim = qi - k0 - 32 * b - 4 * hh;
#pragma unroll
                            for (int r = 0; r < 16; ++r) { const float zz = z[r];
                                const float v = fmaxf(zz, 0.f) + __builtin_amdgcn_logf(1.0f + __builtin_amdgcn_exp2f(-fabsf(zz))); sp[r] = (((r & 3) + 8 * (r >> 2)) < lim) ? v : 0.f; }
                            float Gs[4], Gp[4], Tt[4];
#pragma unroll
                            for (int i = 0; i < 4; ++i) { Gs[i] = (sp[4 * i] + sp[4 * i + 1]) + (sp[4 * i + 2] + sp[4 * i + 3]); Gp[i] = __shfl_xor(Gs[i], 32); Tt[i] = Gs[i] + Gp[i]; }
                            float X[4]; X[3] = 0.f; X[2] = Tt[3]; X[1] = X[2] + Tt[2]; X[0] = X[1] + Tt[1];
                            unsigned wp[8];
#pragma unroll
                            for (int i = 0; i < 4; ++i) {
                                const float newer = carry + X[i] + (hh == 0 ? Gp[i] : 0.f);
                                const float t3 = newer + sp[4 * i + 3], t2 = t3 + sp[4 * i + 2], t1 = t2 + sp[4 * i + 1], t0 = t1 + sp[4 * i];
                                const float tl[4] = {t0, t1, t2, t3}; float w[4];
#pragma unroll
                                for (int j = 0; j < 4; ++j) { const float e = __builtin_amdgcn_exp2f(z[4 * i + j] - tl[j]); w[j] = ((j + 8 * i) < lim) ? e : 0.f; }
                                wp[2 * i] = pk2(w[0], w[1]); wp[2 * i + 1] = pk2(w[2], w[3]);
                            }
                            carry += X[0] + Tt[0];
                            wf[b][0] = __builtin_bit_cast(bf16x8, (v4u){wp[0], wp[1], wp[2], wp[3]}); wf[b][1] = __builtin_bit_cast(bf16x8, (v4u){wp[4], wp[5], wp[6], wp[7]});
                        }
#pragma unroll
                        for (int b = 0; b < 2; ++b)
#pragma unroll
                            for (int s = 0; s < 2; ++s)
#pragma unroll
                                for (int c = 0; c < 4; ++c) { LAS const unsigned char* vpz = Vb + (32 * c + l31) * VPITCH + (32 * b + 16 * s + 4 * hh) * 2;
                                    const v2u va = *(LAS const v2u*)vpz, vb2 = *(LAS const v2u*)(vpz + 16);
                                    const bf16x8 vf = __builtin_bit_cast(bf16x8, (v4u){va.x, va.y, vb2.x, vb2.y});
                                    o[c] = __builtin_amdgcn_mfma_f32_32x32x16_bf16(vf, wf[b][s], o[c], 0, 0, 0); }
                        mydone = __all(carry > thr);
                    }
                    if (more) SB_STORE(cur ^ 1);
                    if (lane == 0) *(LAS unsigned*)(lds + FLAGOFF + ((it & 1) * 8 + wave) * 4) = mydone ? 1u : 0u;
                    __syncthreads();
                    if (!more) break;
                    { const v4u f0 = *(LAS const v4u*)(lds + FLAGOFF + (it & 1) * 32), f1 = *(LAS const v4u*)(lds + FLAGOFF + (it & 1) * 32 + 16);
                      if ((f0.x & f0.y & f0.z & f0.w & f1.x & f1.y & f1.z & f1.w) != 0u) break; }
                    --kt; cur ^= 1; ++it;
                }
#undef SB_LOAD
#undef SB_STORE
                bf16* op = OCAT + (size_t)qi * 4096 + head * 128 + 4 * hh;
#pragma unroll
                for (int c = 0; c < 4; ++c)
#pragma unroll
                    for (int i = 0; i < 4; ++i) *(GAS v2u*)(op + 32 * c + 8 * i) = (v2u){pk2(o[c][4 * i], o[c][4 * i + 1]), pk2(o[c][4 * i + 2], o[c][4 * i + 3])};
                __syncthreads();
            }
            if (bx >= NSCAN) { int nt4 = 4; asm volatile("" : "+s"(nt4)); pg8::SchedHeads S; S.G = GA; S.c = ca; S.nunits = 128; S.nt = nt4; S.A0 = (const char*)PM; S.B0 = (const char*)MVT; S.sA = 256 * 1024 * 2; S.hA = 512; S.hB = 256 * 1024 * 2;
              pg8::EpiBf16 E{OCAT, 4096, 3072, 256};
              pg8::gemm_phase(lds, 1024, 1024, S, E); }
        }
        if (BOTH(4)) GRID_BAR();
    }

    if (IN(6)) {
        PHASE_IDS();
        {
            const float* lng = args.in[I_RWLNG]; const float* lnb = args.in[I_RWLNB];
            const int l31 = lane & 31, lh = lane >> 5, sub = wave >> 2, mt = (wave >> 1) & 1, nt = wave & 1;
            LAS float* xch = (LAS float*)lds;
            for (int it0 = 2 * bx; it0 < 24 * 128; it0 += 2 * G) {
                const int unit = it0 + sub, item = ((unit % 24) << 7) + unit / 24, head = item >> 7, chunk = item & 127;
                const int tq = 32 * nt + l31; const size_t trow = (size_t)(chunk * 64 + tq);
                const bf16* ap = S0ALL + ((size_t)item * 64 + 32 * mt + l31) * 64 + 8 * lh;
                const bf16* bp = PHIT + ((size_t)item * 64 + tq) * 64 + 8 * lh;
                v4u af[4], bfv[4];
#pragma unroll
                for (int ks = 0; ks < 4; ++ks) { af[ks] = *(const GAS v4u*)(ap + 16 * ks); bfv[ks] = *(const GAS v4u*)(bp + 16 * ks); }
                f32x4 yl[4], vv4[4]; v2u gg[4];
                { const int vc = head * 64 + 32 * mt + 4 * lh; const bf16* yp = Y + trow * 1536 + vc; const bf16* gp = GB + trow * 1536 + vc;
                  const bf16* pc = P + trow * NINP + PRW + 3072 + vc; const float* mxp = args.in[I_RWMIX] + 3072 + vc;
#pragma unroll
                  for (int i = 0; i < 4; ++i) { { const v2u y2 = *(const GAS v2u*)(yp + 8 * i); yl[i] = (f32x4){bflo(y2.x), bfhi(y2.x), bflo(y2.y), bfhi(y2.y)}; } gg[i] = *(const GAS v2u*)(gp + 8 * i);
                      const v2u c2 = *(const GAS v2u*)(pc + 8 * i); v2u p2 = (v2u){0u, 0u}; if (trow > 0) p2 = *(const GAS v2u*)(pc - NINP + 8 * i); const f32x4 mx = *(const GAS f32x4*)(mxp + 8 * i);
                      const float cv4[4] = {bflo(c2.x), bfhi(c2.x), bflo(c2.y), bfhi(c2.y)}, pv4[4] = {bflo(p2.x), bfhi(p2.x), bflo(p2.y), bfhi(p2.y)};
#pragma unroll
                      for (int e = 0; e < 4; ++e) vv4[i][e] = cv4[e] + (pv4[e] - cv4[e]) * mx[e]; } }
                const float bon = BONUS[trow * 24 + head];
                f32x16 acc;
#pragma unroll
                for (int r = 0; r < 16; ++r) acc[r] = 0.f;
#pragma unroll
                for (int ks = 0; ks < 4; ++ks) {
                    acc = __builtin_amdgcn_mfma_f32_32x32x16_bf16(__builtin_bit_cast(bf16x8, af[ks]), __builtin_bit_cast(bf16x8, bfv[ks]), acc, 0, 0, 0); }
                float yv[16]; float s1 = 0.f, s2 = 0.f;
#pragma unroll
                for (int i = 0; i < 4; ++i)
#pragma unroll
                    for (int e = 0; e < 4; ++e) { const float y = acc[4 * i + e] + yl[i][e]; yv[4 * i + e] = y; s1 += y; s2 += y * y; }
                s1 += __shfl_xor(s1, 32); s2 += __shfl_xor(s2, 32);
                if (lh == 0) { xch[((sub * 2 + mt) * 64 + tq) * 2] = s1; xch[((sub * 2 + mt) * 64 + tq) * 2 + 1] = s2; }
                __syncthreads();
                { const float o1 = xch[((sub * 2 + (mt ^ 1)) * 64 + tq) * 2], o2 = xch[((sub * 2 + (mt ^ 1)) * 64 + tq) * 2 + 1]; s1 += o1; s2 += o2; }
                const float mu = s1 * (1.f / 64.f), var = fmaxf(s2 * (1.f / 64.f) - mu * mu, 0.f), rstd = 1.0f / sqrtf(var + GN_EPS);
                bf16* op = OCAT + trow * 4096 + 1536 + head * 64 + 32 * mt + 4 * lh;
#pragma unroll
                for (int i = 0; i < 4; ++i) { const int vb = head * 64 + 32 * mt + 8 * i + 4 * lh; const f32x4 gv = *(const GAS f32x4*)(lng + vb), bv = *(const GAS f32x4*)(lnb + vb);
                    const float g4[4] = {bflo(gg[i].x), bfhi(gg[i].x), bflo(gg[i].y), bfhi(gg[i].y)}; float o[4];
#pragma unroll
                    for (int e = 0; e < 4; ++e) o[e] = ((yv[4 * i + e] - mu) * rstd * gv[e] + bv[e] + bon * vv4[i][e]) * g4[e];
                    *(GAS v2u*)(op + 8 * i) = (v2u){pk2(o[0], o[1]), pk2(o[2], o[3])}; }
                __syncthreads();
            }
        }
        {
            LAS float* scr = (LAS float*)(lds + wave * 16384);
            for (int qi = gw; qi < Q2_ITEMS; qi += NGW) Q2_BODY;
        }
        if (BOTH(6)) GRID_BAR();
    }

    if (IN(7)) {
        PHASE_IDS();
        pg8::SchedMerge S; S.to.init(32, 16); S.G = G; S.c = bx; S.OC = (const char*)OCAT; S.WC = (const char*)WCAT_T;
        pg8::EpiMerge E{P, MERGED};
        pg8::gemm_phase(lds, 4096, 4096, S, E);
        if (BOTH(7)) GRID_BAR();
    }

    if (IN(8)) {
        PHASE_IDS();
        pg8::SchedPlain S; S.to.init(32, 16); S.G = G; S.c = bx; S.nt = 64; S.A0 = (const char*)MERGED; S.B0 = (const char*)WOUT_T; S.sA = (size_t)256 * 4096 * 2; S.sB = (size_t)256 * 4096 * 2;
        pg8::EpiResF32 E{args.in[I_X], H1};
        pg8::gemm_phase(lds, 4096, 4096, S, E);
        if (BOTH(8)) GRID_BAR();
    }

    if (IN(9)) {
        PHASE_IDS();
        rms_rows4096(H1, args.in[I_FFNG], XN, gw, NGW, T, lane);
        if (BOTH(9)) GRID_BAR();
    }

    if (IN(10)) {
        PHASE_IDS();
        pg8::SchedPlain S; S.to.init(32, 86); S.G = G; S.c = bx; S.nt = 64; S.A0 = (const char*)XN; S.B0 = (const char*)WGU_T; S.sA = (size_t)256 * 4096 * 2; S.sB = (size_t)256 * 4096 * 2;
        pg8::EpiSwiGLU E{ACT};
        pg8::gemm_phase(lds, 4096, 4096, S, E);
        if (BOTH(10)) GRID_BAR();
    }

    if (IN(11)) {
        PHASE_IDS();
        pg8::SchedPlain S; S.to.init(32, 16); S.G = G; S.c = bx; S.nt = 172; S.A0 = (const char*)ACT; S.B0 = (const char*)WD_T; S.sA = (size_t)256 * DFF * 2; S.sB = (size_t)256 * DFF * 2;
        pg8::EpiResF32 E{H1, args.out};
        pg8::gemm_phase(lds, DFF, DFF, S, E);
    }
#undef IN
#undef BOTH
}

extern "C" void kernel_launch(void* const* d_in, const int* in_sizes, int n_in, void* d_out, int out_size, void* d_ws, size_t ws_size, hipStream_t stream) {
    static int grid = 0;
    if (grid == 0) {
        if (n_in != 29 || in_sizes[0] != T * D || out_size != T * D || ws_size < WS_END) {
            fprintf(stderr, "kernel_launch: unexpected problem (n_in %d, in0 %d, out %d, ws %zu, need %zu); nothing launched\n", n_in, n_in > 0 ? in_sizes[0] : -1, out_size, ws_size, (size_t)WS_END); grid = -1; return; }
        int dev = 0, cus = 0, per_cu = 0;
        if (hipGetDevice(&dev) != hipSuccess || hipDeviceGetAttribute(&cus, hipDeviceAttributeMultiprocessorCount, dev) != hipSuccess) { grid = -1; return; }
        if (hipFuncSetAttribute((const void*)hybrid_fwd, hipFuncAttributeMaxDynamicSharedMemorySize, LDS_BYTES) != hipSuccess) { fprintf(stderr, "kernel_launch: hipFuncSetAttribute failed\n"); grid = -1; return; }
        if (hipOccupancyMaxActiveBlocksPerMultiprocessor(&per_cu, (const void*)hybrid_fwd, NWAVES * 64, LDS_BYTES) != hipSuccess || per_cu < 1)
            fprintf(stderr, "kernel_launch: note: occupancy query reports %d workgroups per CU\n", per_cu);
        (void)hipGetLastError();
        grid = cus;
    }
    if (grid < 0) return;
    if (hipMemsetAsync((char*)d_ws + WS_CTL, 0, CTL_ZERO_BYTES, stream) != hipSuccess) return;
    Args a{};
    for (int i = 0; i < 29; ++i) a.in[i] = (const float*)d_in[i];
    a.out = (float*)d_out; a.ws = (unsigned char*)d_ws;
#if MK_PER_PHASE
    for (int p = 0; p < NPHASES; ++p) { a.ph_lo = p; a.ph_hi = p + 1; hipLaunchKernelGGL(hybrid_fwd, dim3(grid), dim3(NWAVES * 64), LDS_BYTES, stream, a); }
#else
    a.ph_lo = 0; a.ph_hi = NPHASES;
    hipLaunchKernelGGL(hybrid_fwd, dim3(grid), dim3(NWAVES * 64), LDS_BYTES, stream, a);
#endif
}
```

```cpp
#include <hip/hip_runtime.h>
#include <cstdio>
#include <cstdint>

#ifndef MK_PER_PHASE
#define MK_PER_PHASE 0
#endif

constexpr int T = 8192, D = 4096, NMEM = 256;
constexpr int SBW = 1536, RWW = 1536, MEMW = 1024, RWSEG = 5344, DFF = 11008;
constexpr int NIN_ORIG = 23264, NINP = 23296;
constexpr int PQ = 0, PK = 1536, PV = 3072, PRW = 4608, PMQ = 9984, PG = 11008;
constexpr float RMS_EPS = 1e-6f, GN_EPS = 64e-5f;

constexpr size_t MiB = 1u << 20;
constexpr size_t WS_CTL = 0, CTL_ZERO_BYTES = 256 * 1024;
constexpr size_t WS_WIN_T = 1 * MiB;
constexpr size_t WS_WCAT_T = WS_WIN_T + 182 * MiB;
constexpr size_t WS_WOUT_T = WS_WCAT_T + 32 * MiB;
constexpr size_t WS_WKV_T = WS_WOUT_T + 32 * MiB;
constexpr size_t WS_LBWA = WS_WKV_T + 16 * MiB;
constexpr size_t WS_LBG = WS_LBWA + 2 * MiB;
constexpr size_t WS_XN = WS_LBG + 2 * MiB;
constexpr size_t WS_MEMN = WS_XN + 64 * MiB;
constexpr size_t WS_P = WS_MEMN + 2 * MiB;
constexpr size_t WS_R = WS_P + 364 * MiB;
constexpr size_t RSZ = 48 * MiB;
constexpr size_t WS_G = WS_R + 6 * RSZ;
constexpr size_t WS_Y = WS_G + 24 * MiB;
constexpr size_t WS_OCAT = WS_Y + 48 * MiB;
constexpr size_t WS_LATE = WS_OCAT + 64 * MiB;
constexpr size_t WS_QN = WS_LATE;
constexpr size_t WS_KN = WS_QN + 24 * MiB;
constexpr size_t WS_VT = WS_KN + 24 * MiB;
constexpr size_t WS_MQN = WS_VT + 24 * MiB;
constexpr size_t WS_MKRAW = WS_MQN + 16 * MiB;
constexpr size_t WS_MKN = WS_MKRAW + 1 * MiB;
constexpr size_t WS_MVT = WS_MKN + 1 * MiB;
constexpr size_t WS_SM = WS_MVT + 2 * MiB;
constexpr size_t WS_PM = WS_SM + 32 * MiB;
constexpr size_t WS_LA1 = WS_PM + 16 * MiB;
constexpr size_t WS_LA2 = WS_LA1 + 4 * MiB;
constexpr size_t WS_EARLY_END = WS_LA2 + 8 * MiB;
constexpr size_t WS_PHIT = WS_EARLY_END;
constexpr size_t WS_PCT = WS_PHIT + 48 * MiB;
constexpr size_t WS_SLOCT = WS_PCT + 48 * MiB;
constexpr size_t WS_BONUS = WS_SLOCT + 48 * MiB;
constexpr size_t WS_RWKV_END = WS_BONUS + 1 * MiB;
constexpr size_t WS_WGU_T = WS_WIN_T;
constexpr size_t WS_WD_T = WS_R + 2 * RSZ;
constexpr size_t WS_END = WS_RWKV_END;
constexpr size_t WS_MERGED = WS_R;
constexpr size_t WS_H1 = WS_LATE;
constexpr size_t WS_ACT = WS_P;
static_assert(WS_H1 + 128 * MiB <= WS_EARLY_END && WS_WD_T + 86 * MiB <= WS_R + 4 * RSZ, "H1 / W_down copy homes");
static_assert(WS_END <= 1454ull * MiB, "workspace map exceeds the guaranteed 4x largest tensor");

constexpr int CW_TMO = 0, CW_CODE = 1, CW_BAR = 4096, CW_Q1 = 32768, CW_Q2 = 32768 + 64;

constexpr int RING_BYTES = 131072, LDSCTL_OFF = 159744, MISC_OFF = LDSCTL_OFF + 320, LDS_BYTES = 163840;
constexpr int NWAVES = 8;

#define GAS __attribute__((address_space(1)))
#define LAS __attribute__((address_space(3)))
typedef unsigned short bf16;
typedef unsigned v4u __attribute__((ext_vector_type(4)));
typedef unsigned v2u __attribute__((ext_vector_type(2)));
typedef float f32x4 __attribute__((ext_vector_type(4)));
typedef float f32x2 __attribute__((ext_vector_type(2)));
typedef float f32x16 __attribute__((ext_vector_type(16)));
typedef short bf16x8 __attribute__((ext_vector_type(8)));
typedef short s16x4 __attribute__((ext_vector_type(4)));
typedef GAS unsigned gu32;

typedef __bf16 hwbf16x2 __attribute__((ext_vector_type(2)));
__device__ __forceinline__ unsigned pk2(float lo, float hi) { const f32x2 v = {lo, hi}; return __builtin_bit_cast(unsigned, __builtin_convertvector(v, hwbf16x2)); }
__device__ __forceinline__ unsigned f2bf(float f) { return pk2(f, 0.f) & 0xffffu; }
__device__ __forceinline__ float bflo(unsigned w) { return __builtin_bit_cast(float, w << 16); }
__device__ __forceinline__ float bfhi(unsigned w) { return __builtin_bit_cast(float, w & 0xffff0000u); }
__device__ __forceinline__ float fexp(float x) { return __builtin_amdgcn_exp2f(x * 1.44269504088896f); }
__device__ __forceinline__ float flog(float x) { return __builtin_amdgcn_logf(x) * 0.693147180559945f; }
__device__ __forceinline__ float frcp(float x) { return __builtin_amdgcn_rcpf(x); }
__device__ __forceinline__ float sigmoidf_(float x) { return frcp(1.0f + fexp(-x)); }
__device__ __forceinline__ float softplusf_(float x) { return fmaxf(x, 0.f) + flog(1.0f + fexp(-fabsf(x))); }
__device__ __forceinline__ float wave_sum(float v) {
#pragma unroll
    for (int o = 1; o < 64; o <<= 1) v += __shfl_xor(v, o);
    return v;
}
__device__ __forceinline__ float dpp_f(float x, const int ctrl_sel) {
    return x;
}
#define DPP_ADD(x, ctrl) ((x) + __builtin_bit_cast(float, __builtin_amdgcn_update_dpp(0, __builtin_bit_cast(int, (x)), (ctrl), 0xF, 0xF, true)))
#define DPP_MAX(x, ctrl) fmaxf((x), __builtin_bit_cast(float, __builtin_amdgcn_update_dpp(0, __builtin_bit_cast(int, (x)), (ctrl), 0xF, 0xF, true)))
__device__ __forceinline__ float quad_bcast(float x, int g) {
    const int xi = __builtin_bit_cast(int, x);
    switch (g) {
        case 0: return __builtin_bit_cast(float, __builtin_amdgcn_update_dpp(0, xi, 0x00, 0xF, 0xF, true));
        case 1: return __builtin_bit_cast(float, __builtin_amdgcn_update_dpp(0, xi, 0x55, 0xF, 0xF, true));
        case 2: return __builtin_bit_cast(float, __builtin_amdgcn_update_dpp(0, xi, 0xAA, 0xF, 0xF, true));
        default: return __builtin_bit_cast(float, __builtin_amdgcn_update_dpp(0, xi, 0xFF, 0xF, 0xF, true));
    }
}
__device__ __forceinline__ float red16_sum(float x) {
    x = DPP_ADD(x, 0xB1); x = DPP_ADD(x, 0x4E); x = DPP_ADD(x, 0x141); x = DPP_ADD(x, 0x140); return x;
}
__device__ __forceinline__ float wave_sum_u(float x) {
    x = red16_sum(x);
    x += __builtin_bit_cast(float, __builtin_amdgcn_update_dpp(0, __builtin_bit_cast(int, x), 0x142, 0xA, 0xF, false));
    x += __builtin_bit_cast(float, __builtin_amdgcn_update_dpp(0, __builtin_bit_cast(int, x), 0x143, 0xC, 0xF, false));
    return __builtin_bit_cast(float, __builtin_amdgcn_readlane(__builtin_bit_cast(int, x), 63));
}
__device__ __forceinline__ float red16_max(float x) {
    x = DPP_MAX(x, 0xB1); x = DPP_MAX(x, 0x4E); x = DPP_MAX(x, 0x141); x = DPP_MAX(x, 0x140); return x;
}

namespace pg8 {
#define PG8_LAS __attribute__((address_space(3)))
typedef unsigned short bf16_t;
typedef unsigned u32x4 __attribute__((ext_vector_type(4)));
constexpr int BM = 256, BK = 64, HALF = 128, HTB = HALF * BK * 2, STAGE_BYTES = 8 * HTB, NXCD = 8, WGM = 4;

__host__ __device__ __forceinline__ int lds_byte(int r, int c) { const int st = (r >> 4) * 2 + (c >> 5), rr = r & 15, cc = c & 31, ob = rr * 64 + cc * 2; return st * 1024 + (ob ^ (((ob >> 9) & 1) << 5)); }
__host__ __device__ __forceinline__ void stage_rc(int b, int& R, int& C) { const int st = b / 1024, sb = b % 1024, swz = sb ^ (((sb >> 9) & 1) << 5); R = (st >> 1) * 16 + swz / 64; C = (st & 1) * 32 + (swz % 64) / 2; }
__host__ __device__ __forceinline__ int perm32(int rho) { const int n = rho >> 4, i = rho & 15; return 8 * (i >> 2) + 4 * n + (i & 3); }

struct Unit { const char* A; const char* B; int nt, pm, pn, kind; };

struct TileOrder {
    int nM, nN, nwg;
    __device__ __forceinline__ void init(int nM_, int nN_) { nM = nM_; nN = nN_; nwg = nM_ * nN_; }
    __device__ __forceinline__ void map(int L, int& pm, int& pn) const {
        int wgid = L; { const int q = nwg / NXCD, r = nwg % NXCD, xcd = wgid % NXCD, off = wgid / NXCD; wgid = (xcd < r ? xcd * (q + 1) : r * (q + 1) + (xcd - r) * q) + off; }
        const int nig = WGM * nN, gid = wgid / nig, fm = gid * WGM, gsz = (nM - fm) < WGM ? (nM - fm) : WGM;
        pm = fm + ((wgid % nig) % gsz); pn = (wgid % nig) / gsz;
    }
};

__device__ __forceinline__ unsigned cvt_pk_bf16(float lo, float hi) { unsigned r; asm volatile("v_cvt_pk_bf16_f32 %0, %1, %2" : "=v"(r) : "v"(lo), "v"(hi)); return r; }

template <class Epi, class Sched>
__device__ __forceinline__ void gemm_phase(PG8_LAS unsigned char* lds, const int lda, const int ldb, const Sched& S, const Epi& E) {
    const int tid = threadIdx.x, wid = __builtin_amdgcn_readfirstlane(tid >> 6), lane = tid & 63, wr = wid >> 2, wc = wid & 3, fr = lane & 15, fq = lane >> 4;
    unsigned voffA[2], voffB[2];
#pragma unroll
    for (int i = 0; i < 2; ++i) { int R, C; stage_rc(tid * 16 + i * 8192, R, C); const int Rb = Epi::PERM ? ((R & ~31) + perm32(R & 31)) : R;
        voffA[i] = (unsigned)(R * lda + C) * 2u; voffB[i] = (unsigned)(Rb * ldb + C) * 2u; }
    const size_t kstep = (size_t)(BK * 2);
    const size_t hstepA = (size_t)HALF * lda * 2, hstepB = (size_t)HALF * ldb * 2;
    const unsigned ldsw = (unsigned)wid * 1024u;
    const int aoff = lds_byte(wr * 64 + fr, fq * 8), boff = lds_byte(wc * 32 + fr, fq * 8);
#define PG8_SA(b, h) (((b) * 2 + (h)) * HTB)
#define PG8_SB(b, h) ((4 + (b) * 2 + (h)) * HTB)
#define PG8_STAGE(bufoff, gbase, voff) do { _Pragma("unroll") for (int _i = 0; _i < 2; ++_i) \
        __builtin_amdgcn_global_load_lds((const unsigned*)((const char*)(gbase) + (voff)[_i]), (PG8_LAS unsigned*)(lds + (bufoff) + ldsw + _i * 8192), 16, 0, 0); } while (0)
#define PG8_LDA(dst, b, h) do { _Pragma("unroll") for (int m = 0; m < 4; ++m) _Pragma("unroll") for (int k = 0; k < 2; ++k) dst[m][k] = *(const PG8_LAS bf16x8*)(lds + PG8_SA(b, h) + aoff + m * 2048 + k * 1024); } while (0)
#define PG8_LDB(dst, b, h) do { _Pragma("unroll") for (int n = 0; n < 2; ++n) _Pragma("unroll") for (int k = 0; k < 2; ++k) dst[n][k] = *(const PG8_LAS bf16x8*)(lds + PG8_SB(b, h) + boff + n * 2048 + k * 1024); } while (0)
#define PG8_MMA(ai, bj, At, Bt) do { __builtin_amdgcn_s_setprio(1); _Pragma("unroll") for (int m = 0; m < 4; ++m) _Pragma("unroll") for (int n = 0; n < 2; ++n) _Pragma("unroll") for (int k = 0; k < 2; ++k) \
        acc[ai][bj][m][n] = __builtin_amdgcn_mfma_f32_16x16x32_bf16(Bt[n][k], At[m][k], acc[ai][bj][m][n], 0, 0, 0); __builtin_amdgcn_s_setprio(0); } while (0)
#define PG8_WAIT_V(n) asm volatile("s_waitcnt vmcnt(" #n ")" ::: "memory")
#define PG8_WAIT_L(n) asm volatile("s_waitcnt lgkmcnt(" #n ")" ::: "memory")
#define PG8_BAR __builtin_amdgcn_s_barrier()
#define PG8_SCHED __builtin_amdgcn_sched_barrier(0)
    Unit cur, nxt; int ui = 0;
    if (!S.next(0, cur)) return;
    f32x4 acc[2][2][4][2];
#pragma unroll
    for (int a = 0; a < 2; ++a)
#pragma unroll
        for (int b = 0; b < 2; ++b)
#pragma unroll
            for (int m = 0; m < 4; ++m)
#pragma unroll
                for (int n = 0; n < 2; ++n) acc[a][b][m][n] = (f32x4){0.f, 0.f, 0.f, 0.f};
    bf16x8 At[4][2], B0[2][2], B1[2][2];
    const char* cA = cur.A; const char* cB = cur.B; int nt = cur.nt;
    PG8_STAGE(PG8_SB(0, 0), cB, voffB); PG8_STAGE(PG8_SB(0, 1), cB + hstepB, voffB); PG8_STAGE(PG8_SA(0, 0), cA, voffA); PG8_STAGE(PG8_SA(0, 1), cA + hstepA, voffA);
    if (wr == 1) PG8_BAR;
    PG8_WAIT_V(2); PG8_BAR;
    PG8_STAGE(PG8_SB(1, 0), cB + kstep, voffB); PG8_STAGE(PG8_SA(1, 0), cA + kstep, voffA); PG8_STAGE(PG8_SB(1, 1), cB + hstepB + kstep, voffB);
    PG8_WAIT_V(6); PG8_BAR;
    for (;;) {
        const bool has_next = S.next(ui + 1, nxt);
        const char* nA = has_next ? nxt.A : cA; const char* nB = has_next ? nxt.B : cB;
        for (int t = 0; t < nt; t += 2) {
            const bool last = (t == nt - 2);
            const char* a1 = cA + (size_t)(t + 1) * kstep;
            const char* a2 = last ? nA : cA + (size_t)(t + 2) * kstep; const char* b2 = last ? nB : cB + (size_t)(t + 2) * kstep;
            const char* a3 = a2 + kstep; const char* b3 = b2 + kstep;
            PG8_LDB(B0, 0, 0); PG8_LDB(B1, 0, 1); PG8_SCHED; PG8_LDA(At, 0, 0); PG8_STAGE(PG8_SA(1, 1), a1 + hstepA, voffA);
            PG8_WAIT_V(8); PG8_WAIT_L(0); PG8_BAR; PG8_MMA(0, 0, At, B0); PG8_MMA(0, 1, At, B1); PG8_BAR; PG8_SCHED;
            PG8_LDA(At, 0, 1); PG8_STAGE(PG8_SB(0, 0), b2, voffB); PG8_STAGE(PG8_SB(0, 1), b2 + hstepB, voffB); PG8_STAGE(PG8_SA(0, 0), a2, voffA);
            PG8_WAIT_V(8); PG8_WAIT_L(0); PG8_BAR; PG8_MMA(1, 0, At, B0); PG8_MMA(1, 1, At, B1); PG8_BAR; PG8_SCHED;
            PG8_LDB(B0, 1, 0); PG8_LDB(B1, 1, 1); PG8_SCHED; PG8_LDA(At, 1, 0); PG8_STAGE(PG8_SA(0, 1), a2 + hstepA, voffA);
            PG8_WAIT_V(8); PG8_WAIT_L(0); PG8_BAR; PG8_MMA(0, 0, At, B0); PG8_MMA(0, 1, At, B1); PG8_BAR; PG8_SCHED;
            PG8_LDA(At, 1, 1); PG8_STAGE(PG8_SB(1, 0), b3, voffB); PG8_STAGE(PG8_SB(1, 1), b3 + hstepB, voffB); PG8_STAGE(PG8_SA(1, 0), a3, voffA);
            PG8_WAIT_V(8); PG8_WAIT_L(0); PG8_BAR; PG8_MMA(1, 0, At, B0); PG8_MMA(1, 1, At, B1); PG8_BAR; PG8_SCHED;
        }
        if (wr == 0) PG8_BAR;
        const bool keep = E(acc, cur, wr, wc, fr, fq);
        if (!has_next) break;
        if (!keep) {
#pragma unroll
            for (int a = 0; a < 2; ++a)
#pragma unroll
                for (int b = 0; b < 2; ++b)
#pragma unroll
                    for (int m = 0; m < 4; ++m)
#pragma unroll
                        for (int n = 0; n < 2; ++n) acc[a][b][m][n] = (f32x4){0.f, 0.f, 0.f, 0.f};
        }
        cur = nxt; cA = nA; cB = nB; nt = cur.nt; ++ui;
        if (wr == 1) PG8_BAR;
    }
    PG8_WAIT_V(0);
    PG8_BAR;
#undef PG8_SA
#undef PG8_SB
#undef PG8_STAGE
#undef PG8_LDA
#undef PG8_LDB
#undef PG8_MMA
#undef PG8_WAIT_V
#undef PG8_WAIT_L
#undef PG8_BAR
#undef PG8_SCHED
}

struct SchedPlain {
    TileOrder to; int G, c, nt; const char* A0; const char* B0; size_t sA, sB;
    __device__ __forceinline__ bool next(int i, Unit& u) const {
        const int L = i * G + c; if (L >= to.nwg) return false;
        int pm, pn; to.map(L, pm, pn); u.A = A0 + (size_t)pm * sA; u.B = B0 + (size_t)pn * sB; u.nt = nt; u.pm = pm; u.pn = pn; u.kind = 0; return true;
    }
};
struct SchedGemm1 {
    TileOrder to; int G, c; const char *XN, *WIN, *MEMN, *WKV;
    __device__ __forceinline__ bool next(int i, Unit& u) const {
        const int L = i * G + c; u.nt = 64;
        if (L < to.nwg) { int pm, pn; to.map(L, pm, pn); u.A = XN + (size_t)pm * 256 * 4096 * 2; u.B = WIN + (size_t)pn * 256 * 4096 * 2; u.pm = pm; u.pn = pn; u.kind = 0; return true; }
        const int e = L - to.nwg; if (e >= 8) return false;
        if (e < 4) { u.A = MEMN; u.B = WKV + (size_t)e * 256 * 4096 * 2; u.pm = 0; u.pn = e; u.kind = 1; }
        else { u.A = WKV + (size_t)(1024 + 256 * (e - 4)) * 4096 * 2; u.B = MEMN; u.pm = e - 4; u.pn = 0; u.kind = 2; }
        return true;
    }
};
struct SchedHeads {
    int G, c, nunits, nt; const char* A0; const char* B0; size_t sA, hA, hB;
    __device__ __forceinline__ bool next(int i, Unit& u) const {
        const int L = i * G + c; if (L >= nunits) return false;
        const int pm = L & 31, h = L >> 5; u.A = A0 + (size_t)pm * sA + (size_t)h * hA; u.B = B0 + (size_t)h * hB; u.nt = nt; u.pm = pm; u.pn = 0; u.kind = h; return true;
    }
};
struct SchedMerge {
    TileOrder to; int G, c; const char* OC; const char* WC;
    __device__ __forceinline__ bool next(int i, Unit& u) const {
        const int ti = i / 3, b = i - 3 * ti; const int L = ti * G + c; if (L >= to.nwg) return false;
        int pm, pn; to.map(L, pm, pn); const int koff = b * 1536;
        u.A = OC + ((size_t)pm * 256 * 4096 + koff) * 2; u.B = WC + ((size_t)pn * 256 * 4096 + koff) * 2; u.nt = (b < 2) ? 24 : 16; u.pm = pm; u.pn = pn; u.kind = b; return true;
    }
};

struct EpiGemm1 {
    static constexpr bool PERM = true;
    bf16_t *P, *MK, *MVT;
    __device__ __forceinline__ bool operator()(f32x4 (&acc)[2][2][4][2], const Unit& u, int wr, int wc, int fr, int fq) const {
        bf16_t* base; int ldc;
        if (u.kind == 0) { base = P + (size_t)u.pm * 256 * NINP + u.pn * 256; ldc = NINP; }
        else if (u.kind == 1) { base = MK + u.pn * 256; ldc = 1024; }
        else { base = MVT + (size_t)u.pm * 256 * 1024; ldc = 1024; }
        base += (size_t)(wr * 64 + fr) * ldc + wc * 32 + 8 * fq;
#pragma unroll
        for (int ai = 0; ai < 2; ++ai)
#pragma unroll
            for (int m = 0; m < 4; ++m) { bf16_t* rowp = base + (size_t)(ai * HALF + m * 16) * ldc;
#pragma unroll
                for (int bj = 0; bj < 2; ++bj) { const f32x4 v0 = acc[ai][bj][m][0], v1 = acc[ai][bj][m][1];
                    u32x4 w; w.x = cvt_pk_bf16(v0[0], v0[1]); w.y = cvt_pk_bf16(v0[2], v0[3]); w.z = cvt_pk_bf16(v1[0], v1[1]); w.w = cvt_pk_bf16(v1[2], v1[3]);
                    *(u32x4*)(rowp + bj * HALF) = w; } }
        return false;
    }
};
struct EpiBf16 {
    static constexpr bool PERM = true;
    bf16_t* O; int ldc, coff, kstride;
    __device__ __forceinline__ bool operator()(f32x4 (&acc)[2][2][4][2], const Unit& u, int wr, int wc, int fr, int fq) const {
        bf16_t* base = O + (size_t)(u.pm * 256 + wr * 64 + fr) * ldc + coff + u.kind * kstride + u.pn * 256 + wc * 32 + 8 * fq;
#pragma unroll
        for (int ai = 0; ai < 2; ++ai)
#pragma unroll
            for (int m = 0; m < 4; ++m) { bf16_t* rowp = base + (size_t)(ai * HALF + m * 16) * ldc;
#pragma unroll
                for (int bj = 0; bj < 2; ++bj) { const f32x4 v0 = acc[ai][bj][m][0], v1 = acc[ai][bj][m][1];
                    u32x4 w; w.x = cvt_pk_bf16(v0[0], v0[1]); w.y = cvt_pk_bf16(v0[2], v0[3]); w.z = cvt_pk_bf16(v1[0], v1[1]); w.w = cvt_pk_bf16(v1[2], v1[3]);
                    *(u32x4*)(rowp + bj * HALF) = w; } }
        return false;
    }
};
struct EpiScoreF32 {
    static constexpr bool PERM = false;
    float* S;
    __device__ __forceinline__ bool operator()(f32x4 (&acc)[2][2][4][2], const Unit& u, int wr, int wc, int fr, int fq) const {
        float* base = S + (size_t)(u.pm * 256 + wr * 64 + fr) * 1024 + u.kind * 256 + wc * 32 + 4 * fq;
#pragma unroll
        for (int ai = 0; ai < 2; ++ai)
#pragma unroll
            for (int m = 0; m < 4; ++m) { float* rowp = base + (size_t)(ai * HALF + m * 16) * 1024;
#pragma unroll
                for (int bj = 0; bj < 2; ++bj)
#pragma unroll
                    for (int n = 0; n < 2; ++n) *(f32x4*)(rowp + bj * HALF + n * 16) = acc[ai][bj][m][n]; }
        return false;
    }
};
struct EpiLoraWA {
    static constexpr bool PERM = false;
    const float *w0, *a0; float *RW; bf16_t *RA;
    __device__ __forceinline__ bool operator()(f32x4 (&acc)[2][2][4][2], const Unit& u, int wr, int wc, int fr, int fq) const {
        const bool isw = u.pn < 6; const int cb = (isw ? u.pn : u.pn - 6) * 256 + wc * 32 + 4 * fq;
        const float* bias = (isw ? w0 : a0) + cb; const size_t eb = (size_t)(u.pm * 256 + wr * 64 + fr) * 1536 + cb;
        f32x4 bv[2][2];
#pragma unroll
        for (int bj = 0; bj < 2; ++bj)
#pragma unroll
            for (int n = 0; n < 2; ++n) bv[bj][n] = *(const f32x4*)(bias + bj * HALF + n * 16);
#pragma unroll
        for (int ai = 0; ai < 2; ++ai)
#pragma unroll
            for (int m = 0; m < 4; ++m) { const size_t ro = eb + (size_t)(ai * HALF + m * 16) * 1536;
#pragma unroll
                for (int bj = 0; bj < 2; ++bj)
#pragma unroll
                    for (int n = 0; n < 2; ++n) { f32x4 x = acc[ai][bj][m][n] + bv[bj][n]; f32x4 o;
#pragma unroll
                        for (int j = 0; j < 4; ++j) { const float sg = sigmoidf_(x[j]); o[j] = isw ? fexp(-0.6065306597126334f * sg) : sg; }
                        if (isw) *(f32x4*)(RW + ro + bj * HALF + n * 16) = o;
                        else { v2u ob; ob[0] = cvt_pk_bf16(o[0], o[1]); ob[1] = cvt_pk_bf16(o[2], o[3]); *(v2u*)(RA + ro + bj * HALF + n * 16) = ob; } } }
        return false;
    }
};
struct EpiMerge {
    static constexpr bool PERM = true;
    const bf16_t* P; bf16_t* MG;
    __device__ __forceinline__ bool operator()(f32x4 (&acc)[2][2][4][2], const Unit& u, int wr, int wc, int fr, int fq) const {
        const int b = u.kind; const int row0 = u.pm * 256 + wr * 64 + fr, col0 = u.pn * 256 + wc * 32 + 8 * fq;
        const bf16_t* gbase = P + (size_t)row0 * NINP + PG + 4096 * b + col0;
#pragma unroll
        for (int ai = 0; ai < 2; ++ai) {
            u32x4 g0v[4][2], g1v[4][2];
#pragma unroll
            for (int m = 0; m < 4; ++m)
#pragma unroll
                for (int bj = 0; bj < 2; ++bj) { const bf16_t* gp = gbase + (size_t)(ai * HALF + m * 16) * NINP + bj * HALF; g0v[m][bj] = *(const u32x4*)gp; g1v[m][bj] = (b < 2) ? *(const u32x4*)(gp + 4096) : g0v[m][bj]; }
#pragma unroll
            for (int m = 0; m < 4; ++m) { const size_t row = (size_t)(row0 + ai * HALF + m * 16);
#pragma unroll
                for (int bj = 0; bj < 2; ++bj) { const u32x4 g0 = g0v[m][bj];
                    float e0[8]; const unsigned gw0[4] = {g0.x, g0.y, g0.z, g0.w};
#pragma unroll
                    for (int j = 0; j < 4; ++j) { e0[2 * j] = 1.0f + fexp(-bflo(gw0[j])); e0[2 * j + 1] = 1.0f + fexp(-bfhi(gw0[j])); }
                    if (b < 2) { const u32x4 g1 = g1v[m][bj]; const unsigned gw1[4] = {g1.x, g1.y, g1.z, g1.w};
#pragma unroll
                        for (int j = 0; j < 4; ++j) { const float r0 = (1.0f + fexp(-bflo(gw1[j]))) * frcp(e0[2 * j]), r1 = (1.0f + fexp(-bfhi(gw1[j]))) * frcp(e0[2 * j + 1]);
                            acc[ai][bj][m][j >> 1][(2 * j) & 3] *= r0; acc[ai][bj][m][j >> 1][(2 * j + 1) & 3] *= r1; }
                    } else { float v[8];
#pragma unroll
                        for (int j = 0; j < 8; ++j) v[j] = acc[ai][bj][m][j >> 2][j & 3] * frcp(e0[j]);
                        u32x4 w; w.x = cvt_pk_bf16(v[0], v[1]); w.y = cvt_pk_bf16(v[2], v[3]); w.z = cvt_pk_bf16(v[4], v[5]); w.w = cvt_pk_bf16(v[6], v[7]);
                        *(u32x4*)(MG + row * 4096 + col0 + bj * HALF) = w; } } }
            asm volatile("" ::: "memory");
        }
        return b < 2;
    }
};
struct EpiResF32 {
    static constexpr bool PERM = false;
    const float* res; float* out;
    __device__ __forceinline__ bool operator()(f32x4 (&acc)[2][2][4][2], const Unit& u, int wr, int wc, int fr, int fq) const {
        const size_t off0 = (size_t)(u.pm * 256 + wr * 64 + fr) * 4096 + u.pn * 256 + wc * 32 + 4 * fq;
#pragma unroll
        for (int ai = 0; ai < 2; ++ai)
#pragma unroll
            for (int mp = 0; mp < 2; ++mp) { f32x4 rv[2][2][2];
#pragma unroll
                for (int mm = 0; mm < 2; ++mm)
#pragma unroll
                    for (int bj = 0; bj < 2; ++bj)
#pragma unroll
                        for (int n = 0; n < 2; ++n) rv[mm][bj][n] = *(const f32x4*)(res + off0 + (size_t)(ai * HALF + (2 * mp + mm) * 16) * 4096 + bj * HALF + n * 16);
#pragma unroll
                for (int mm = 0; mm < 2; ++mm) { const size_t off = off0 + (size_t)(ai * HALF + (2 * mp + mm) * 16) * 4096;
#pragma unroll
                    for (int bj = 0; bj < 2; ++bj)
#pragma unroll
                        for (int n = 0; n < 2; ++n) *(f32x4*)(out + off + bj * HALF + n * 16) = rv[mm][bj][n] + acc[ai][bj][2 * mp + mm][n]; }
                asm volatile("" ::: "memory"); }
        return false;
    }
};
struct EpiResToBf16 {
    static constexpr bool PERM = true;
    const float* res; bf16_t* out;
    __device__ __forceinline__ bool operator()(f32x4 (&acc)[2][2][4][2], const Unit& u, int wr, int wc, int fr, int fq) const {
        const size_t off0 = (size_t)(u.pm * 256 + wr * 64 + fr) * 4096 + u.pn * 256 + wc * 32 + 8 * fq;
#pragma unroll
        for (int ai = 0; ai < 2; ++ai)
#pragma unroll
            for (int mp = 0; mp < 2; ++mp) { f32x4 rv[2][2][2];
#pragma unroll
                for (int mm = 0; mm < 2; ++mm)
#pragma unroll
                    for (int bj = 0; bj < 2; ++bj)
#pragma unroll
                        for (int n = 0; n < 2; ++n) rv[mm][bj][n] = *(const f32x4*)(res + off0 + (size_t)(ai * HALF + (2 * mp + mm) * 16) * 4096 + bj * HALF + n * 4);
#pragma unroll
                for (int mm = 0; mm < 2; ++mm) { const size_t off = off0 + (size_t)(ai * HALF + (2 * mp + mm) * 16) * 4096;
#pragma unroll
                    for (int bj = 0; bj < 2; ++bj) { const f32x4 v0 = rv[mm][bj][0] + acc[ai][bj][2 * mp + mm][0], v1 = rv[mm][bj][1] + acc[ai][bj][2 * mp + mm][1];
                        u32x4 w; w.x = cvt_pk_bf16(v0[0], v0[1]); w.y = cvt_pk_bf16(v0[2], v0[3]); w.z = cvt_pk_bf16(v1[0], v1[1]); w.w = cvt_pk_bf16(v1[2], v1[3]);
                        *(u32x4*)(out + off + bj * HALF) = w; } }
                asm volatile("" ::: "memory"); }
        return false;
    }
};
struct EpiResFromBf16 {
    static constexpr bool PERM = true;
    const bf16_t* res; float* out;
    __device__ __forceinline__ bool operator()(f32x4 (&acc)[2][2][4][2], const Unit& u, int wr, int wc, int fr, int fq) const {
        const size_t off0 = (size_t)(u.pm * 256 + wr * 64 + fr) * 4096 + u.pn * 256 + wc * 32 + 8 * fq;
#pragma unroll
        for (int ai = 0; ai < 2; ++ai)
#pragma unroll
            for (int mp = 0; mp < 2; ++mp) { u32x4 rv[2][2];
#pragma unroll
                for (int mm = 0; mm < 2; ++mm)
#pragma unroll
                    for (int bj = 0; bj < 2; ++bj) rv[mm][bj] = *(const u32x4*)(res + off0 + (size_t)(ai * HALF + (2 * mp + mm) * 16) * 4096 + bj * HALF);
#pragma unroll
                for (int mm = 0; mm < 2; ++mm) { const size_t off = off0 + (size_t)(ai * HALF + (2 * mp + mm) * 16) * 4096;
#pragma unroll
                    for (int bj = 0; bj < 2; ++bj) { const u32x4 r = rv[mm][bj];
                        const f32x4 r0 = {__builtin_bit_cast(float, r.x << 16), __builtin_bit_cast(float, r.x & 0xffff0000u), __builtin_bit_cast(float, r.y << 16), __builtin_bit_cast(float, r.y & 0xffff0000u)};
                        const f32x4 r1 = {__builtin_bit_cast(float, r.z << 16), __builtin_bit_cast(float, r.z & 0xffff0000u), __builtin_bit_cast(float, r.w << 16), __builtin_bit_cast(float, r.w & 0xffff0000u)};
                        *(f32x4*)(out + off + bj * HALF) = r0 + acc[ai][bj][2 * mp + mm][0]; *(f32x4*)(out + off + bj * HALF + 4) = r1 + acc[ai][bj][2 * mp + mm][1]; } }
                asm volatile("" ::: "memory"); }
        return false;
    }
};
struct EpiSwiGLU {
    static constexpr bool PERM = true;
    bf16_t* ACT;
    __device__ __forceinline__ bool operator()(f32x4 (&acc)[2][2][4][2], const Unit& u, int wr, int wc, int fr, int fq) const {
        bf16_t* base = ACT + (size_t)(u.pm * 256 + wr * 64 + fr) * DFF + u.pn * 128 + wc * 32 + 8 * fq;
#pragma unroll
        for (int ai = 0; ai < 2; ++ai)
#pragma unroll
            for (int m = 0; m < 4; ++m) { float v[8];
#pragma unroll
                for (int j = 0; j < 8; ++j) { const float g = acc[ai][0][m][j >> 2][j & 3], up = acc[ai][1][m][j >> 2][j & 3]; v[j] = g * sigmoidf_(g) * up; }
                u32x4 w; w.x = cvt_pk_bf16(v[0], v[1]); w.y = cvt_pk_bf16(v[2], v[3]); w.z = cvt_pk_bf16(v[4], v[5]); w.w = cvt_pk_bf16(v[6], v[7]);
                *(u32x4*)(base + (size_t)(ai * HALF + m * 16) * DFF) = w; }
        return false;
    }
};
}

#define XB_TMO      128
#define XB_XCNT(j)  (256  + 64 * (j))
#define XB_XSUB(j)  (1280 + 64 * (j))
#define XB_XGEN(j)  (2304 + 64 * (j))
#define XB_TOP      3328
#define XB_TOPGEN   3392
#define XCD_BAR_WORDS 3456
#define XB_SPIN_CAP (1u << 18)
__device__ __forceinline__ unsigned xb_ld(unsigned* p)              { return __hip_atomic_load(p, __ATOMIC_RELAXED, __HIP_MEMORY_SCOPE_AGENT); }
__device__ __forceinline__ unsigned xb_add(unsigned* p, unsigned v) { return __hip_atomic_fetch_add(p, v, __ATOMIC_RELAXED, __HIP_MEMORY_SCOPE_AGENT); }
__device__ __forceinline__ unsigned xb_xcc_id() { return (unsigned)__builtin_amdgcn_s_getreg((3 << 11) | 20) & 0xFu; }
#define XB_SPIN(cond, bar) do { unsigned _sp = 0; while (cond) { __builtin_amdgcn_s_sleep(1); \
    if ((++_sp & 255u) == 0u) { if (xb_ld(&(bar)[XB_TMO])) break; if (_sp > XB_SPIN_CAP) { atomicAdd(&(bar)[XB_TMO], 1u); break; } } } } while (0)
struct XcdBarrier { unsigned* bar; unsigned x; volatile LAS unsigned* st; };
__device__ __forceinline__ XcdBarrier xcd_barrier_post(unsigned* bar, volatile LAS unsigned* st) {
    XcdBarrier b; b.bar = bar; b.x = xb_xcc_id(); b.st = st;
    if (threadIdx.x == 0) (void)xb_add(&bar[XB_XCNT(b.x)], 1u);
    return b;
}
__device__ __forceinline__ void xcd_barrier_complete(unsigned* bar, unsigned x, unsigned& nloc, unsigned& nx) {
    const unsigned G = gridDim.x * gridDim.y * gridDim.z;
    unsigned sum, cnt, mine, sp = 0u;
    for (;;) {
        sum = 0u; cnt = 0u; mine = 0u;
#pragma unroll
        for (unsigned j = 0; j < 16; ++j) { const unsigned c = xb_ld(&bar[XB_XCNT(j)]); sum += c; cnt += (c > 0u) ? 1u : 0u; mine = (j == x) ? c : mine; }
        if (sum == G) break;
        __builtin_amdgcn_s_sleep(1);
        if ((++sp & 255u) == 0u) { if (xb_ld(&bar[XB_TMO])) break; if (sp > XB_SPIN_CAP) { atomicAdd(&bar[XB_TMO], 1u); break; } }
    }
    nloc = mine > 0u ? mine : 1u; nx = cnt > 0u ? cnt : 1u;
}
__device__ __forceinline__ void xcd_barrier(const XcdBarrier& b) {
    asm volatile("s_waitcnt vmcnt(0)" ::: "memory");
    __syncthreads();
    if (threadIdx.x == 0) {
        unsigned* bar = b.bar;
        __builtin_amdgcn_s_waitcnt(0);
        unsigned nloc = b.st[0], nx = b.st[1];
        if (nloc == 0u) { xcd_barrier_complete(bar, b.x, nloc, nx); b.st[0] = nloc; b.st[1] = nx; }
        const unsigned old = xb_add(&bar[XB_XSUB(b.x)], 1u);
        const unsigned gen = old / nloc;
        if (old + 1u == (gen + 1u) * nloc) {
            __builtin_amdgcn_fence(__ATOMIC_RELEASE, "agent");
            asm volatile("s_waitcnt vmcnt(0)" ::: "memory");
            const unsigned og = xb_add(&bar[XB_TOP], 1u);
            const unsigned tg = og / nx;
            if (og + 1u == (tg + 1u) * nx) xb_add(&bar[XB_TOPGEN], 1u);
            else XB_SPIN(xb_ld(&bar[XB_TOPGEN]) == tg, bar);
            __builtin_amdgcn_fence(__ATOMIC_ACQUIRE, "agent");
            xb_add(&bar[XB_XGEN(b.x)], 1u);
            asm volatile("s_waitcnt vmcnt(0)" ::: "memory");
        } else {
            XB_SPIN(xb_ld(&bar[XB_XGEN(b.x)]) == gen, bar);
            __builtin_amdgcn_fence(__ATOMIC_ACQUIRE, "agent");
            asm volatile("s_waitcnt vmcnt(0)" ::: "memory");
        }
    }
    __syncthreads();
}

struct Args {
    const float* in[29]; float* out; unsigned char* ws; int ph_lo, ph_hi;
};
enum { I_X = 0, I_MEM, I_ATTN_G, I_MEM_G, I_WIN, I_SBQG, I_SBKG, I_RWMIX, I_RWW0, I_RWWUP, I_RWA0, I_RWAUP, I_RWGUP, I_RWKK, I_RWKA, I_RWRK, I_RWLNG, I_RWLNB,
       I_MEMWKV, I_MEMQG, I_MEMKG, I_WSBO, I_WRWO, I_WMEMO, I_WOUT, I_FFNG, I_WGATE, I_WUP, I_WDOWN };

#define LDS_WAIT() asm volatile("s_waitcnt lgkmcnt(0)" ::: "memory")

__device__ __forceinline__ int rowmap(int mode, int n, int roff) {
    if (mode == 1) return n + (n >= 9952 ? 32 : 0);
    if (mode == 2) return (n >> 7) * 256 + (n & 127);
    if (mode == 3) return (n >> 7) * 256 + 128 + (n & 127);
    return n + roff;
}
__device__ __forceinline__ void transpose_item(const float* W, int N, bf16* WT, int ldk, int koff, int mode, int roff, LAS float* scr, int item, int lane) {
    const int nblk = N / 32, kb = item / nblk, nb = item - kb * nblk, k0 = 64 * kb, n0 = 32 * nb;
    { const int rr = lane >> 3, c4 = (lane & 7) * 4; f32x4 wv[8];
#pragma unroll
      for (int i = 0; i < 8; ++i) wv[i] = *(const GAS f32x4*)(W + (size_t)(k0 + 8 * i + rr) * N + n0 + c4);
#pragma unroll
      for (int i = 0; i < 8; ++i) { LAS float* d = scr + (8 * i + rr) * 33 + c4; d[0] = wv[i].x; d[1] = wv[i].y; d[2] = wv[i].z; d[3] = wv[i].w; } }
    LDS_WAIT(); asm volatile("" ::: "memory");
    const int c = lane & 7;
#pragma unroll
    for (int j = 0; j < 4; ++j) { const int n = (lane >> 3) + 8 * j; const LAS float* s = scr + (8 * c) * 33 + n;
        v4u o; o.x = pk2(s[0 * 33], s[1 * 33]); o.y = pk2(s[2 * 33], s[3 * 33]); o.z = pk2(s[4 * 33], s[5 * 33]); o.w = pk2(s[6 * 33], s[7 * 33]);
        *(GAS v4u*)(WT + (size_t)rowmap(mode, n0 + n, roff) * ldk + koff + k0 + 8 * c) = o; }
    LDS_WAIT(); asm volatile("" ::: "memory");
}
__device__ __forceinline__ void rms_rows4096(const float* x, const float* g, bf16* out, int first, int stride, int nrows, int lane) {
    if (first >= nrows) return;
    f32x4 v[16], nv[16];
    { const GAS f32x4* xr = (const GAS f32x4*)(x + (size_t)first * 4096) + lane;
#pragma unroll
      for (int j = 0; j < 16; ++j) v[j] = xr[64 * j]; }
    const GAS f32x4* gr = (const GAS f32x4*)g + lane;
    for (int m = first; m < nrows; m += stride) {
        const bool more = m + stride < nrows;
        if (more) { const GAS f32x4* xr = (const GAS f32x4*)(x + (size_t)(m + stride) * 4096) + lane;
#pragma unroll
            for (int j = 0; j < 16; ++j) nv[j] = xr[64 * j]; }
        float s = 0.f;
#pragma unroll
        for (int j = 0; j < 16; ++j) s += (v[j].x * v[j].x + v[j].y * v[j].y) + (v[j].z * v[j].z + v[j].w * v[j].w);
        const float rstd = 1.0f / sqrtf(wave_sum(s) * (1.f / 4096.f) + RMS_EPS);
        GAS v2u* o8 = (GAS v2u*)(out + (size_t)m * 4096) + lane;
#pragma unroll
        for (int j = 0; j < 16; ++j) { const f32x4 gv = gr[64 * j]; v2u o; o.x = pk2(v[j].x * rstd * gv.x, v[j].y * rstd * gv.y); o.y = pk2(v[j].z * rstd * gv.z, v[j].w * rstd * gv.w); o8[64 * j] = o; }
        if (more) {
#pragma unroll
            for (int j = 0; j < 16; ++j) v[j] = nv[j]; }
    }
}
__device__ __forceinline__ void rms_rows4096_b(const bf16* x, const float* g, bf16* out, int first, int stride, int nrows, int lane) {
    if (first >= nrows) return;
    v4u v[8], nv[8];
    { const GAS v4u* xr = (const GAS v4u*)(x + (size_t)first * 4096) + lane;
#pragma unroll
      for (int j = 0; j < 8; ++j) v[j] = xr[64 * j]; }
    const GAS f32x4* gr = (const GAS f32x4*)g + 2 * lane;
    for (int m = first; m < nrows; m += stride) {
        const bool more = m + stride < nrows;
        if (more) { const GAS v4u* xr = (const GAS v4u*)(x + (size_t)(m + stride) * 4096) + lane;
#pragma unroll
            for (int j = 0; j < 8; ++j) nv[j] = xr[64 * j]; }
        float s = 0.f;
#pragma unroll
        for (int j = 0; j < 8; ++j) { const float a0 = bflo(v[j].x), a1 = bfhi(v[j].x), a2 = bflo(v[j].y), a3 = bfhi(v[j].y), a4 = bflo(v[j].z), a5 = bfhi(v[j].z), a6 = bflo(v[j].w), a7 = bfhi(v[j].w);
            s += ((a0 * a0 + a1 * a1) + (a2 * a2 + a3 * a3)) + ((a4 * a4 + a5 * a5) + (a6 * a6 + a7 * a7)); }
        const float rstd = 1.0f / sqrtf(wave_sum(s) * (1.f / 4096.f) + RMS_EPS);
        GAS v4u* o16 = (GAS v4u*)(out + (size_t)m * 4096) + lane;
#pragma unroll
        for (int j = 0; j < 8; ++j) { const f32x4 g0 = gr[128 * j], g1 = gr[128 * j + 1]; v4u o;
            o.x = pk2(bflo(v[j].x) * rstd * g0.x, bfhi(v[j].x) * rstd * g0.y); o.y = pk2(bflo(v[j].y) * rstd * g0.z, bfhi(v[j].y) * rstd * g0.w);
            o.z = pk2(bflo(v[j].z) * rstd * g1.x, bfhi(v[j].z) * rstd * g1.y); o.w = pk2(bflo(v[j].w) * rstd * g1.z, bfhi(v[j].w) * rstd * g1.w); o16[64 * j] = o; }
        if (more) {
#pragma unroll
            for (int j = 0; j < 8; ++j) v[j] = nv[j]; }
    }
}
#define QB 16
#define QUEUE_PULL(headword, nitems, BODY) do { for (;;) { int it_ = 0; if ((threadIdx.x & 63) == 0) it_ = (int)__hip_atomic_fetch_add((unsigned*)(headword), (unsigned)QB, __ATOMIC_RELAXED, __HIP_MEMORY_SCOPE_AGENT); \
        it_ = __builtin_amdgcn_readfirstlane(it_); if (it_ >= (nitems)) break; const int qe_ = (it_ + QB < (nitems)) ? it_ + QB : (nitems); \
        for (int qi = it_; qi < qe_; ++qi) { BODY; } } } while (0)
constexpr int NPHASES = 12;
__global__ void __launch_bounds__(NWAVES * 64, 2) hybrid_fwd(Args args) {
    extern __shared__ __attribute__((aligned(16))) unsigned char lds_raw[];
    LAS unsigned char* lds = (LAS unsigned char*)lds_raw;
    volatile LAS unsigned* MISC = (volatile LAS unsigned*)(lds + MISC_OFF);
    const int G = gridDim.x, bx = blockIdx.x, NGW = G * NWAVES;
    unsigned char* ws = args.ws;
    gu32* ctl = (gu32*)(ws + WS_CTL);
    for (int u = threadIdx.x; u < (LDS_BYTES - LDSCTL_OFF) / 4; u += NWAVES * 64) ((LAS unsigned*)(lds + LDSCTL_OFF))[u] = 0u;
#define PHASE_IDS() int tid = threadIdx.x; asm volatile("" : "+v"(tid)); const int lane = tid & 63, wave = __builtin_amdgcn_readfirstlane(tid >> 6), gw = bx * NWAVES + wave; (void)lane; (void)gw
    __syncthreads();
#if MK_PER_PHASE
    XcdBarrier bar; bar.bar = (unsigned*)(ctl + CW_BAR); bar.x = 0; bar.st = nullptr;
#define GRID_BAR() do { } while (0)
#else
    XcdBarrier bar = xcd_barrier_post((unsigned*)(ctl + CW_BAR), MISC + 8);
#define GRID_BAR() xcd_barrier(bar)
#endif
    const int lo = args.ph_lo, hi = args.ph_hi;
#define IN(k) (lo <= (k) && (k) < hi)
#define BOTH(k) (IN(k) && IN((k) + 1))

    bf16* WIN_T = (bf16*)(ws + WS_WIN_T); bf16* WCAT_T = (bf16*)(ws + WS_WCAT_T); bf16* WOUT_T = (bf16*)(ws + WS_WOUT_T); bf16* WKV_T = (bf16*)(ws + WS_WKV_T);
    bf16* LBWA = (bf16*)(ws + WS_LBWA); bf16* LBG = (bf16*)(ws + WS_LBG); bf16* XN = (bf16*)(ws + WS_XN); bf16* MEMN = (bf16*)(ws + WS_MEMN); bf16* P = (bf16*)(ws + WS_P);
    float* R_R = (float*)(ws + WS_R); float* R_W = (float*)(ws + WS_R + RSZ); float* R_KP = (float*)(ws + WS_R + 2 * RSZ); float* R_V = (float*)(ws + WS_R + 3 * RSZ);
    float* R_KK = (float*)(ws + WS_R + 4 * RSZ); bf16* R_NB = (bf16*)(ws + WS_R + 5 * RSZ);
    bf16* GB = (bf16*)(ws + WS_G); bf16* Y = (bf16*)(ws + WS_Y);     bf16* OCAT = (bf16*)(ws + WS_OCAT);
    bf16* QN = (bf16*)(ws + WS_QN); bf16* KN = (bf16*)(ws + WS_KN); bf16* VT = (bf16*)(ws + WS_VT); bf16* MQN = (bf16*)(ws + WS_MQN);
    bf16* MKRAW = (bf16*)(ws + WS_MKRAW); bf16* MKN = (bf16*)(ws + WS_MKN); bf16* MVT = (bf16*)(ws + WS_MVT);
    float* SM = (float*)(ws + WS_SM); bf16* PM = (bf16*)(ws + WS_PM); bf16* LA1 = (bf16*)(ws + WS_LA1); bf16* LA2 = (bf16*)(ws + WS_LA2);
    bf16* S0ALL = (bf16*)R_R;     float* BONUS = (float*)(ws + WS_BONUS);
    bf16* PHIT = (bf16*)(ws + WS_PHIT);   float* PCT = (float*)(ws + WS_PCT); bf16* SLOCT = (bf16*)(ws + WS_SLOCT);
    bf16* WGU_T = (bf16*)(ws + WS_WGU_T); bf16* WD_T = (bf16*)(ws + WS_WD_T); bf16* MERGED = (bf16*)(ws + WS_MERGED); bf16* H1 = (bf16*)(ws + WS_H1);     bf16* ACT = (bf16*)(ws + WS_ACT);

#define Q1_ITEMS (24 * 128 + 24 * 128 + 16 * 128 + 64 * 128 + 172 * 128)
#define Q1_BODY { int r = qi; LAS float* scr = (LAS float*)(lds + wave * 16384); \
        if (r < 24 * 128) transpose_item(args.in[I_WSBO], 4096, WCAT_T, 4096, 0, 0, 0, scr, r, lane); \
        else if ((r -= 24 * 128) < 24 * 128) transpose_item(args.in[I_WRWO], 4096, WCAT_T, 4096, 1536, 0, 0, scr, r, lane); \
        else if ((r -= 24 * 128) < 16 * 128) transpose_item(args.in[I_WMEMO], 4096, WCAT_T, 4096, 3072, 0, 0, scr, r, lane); \
        else if ((r -= 16 * 128) < 64 * 128) transpose_item(args.in[I_WOUT], 4096, WOUT_T, 4096, 0, 0, 0, scr, r, lane); \
        else { r -= 64 * 128; transpose_item(args.in[I_WDOWN], 4096, WD_T, DFF, 0, 0, 0, scr, r, lane); } }
#define Q2_ITEMS (2 * 64 * 344)
#define Q2_BODY { int r = qi; LAS float* scr2 = (LAS float*)(lds + wave * 16384); \
        if (r < 64 * 344) transpose_item(args.in[I_WGATE], DFF, WGU_T, 4096, 0, 2, 0, scr2, r, lane); \
        else transpose_item(args.in[I_WUP], DFF, WGU_T, 4096, 0, 3, 0, scr2, r - 64 * 344, lane); }
    if (IN(0)) {
        PHASE_IDS();
        LAS float* scr = (LAS float*)(lds + wave * 16384);
        constexpr int I_IN = 64 * 727, I_KV = 64 * 64;
        constexpr int NITEMS = I_IN + I_KV;
        for (int it = gw; it < NITEMS; it += NGW) {
            int r = it;
            if (r < I_IN) { transpose_item(args.in[I_WIN], NIN_ORIG, WIN_T, 4096, 0, 1, 0, scr, r, lane); continue; } r -= I_IN;
            transpose_item(args.in[I_MEMWKV], 2048, WKV_T, 4096, 0, 0, 0, scr, r, lane);
        }
        for (int i = bx * 512 + tid; i < 32 * 4096 / 8; i += G * 512) ((GAS v4u*)(WIN_T + (size_t)9952 * 4096))[i] = (v4u){0u, 0u, 0u, 0u};
        for (int i = bx * 512 + tid; i < 3072 * 256; i += G * 512) { const int n = i >> 8, k = i & 255; float v = 0.f;
            if (n < 1536) { if (k < 128) v = args.in[I_RWWUP][(size_t)k * 1536 + n]; } else { if (k >= 128) v = args.in[I_RWAUP][(size_t)(k - 128) * 1536 + (n - 1536)]; }
            LBWA[i] = (bf16)f2bf(v); }
        for (int i = bx * 512 + tid; i < 1536 * 512; i += G * 512) { const int n = i >> 9, k = i & 511; const float v = (k < 480) ? args.in[I_RWGUP][(size_t)k * 1536 + n] : 0.f; LBG[i] = (bf16)f2bf(v); }
        rms_rows4096(args.in[I_X], args.in[I_ATTN_G], XN, gw, NGW, T, lane);
        rms_rows4096(args.in[I_MEM], args.in[I_MEM_G], MEMN, gw, NGW, NMEM, lane);
        if (BOTH(0)) GRID_BAR();
    }

    if (IN(1)) {
        PHASE_IDS();
        pg8::SchedGemm1 S; S.to.init(32, 91); S.G = G; S.c = bx; S.XN = (const char*)XN; S.WIN = (const char*)WIN_T; S.MEMN = (const char*)MEMN; S.WKV = (const char*)WKV_T;
        pg8::EpiGemm1 E{P, MKRAW, MVT};
        pg8::gemm_phase(lds, 4096, 4096, S, E);
        QUEUE_PULL(ctl + CW_Q1, Q1_ITEMS, Q1_BODY);
        if (BOTH(1)) GRID_BAR();
    }

    if (IN(2)) {
        PHASE_IDS();
        QUEUE_PULL(ctl + CW_Q1, Q1_ITEMS, Q1_BODY);
        __syncthreads();
        {
            const float qscale = 0.08838834764831845f * 1.4426950408889634f;
            for (int t = gw; t < T; t += NGW) {
                const bf16* prow = P + (size_t)t * NINP;
#pragma unroll
                for (int which = 0; which < 2; ++which) {
                    const float* gain = args.in[which ? I_SBKG : I_SBQG]; bf16* dst = (which ? KN : QN) + (size_t)t * 1536; const int cb = which ? PK : PQ;
                    const f32x4 g0 = *(const GAS f32x4*)(gain + (8 * lane & 127)), g1 = *(const GAS f32x4*)(gain + (8 * lane & 127) + 4);
#pragma unroll
                    for (int p = 0; p < 3; ++p) {
                        const v4u raw = *(const GAS v4u*)(prow + cb + 512 * p + 8 * lane);
                        float v[8] = {bflo(raw.x), bfhi(raw.x), bflo(raw.y), bfhi(raw.y), bflo(raw.z), bfhi(raw.z), bflo(raw.w), bfhi(raw.w)};
                        float ss = 0.f;
#pragma unroll
                        for (int j = 0; j < 8; ++j) ss += v[j] * v[j];
                        ss = red16_sum(ss);
                        const float rstd = (which ? 1.0f : qscale) / sqrtf(ss * (1.f / 128.f) + RMS_EPS);
                        v4u o; o.x = pk2(v[0] * rstd * g0.x, v[1] * rstd * g0.y); o.y = pk2(v[2] * rstd * g0.z, v[3] * rstd * g0.w);
                        o.z = pk2(v[4] * rstd * g1.x, v[5] * rstd * g1.y); o.w = pk2(v[6] * rstd * g1.z, v[7] * rstd * g1.w);
                        *(GAS v4u*)(dst + 512 * p + 8 * lane) = o;
                    }
                }
                {
                    const float* gain = args.in[I_MEMQG] + ((16 * lane) & 255);
                    const v4u r0 = *(const GAS v4u*)(prow + PMQ + 16 * lane), r1 = *(const GAS v4u*)(prow + PMQ + 16 * lane + 8);
                    float v[16] = {bflo(r0.x), bfhi(r0.x), bflo(r0.y), bfhi(r0.y), bflo(r0.z), bfhi(r0.z), bflo(r0.w), bfhi(r0.w), bflo(r1.x), bfhi(r1.x), bflo(r1.y), bfhi(r1.y), bflo(r1.z), bfhi(r1.z), bflo(r1.w), bfhi(r1.w)};
                    float ss = 0.f;
#pragma unroll
                    for (int j = 0; j < 16; ++j) ss += v[j] * v[j];
                    ss = red16_sum(ss);
                    const float rstd = 0.0625f / sqrtf(ss * (1.f / 256.f) + RMS_EPS);
                    unsigned o[8];
#pragma unroll
                    for (int j = 0; j < 8; ++j) o[j] = pk2(v[2 * j] * rstd * gain[2 * j], v[2 * j + 1] * rstd * gain[2 * j + 1]);
                    *(GAS v4u*)(MQN + (size_t)t * 1024 + 16 * lane) = (v4u){o[0], o[1], o[2], o[3]};
                    *(GAS v4u*)(MQN + (size_t)t * 1024 + 16 * lane + 8) = (v4u){o[4], o[5], o[6], o[7]};
                }
            }
            for (int m = gw; m < NMEM; m += NGW) {
                const float* gain = args.in[I_MEMKG] + ((16 * lane) & 255);
                const v4u r0 = *(const GAS v4u*)(MKRAW + (size_t)m * 1024 + 16 * lane), r1 = *(const GAS v4u*)(MKRAW + (size_t)m * 1024 + 16 * lane + 8);
                float v[16] = {bflo(r0.x), bfhi(r0.x), bflo(r0.y), bfhi(r0.y), bflo(r0.z), bfhi(r0.z), bflo(r0.w), bfhi(r0.w), bflo(r1.x), bfhi(r1.x), bflo(r1.y), bfhi(r1.y), bflo(r1.z), bfhi(r1.z), bflo(r1.w), bfhi(r1.w)};
                float ss = 0.f;
#pragma unroll
                for (int j = 0; j < 16; ++j) ss += v[j] * v[j];
                ss = red16_sum(ss);
                const float rstd = 1.0f / sqrtf(ss * (1.f / 256.f) + RMS_EPS);
                unsigned o[8];
#pragma unroll
                for (int j = 0; j < 8; ++j) o[j] = pk2(v[2 * j] * rstd * gain[2 * j], v[2 * j + 1] * rstd * gain[2 * j + 1]);
                *(GAS v4u*)(MKN + (size_t)m * 1024 + 16 * lane) = (v4u){o[0], o[1], o[2], o[3]};
                *(GAS v4u*)(MKN + (size_t)m * 1024 + 16 * lane + 8) = (v4u){o[4], o[5], o[6], o[7]};
            }
        }
        {
            LAS unsigned char* scr = lds + wave * 16640;
            for (int it = gw; it < 12 * 128; it += NGW) {
                const int h = it >> 7, t0 = (it & 127) * 64;
#pragma unroll
                for (int i = 0; i < 16; ++i) { const int tt = 4 * i + (lane >> 4), c = lane & 15;
                    const v4u raw = *(const GAS v4u*)(P + (size_t)(t0 + tt) * NINP + PV + 128 * h + 8 * c);
                    LAS unsigned* d = (LAS unsigned*)(scr + tt * 260 + c * 16); d[0] = raw.x; d[1] = raw.y; d[2] = raw.z; d[3] = raw.w; }
                LDS_WAIT(); asm volatile("" ::: "memory");
#pragma unroll
                for (int i = 0; i < 16; ++i) { const int d = 8 * i + (lane >> 3), tc = lane & 7;
                    unsigned short e[8];
#pragma unroll
                    for (int j = 0; j < 8; ++j) e[j] = *(const LAS unsigned short*)(scr + (8 * tc + j) * 260 + d * 2);
                    v4u o; o.x = e[0] | ((unsigned)e[1] << 16); o.y = e[2] | ((unsigned)e[3] << 16); o.z = e[4] | ((unsigned)e[5] << 16); o.w = e[6] | ((unsigned)e[7] << 16);
                    *(GAS v4u*)(VT + ((size_t)h * 128 + d) * T + t0 + 8 * tc) = o; }
                LDS_WAIT(); asm volatile("" ::: "memory");
            }
        }
        {
            const float* mix = args.in[I_RWMIX];
            for (int t = gw; t < T; t += NGW) {
                const bf16* cur = P + (size_t)t * NINP + PRW; const bf16* prv = cur - NINP;
                for (int c8 = 576 + lane; c8 < RWSEG / 8; c8 += 64) {
                    const int c0 = 8 * c8;
                    const v4u rc = *(const GAS v4u*)(cur + c0); v4u rp = (v4u){0u, 0u, 0u, 0u}; if (t > 0) rp = *(const GAS v4u*)(prv + c0);
                    const f32x4 m0 = *(const GAS f32x4*)(mix + c0), m1 = *(const GAS f32x4*)(mix + c0 + 4);
                    const float cv[8] = {bflo(rc.x), bfhi(rc.x), bflo(rc.y), bfhi(rc.y), bflo(rc.z), bfhi(rc.z), bflo(rc.w), bfhi(rc.w)};
                    const float pv[8] = {bflo(rp.x), bfhi(rp.x), bflo(rp.y), bfhi(rp.y), bflo(rp.z), bfhi(rp.z), bflo(rp.w), bfhi(rp.w)};
                    const float mv[8] = {m0.x, m0.y, m0.z, m0.w, m1.x, m1.y, m1.z, m1.w};
                    float s[8];
#pragma unroll
                    for (int j = 0; j < 8; ++j) s[j] = cv[j] + (pv[j] - cv[j]) * mv[j];
                    if (c0 < 4864) { const bool isw = c0 < 4736;
                        if (isw) {
#pragma unroll
                            for (int j = 0; j < 8; ++j) { const float e = fexp(2.f * s[j]); s[j] = 1.f - 2.f * frcp(e + 1.f); } }
                        *(GAS v4u*)(LA1 + (size_t)t * 256 + (c0 - 4608)) = (v4u){pk2(s[0], s[1]), pk2(s[2], s[3]), pk2(s[4], s[5]), pk2(s[6], s[7])}; }
                    else {
#pragma unroll
                        for (int j = 0; j < 8; ++j) s[j] = sigmoidf_(s[j]);
                        *(GAS v4u*)(LA2 + (size_t)t * 512 + (c0 - 4864)) = (v4u){pk2(s[0], s[1]), pk2(s[2], s[3]), pk2(s[4], s[5]), pk2(s[6], s[7])}; }
                }
                if (lane < 4) *(GAS v4u*)(LA2 + (size_t)t * 512 + 480 + 8 * lane) = (v4u){0u, 0u, 0u, 0u};
            }
        }
        if (BOTH(2)) GRID_BAR();
    }

    if (IN(3)) {
        PHASE_IDS();
        int nt4 = 4, nt8 = 8; asm volatile("" : "+s"(nt4), "+s"(nt8));
        { pg8::SchedPlain S; S.to.init(32, 12); S.G = G; S.c = bx; S.nt = nt4; S.A0 = (const char*)LA1; S.B0 = (const char*)LBWA; S.sA = 256 * 256 * 2; S.sB = 256 * 256 * 2;
          pg8::EpiLoraWA E{args.in[I_RWW0], args.in[I_RWA0], R_W, R_NB};
          pg8::gemm_phase(lds, 256, 256, S, E); }
        { pg8::SchedPlain S; S.to.init(32, 6); S.G = G; S.c = (bx + G - 64) % G; S.nt = nt8; S.A0 = (const char*)LA2; S.B0 = (const char*)LBG; S.sA = 256 * 512 * 2; S.sB = 256 * 512 * 2;
          pg8::EpiBf16 E{GB, 1536, 0, 0};
          pg8::gemm_phase(lds, 512, 512, S, E); }
        { pg8::SchedHeads S; S.G = G; S.c = (bx + G - 128) % G; S.nunits = 128; S.nt = nt4; S.A0 = (const char*)MQN; S.B0 = (const char*)MKN; S.sA = 256 * 1024 * 2; S.hA = 512; S.hB = 512;
          pg8::EpiScoreF32 E{SM};
          pg8::gemm_phase(lds, 1024, 1024, S, E); }
        if (BOTH(3)) GRID_BAR();
    }

    if (IN(4)) {
        PHASE_IDS();
        constexpr int RP = 260, SLOT = 64 * RP, NP = 272;
        constexpr int S_AT = 0, S_BT = SLOT, S_KT = 2 * SLOT, S_RT = 3 * SLOT, S_NABT = 4 * SLOT, S_NAK = S_NABT + 64 * NP, S_MBR = S_NAK + SLOT, S_MKR = S_MBR + SLOT, S_SEG = S_MKR + SLOT, S_GC = S_SEG + 2048;
        static_assert(S_GC + 256 <= LDSCTL_OFF, "chunk-prep LDS map");
        constexpr int HP = 144, HSL = 64 * HP, H_AT = S_NABT, H_BT = H_AT + HSL, H_KT = H_BT + HSL, H_RT = H_KT + HSL;
        static_assert(H_RT + HSL <= S_SEG, "bf16 operand copies inside the Gram output slots");
        constexpr int H_PSIT = S_GC + 256, H_QCT = H_PSIT + HSL;
        static_assert(H_QCT + HSL <= LDSCTL_OFF, "chunk-prep LDS map (bf16 step-F operands)");
        const int l31 = lane & 31, lh = lane >> 5;
        float nwv[8], nkrv[8], nav[8], nrv[8], nvv[8];
        unsigned short pr_[9], pk_[9], pv_[9];
        float cmr, cmk, cmv, ckk, cka, crk;
#define S1_FETCH(it_) do { const int t0_ = ((it_) & 127) * 64 + 8 * wave, hc_ = ((it_) >> 7) * 64 + lane; const unsigned gb_ = (unsigned)(t0_ * 1536 + hc_) * 4u; \
            cmr = args.in[I_RWMIX][hc_]; cmk = args.in[I_RWMIX][1536 + hc_]; cmv = args.in[I_RWMIX][3072 + hc_]; ckk = args.in[I_RWKK][hc_]; cka = args.in[I_RWKA][hc_]; crk = args.in[I_RWRK][hc_]; \
            _Pragma("unroll") for (int i = 0; i < 8; ++i) { const unsigned o_ = gb_ + (unsigned)i * 6144u; nwv[i] = *(const GAS float*)((const GAS char*)R_W + o_); nav[i] = bflo(*(const GAS unsigned short*)((const GAS char*)R_NB + (o_ >> 1))); } \
            _Pragma("unroll") for (int i = 0; i < 9; ++i) { const int row_ = (t0_ + i - 1) > 0 ? (t0_ + i - 1) : 0; const unsigned po_ = (unsigned)(row_ * NINP + PRW + hc_) * 2u;     \
                pr_[i] = *(const GAS unsigned short*)((const GAS char*)P + po_); pk_[i] = *(const GAS unsigned short*)((const GAS char*)P + po_ + 3072u); pv_[i] = *(const GAS unsigned short*)((const GAS char*)P + po_ + 6144u); } \
            if (t0_ == 0) { pr_[0] = 0; pk_[0] = 0; pv_[0] = 0; }     } while (0)
#define S1_SHIFT() do { const float mr_ = cmr, mk_ = cmk, mv_ = cmv; \
            _Pragma("unroll") for (int i = 0; i < 8; ++i) { const float cr_ = bflo(pr_[i + 1]), ck_ = bflo(pk_[i + 1]), cv_ = bflo(pv_[i + 1]); \
                nrv[i] = cr_ + (bflo(pr_[i]) - cr_) * mr_; nkrv[i] = ck_ + (bflo(pk_[i]) - ck_) * mk_; nvv[i] = cv_ + (bflo(pv_[i]) - cv_) * mv_; } } while (0)
#define S1_MAP(u_) ((((u_) % 24) << 7) + (u_) / 24)
        if (bx < 24 * 128) S1_FETCH(S1_MAP(bx));
        for (int unit = bx; unit < 24 * 128; unit += G) {
            const int item = S1_MAP(unit);
            const int head = item >> 7, chunk = item & 127;
            unsigned vvp[4];
            {
                S1_SHIFT();
                float nkkv[8], nnbv[8], nkpv[8];
                { const float kkc = ckk, kac = cka;
#pragma unroll
                  for (int i = 0; i < 8; ++i) { const float kq = nkrv[i] * kkc; const float ss = wave_sum_u(kq * kq);
                      const float kn = kq * fminf(__builtin_amdgcn_rsqf(ss), 1e12f);     nkkv[i] = kn; nnbv[i] = -(kn * nav[i]); nkpv[i] = nkrv[i] * (1.0f + (nav[i] - 1.0f) * kac); } }
                float g[8]; g[0] = nwv[0];
#pragma unroll
                for (int i = 1; i < 8; ++i) g[i] = g[i - 1] * nwv[i];
                *(LAS float*)(lds + S_SEG + (wave * 64 + lane) * 4) = g[7];
                __syncthreads();
                float pre = 1.0f;
#pragma unroll
                for (int w2 = 0; w2 < 7; ++w2) { const float gw2 = *(LAS const float*)(lds + S_SEG + (w2 * 64 + lane) * 4); pre *= (w2 < wave) ? gw2 : 1.0f; }
                float avs[8];
#pragma unroll
                for (int i = 0; i < 8; ++i) { const float gt = pre * g[i], gp = (i == 0) ? pre : pre * g[i - 1], inv = frcp(gt); const int o = (8 * wave + i) * RP + lane * 4;
                    const float av = nkkv[i] * gp, bv = nnbv[i] * inv, kv = nkpv[i] * inv, rvv = nrv[i] * gt;
                    avs[i] = av; *(LAS float*)(lds + S_BT + o) = bv; *(LAS float*)(lds + S_KT + o) = kv; *(LAS float*)(lds + S_RT + o) = rvv;
                    const int ob = (8 * wave + i) * HP + lane * 2;
                    *(LAS unsigned short*)(lds + H_AT + ob) = (unsigned short)f2bf(av); *(LAS unsigned short*)(lds + H_BT + ob) = (unsigned short)f2bf(bv);
                    *(LAS unsigned short*)(lds + H_KT + ob) = (unsigned short)f2bf(kv); *(LAS unsigned short*)(lds + H_RT + ob) = (unsigned short)f2bf(rvv); }
                *(LAS v4u*)(lds + S_AT + lane * HP + wave * 16) = (v4u){pk2(avs[0], avs[1]), pk2(avs[2], avs[3]), pk2(avs[4], avs[5]), pk2(avs[6], avs[7])};
                vvp[0] = pk2(nvv[0], nvv[1]); vvp[1] = pk2(nvv[2], nvv[3]); vvp[2] = pk2(nvv[4], nvv[5]); vvp[3] = pk2(nvv[6], nvv[7]);
                if (wave == 7) *(LAS float*)(lds + S_GC + lane * 4) = pre * g[7];
                { const float rkl = crk;
                  float bsv = 0.f;
#pragma unroll
                  for (int i = 0; i < 8; ++i) { const float bsum = wave_sum_u(nrv[i] * nkpv[i] * rkl); bsv = (lane == i) ? bsum : bsv; }
                  if (lane < 8) BONUS[(size_t)(chunk * 64 + 8 * wave + lane) * 24 + head] = bsv; }
                if (unit + G < 24 * 128) S1_FETCH(S1_MAP(unit + G));
                __syncthreads();
            }
            {
                const int Ls = (wave >> 2) ? H_KT : H_BT, Rs = ((wave >> 1) & 1) ? H_RT : H_AT, hm = wave & 1, which = wave >> 1;
                LAS const unsigned char* Lp = lds + Ls + (32 * hm + l31) * HP + lh * 16;
                LAS const unsigned char* Rp = lds + Rs + l31 * HP + lh * 16;
                f32x16 acc0, acc1;
#pragma unroll
                for (int r = 0; r < 16; ++r) { acc0[r] = 0.f; acc1[r] = 0.f; }
#pragma unroll
                for (int ks = 0; ks < 4; ++ks) { const bf16x8 a = *(LAS const bf16x8*)(Lp + ks * 32), b0 = *(LAS const bf16x8*)(Rp + ks * 32), b1 = *(LAS const bf16x8*)(Rp + 32 * HP + ks * 32);
                    acc0 = __builtin_amdgcn_mfma_f32_32x32x16_bf16(a, b0, acc0, 0, 0, 0); acc1 = __builtin_amdgcn_mfma_f32_32x32x16_bf16(a, b1, acc1, 0, 0, 0); }
                __syncthreads();
#define S1_GVAL(strict_) const int j = 32 * hm + (r & 3) + 8 * (r >> 2) + 4 * lh, t = 32 * nt + l31; float val = nt ? acc1[r] : acc0[r]; val = ((strict_) ? (j < t) : (j <= t)) ? val : 0.f
                if (which == 0) {
#pragma unroll
                    for (int nt = 0; nt < 2; ++nt)
#pragma unroll
                        for (int r = 0; r < 16; ++r) { S1_GVAL(true); *(LAS float*)(lds + S_NABT + t * NP + ((j & 3) * 16 + (j >> 2)) * 4) = val; }
                } else if (which == 2) {
#pragma unroll
                    for (int nt = 0; nt < 2; ++nt)
#pragma unroll
                        for (int r = 0; r < 16; ++r) { S1_GVAL(true); *(LAS unsigned short*)(lds + S_NAK + j * HP + t * 2) = (unsigned short)f2bf(val); }
                } else {
                    const int mslot = (which == 1) ? S_MBR : S_MKR;
#pragma unroll
                    for (int nt = 0; nt < 2; ++nt)
#pragma unroll
                        for (int r = 0; r < 16; ++r) { S1_GVAL(false); *(LAS float*)(lds + mslot + j * RP + t * 4) = val; }
                }
                __syncthreads();
            }
            {
                const int ci = lane >> 2, g = lane & 3, c = 16 * (wave & 3) + ci; const int slot = (wave < 4) ? S_MBR : S_BT;
                f32x2 xr[8];
#pragma unroll
                for (int q = 0; q < 16; ++q) xr[q >> 1][q & 1] = *(LAS const float*)(lds + slot + (4 * q + g) * RP + c * 4);
                __syncthreads();
                f32x4 ca[4], cb[4], cc[4];
#define S1_CF(t_, dst_) do { if ((t_) >= 1) { _Pragma("unroll") for (int qg = 0; qg < 4; ++qg) if (4 * qg < ((t_) >> 2) + 1) dst_[qg] = *(LAS const f32x4*)(lds + S_NABT + (t_) * NP + (g * 16 + 4 * qg) * 4); } } while (0)
#define S1_STEP(t_, cur_, nxt_) do { S1_CF((t_) - 2, nxt_); __builtin_amdgcn_sched_barrier(0); \
                    const float xt = quad_bcast(xr[(t_) >> 3][((t_) >> 2) & 1], (t_) & 3);     \
                    const f32x2 xt2 = {xt, xt}; \
                    _Pragma("unroll") for (int qp = 0; qp < 8; ++qp) if (2 * qp < ((t_) >> 2) + 1) { const f32x2 cf2 = {cur_[qp >> 1][2 * (qp & 1)], cur_[qp >> 1][2 * (qp & 1) + 1]}; \
                        xr[qp] = __builtin_elementwise_fma(cf2, xt2, xr[qp]); }     \
                    __builtin_amdgcn_sched_barrier(0); } while (0)
                S1_CF(63, ca); S1_CF(62, cb);
#pragma unroll
                for (int tb = 63; tb >= 1; tb -= 3) { S1_STEP(tb, ca, cc); S1_STEP(tb - 1, cb, ca); S1_STEP(tb - 2, cc, cb); }
#pragma unroll
                for (int q = 0; q < 16; ++q) *(LAS unsigned short*)(lds + slot + c * HP + (4 * q + g) * 2) = (unsigned short)f2bf(xr[q >> 1][q & 1]);
                __syncthreads();
            }
            {
                const int which = wave >> 2, hm = (wave >> 1) & 1, ch = wave & 1; const int Xs = ch ? S_BT : S_MBR;
                LAS const unsigned char* Ap = lds + (which ? S_NAK : S_AT) + (32 * hm + l31) * HP + lh * 16;
                LAS const unsigned char* Bp = lds + Xs + l31 * HP + lh * 16;
                f32x16 acc0, acc1;
                int l31e = l31, lhe = lh; asm volatile("" : "+v"(l31e), "+v"(lhe));
                {
                    const int ibase = (which == 0) ? S_RT : (ch ? S_KT : S_MKR), sm = (which == 0) ? 4 : RP, sn = (which == 0) ? RP : 4;
                    const int tb = ibase + (32 * hm + 4 * lhe) * sm + l31e * sn;
#pragma unroll
                    for (int r = 0; r < 16; ++r) { const int om = ((r & 3) + 8 * (r >> 2)) * sm; acc0[r] = *(LAS const float*)(lds + tb + om); acc1[r] = *(LAS const float*)(lds + tb + om + 32 * sn); }
                    if (which == 0 && ch) {
#pragma unroll
                        for (int r = 0; r < 16; ++r) { const int m = 32 * hm + (r & 3) + 8 * (r >> 2) + 4 * lhe; acc0[r] = (m == l31e) ? 1.0f : 0.0f; acc1[r] = (m == 32 + l31e) ? 1.0f : 0.0f; }
                    }
                }
#pragma unroll
                for (int ks = 0; ks < 4; ++ks) { const bf16x8 a = *(LAS const bf16x8*)(Ap + ks * 32), b0 = *(LAS const bf16x8*)(Bp + ks * 32), b1 = *(LAS const bf16x8*)(Bp + 32 * HP + ks * 32);
                    acc0 = __builtin_amdgcn_mfma_f32_32x32x16_bf16(a, b0, acc0, 0, 0, 0); acc1 = __builtin_amdgcn_mfma_f32_32x32x16_bf16(a, b1, acc1, 0, 0, 0); }
#pragma unroll
                for (int nt = 0; nt < 2; ++nt) { const int n = 32 * nt + l31; const float gcn = ch ? *(LAS const float*)(lds + S_GC + n * 4) : 1.0f;
                    if (which == 0) { const size_t eo = ((size_t)item * 64 + n) * 64 + 32 * hm + 4 * lh;
                        if (ch) {
#pragma unroll
                            for (int i = 0; i < 4; ++i) { f32x4 o;
#pragma unroll
                                for (int e = 0; e < 4; ++e) o[e] = (nt ? acc1[4 * i + e] : acc0[4 * i + e]) * gcn;
                                *(GAS f32x4*)(PCT + eo + 8 * i) = o; }
                        } else {
#pragma unroll
                            for (int i = 0; i < 4; ++i) { const int q = 4 * i;
                                *(GAS v2u*)(PHIT + eo + 8 * i) = nt ? (v2u){pk2(acc1[q], acc1[q + 1]), pk2(acc1[q + 2], acc1[q + 3])} : (v2u){pk2(acc0[q], acc0[q + 1]), pk2(acc0[q + 2], acc0[q + 3])}; }
                        } }
                    else {
#pragma unroll
                        for (int i = 0; i < 4; ++i) { const int j0 = 32 * hm + 8 * i + 4 * lh; float o[4];
#pragma unroll
                            for (int e = 0; e < 4; ++e) o[e] = (nt ? acc1[4 * i + e] : acc0[4 * i + e]) * gcn;
                            *(LAS v2u*)(lds + (ch ? H_QCT : H_PSIT) + n * HP + j0 * 2) = (v2u){pk2(o[0], o[1]), pk2(o[2], o[3])}; } } }
                *(LAS v4u*)(lds + S_NABT + lane * HP + wave * 16) = (v4u){vvp[0], vvp[1], vvp[2], vvp[3]};
                __syncthreads();
            }
            {
                const int hm = wave >> 2, ct = wave & 3, nt = ct & 1; const int Bs = (ct < 2) ? H_PSIT : H_QCT;
                LAS const unsigned char* Ap = lds + S_NABT + (32 * hm + l31) * HP + lh * 16;
                LAS const unsigned char* Bp = lds + Bs + (32 * nt + l31) * HP + lh * 16;
                f32x16 acc;
#pragma unroll
                for (int r = 0; r < 16; ++r) acc[r] = 0.f;
#pragma unroll
                for (int ks = 0; ks < 4; ++ks) acc = __builtin_amdgcn_mfma_f32_32x32x16_bf16(*(LAS const bf16x8*)(Ap + ks * 32), *(LAS const bf16x8*)(Bp + ks * 32), acc, 0, 0, 0);
                const int n = 32 * nt + l31;
                bf16* dst = (ct < 2) ? (Y + (size_t)(chunk * 64 + n) * 1536 + head * 64 + 32 * hm + 4 * lh) : (SLOCT + ((size_t)item * 64 + n) * 64 + 32 * hm + 4 * lh);
#pragma unroll
                for (int i = 0; i < 4; ++i) *(GAS v2u*)(dst + 8 * i) = (v2u){pk2(acc[4 * i], acc[4 * i + 1]), pk2(acc[4 * i + 2], acc[4 * i + 3])};
                __syncthreads();
            }
        }
        for (int t = gw; t < T; t += NGW) {
            {
                const float* srow = SM + (size_t)t * 1024 + 16 * lane; f32x4 s[4]; float mx = -3.0e38f;
#pragma unroll
                for (int j = 0; j < 4; ++j) { s[j] = *(const GAS f32x4*)(srow + 4 * j); mx = fmaxf(mx, fmaxf(fmaxf(s[j].x, s[j].y), fmaxf(s[j].z, s[j].w))); }
                mx = red16_max(mx); float sum = 0.f;
#pragma unroll
                for (int j = 0; j < 4; ++j) { s[j].x = fexp(s[j].x - mx); s[j].y = fexp(s[j].y - mx); s[j].z = fexp(s[j].z - mx); s[j].w = fexp(s[j].w - mx); sum += (s[j].x + s[j].y) + (s[j].z + s[j].w); }
                sum = red16_sum(sum); const float inv = 1.0f / sum;
                unsigned o[8];
#pragma unroll
                for (int j = 0; j < 4; ++j) { o[2 * j] = pk2(s[j].x * inv, s[j].y * inv); o[2 * j + 1] = pk2(s[j].z * inv, s[j].w * inv); }
                *(GAS v4u*)(PM + (size_t)t * 1024 + 16 * lane) = (v4u){o[0], o[1], o[2], o[3]};
                *(GAS v4u*)(PM + (size_t)t * 1024 + 16 * lane + 8) = (v4u){o[4], o[5], o[6], o[7]};
            }
        }
        if (BOTH(4)) GRID_BAR();
    }

    if (IN(5)) {
        PHASE_IDS();
        constexpr int NSCAN = 96;
        if (bx < NSCAN) {
            const int head = 3 * (bx & 7) + (bx >> 5), rb = (bx >> 3) & 3, gk = lane >> 4, j = lane & 15, n0 = 16 * (wave & 3);
            constexpr int SP = 272, SBUF = 16 * SP;
            for (int i = tid; i < 2 * SBUF / 4; i += 512) *(LAS float*)(lds + i * 4) = 0.f;
            __syncthreads();
            int cur = 0;
            if (wave < 4) {
                const float* bsrc = PCT + ((size_t)head * 128 * 64 + n0 + j) * 64 + 16 * gk;
                const bf16* xsrc = SLOCT + ((size_t)head * 128 * 64 + n0 + j) * 64 + 16 * rb + 4 * gk;
                f32x4 bqs[3][4]; v2u xqs[3];
#define S2_LOAD(set, cc) do { const int cl_ = (cc) < 127 ? (cc) : 127; _Pragma("unroll") for (int q4 = 0; q4 < 4; ++q4) bqs[set][q4] = *(const GAS f32x4*)(bsrc + (size_t)cl_ * 4096 + 4 * q4); \
                    xqs[set] = *(const GAS v2u*)(xsrc + (size_t)cl_ * 4096); } while (0)
#define S2_STEP(set, cc) do { f32x4 a4[4]; _Pragma("unroll") for (int q4 = 0; q4 < 4; ++q4) a4[q4] = *(LAS const f32x4*)(lds + cur * SBUF + j * SP + (16 * gk + 4 * q4) * 4); \
                    f32x4 acc[4]; _Pragma("unroll") for (int e = 0; e < 4; ++e) acc[e] = (f32x4){0.f, 0.f, 0.f, 0.f}; \
                    _Pragma("unroll") for (int q4 = 0; q4 < 4; ++q4) _Pragma("unroll") for (int e = 0; e < 4; ++e) acc[e] = __builtin_amdgcn_mfma_f32_16x16x4f32(a4[q4][e], bqs[set][q4][e], acc[e], 0, 0, 0); \
                    const f32x4 sum = (acc[0] + acc[1]) + (acc[2] + acc[3]) + (f32x4){bflo(xqs[set].x), bfhi(xqs[set].x), bflo(xqs[set].y), bfhi(xqs[set].y)}; \
                    _Pragma("unroll") for (int r = 0; r < 4; ++r) *(LAS float*)(lds + (cur ^ 1) * SBUF + (4 * gk + r) * SP + (n0 + j) * 4) = sum[r]; \
                    S2_LOAD(set, (cc) + 3); __syncthreads(); cur ^= 1; } while (0)
                S2_LOAD(0, 0); S2_LOAD(1, 1); S2_LOAD(2, 2);
                for (int c = 0; c < 126; c += 3) { S2_STEP(0, c); S2_STEP(1, c + 1); S2_STEP(2, c + 2); } S2_STEP(0, 126); S2_STEP(1, 127);
#undef S2_LOAD
#undef S2_STEP
            } else {
                const int srow = 4 * (wave - 4) + (lane >> 4), sk = 4 * (lane & 15);
                bf16* dst = S0ALL + ((size_t)head * 128 * 64 + 16 * rb + srow) * 64 + sk;
                for (int c = 0; c < 128; ++c) { const f32x4 sv = *(LAS const f32x4*)(lds + cur * SBUF + srow * SP + sk * 4); *(GAS v2u*)(dst + (size_t)c * 4096) = (v2u){pk2(sv[0], sv[1]), pk2(sv[2], sv[3])}; __syncthreads(); cur ^= 1; }
            }
        }
        {
            const int GA = G - NSCAN, ca = bx - NSCAN;
            float thr;
            {
                const float* gq = args.in[I_SBQG]; const float* gk = args.in[I_SBKG];
                float mq = fmaxf(fabsf(gq[lane]), fabsf(gq[lane + 64])), mk = fmaxf(fabsf(gk[lane]), fabsf(gk[lane + 64]));
#pragma unroll
                for (int o = 1; o < 64; o <<= 1) { mq = fmaxf(mq, __shfl_xor(mq, o)); mk = fmaxf(mk, __shfl_xor(mk, o)); }
                thr = (11.3137085f * 1.02f * mq * mk + 104.0f) * 1.4426950408889634f;
            }
            constexpr int KPITCH = 272, VPITCH = 136, KBUF = 64 * KPITCH, VBUF = 128 * VPITCH, VOFF = 2 * KBUF, FLAGOFF = VOFF + 2 * VBUF, UQOFF = FLAGOFF + 64;
            const int hh = lane >> 5, l31 = lane & 31;
            __syncthreads();
            for (;;) {
                if (tid == 0) *(LAS int*)(lds + UQOFF) = (int)__hip_atomic_fetch_add((unsigned*)(ctl + CW_Q2), 1u, __ATOMIC_RELAXED, __HIP_MEMORY_SCOPE_AGENT);
                __syncthreads();
                const int uidx = *(LAS const int*)(lds + UQOFF);
                if (uidx >= 12 * 32) break;
                const int head = uidx % 12, qb = 31 - uidx / 12;
                const int q0 = qb * 256 + wave * 32, qi = q0 + l31;
                bf16x8 qf[8];
                { const bf16* qp = QN + (size_t)qi * 1536 + head * 128 + 8 * hh;
#pragma unroll
                  for (int s = 0; s < 8; ++s) qf[s] = *(const GAS bf16x8*)(qp + 16 * s); }
                f32x16 o[4];
#pragma unroll
                for (int c = 0; c < 4; ++c)
#pragma unroll
                    for (int r = 0; r < 16; ++r) o[c][r] = 0.f;
                float carry = 0.f; bool mydone = false;
                const int kkey = tid >> 3, kc = (tid & 7) * 2, vhd = tid >> 2, vp = tid & 3;
                const unsigned kofs = (unsigned)(kkey * 1536 + kc * 8) * 2u, vofs = (unsigned)(vhd * T + vp * 16) * 2u;
                const char* kgb = (const char*)KN + (size_t)head * 256; const char* vgb = (const char*)VT + (size_t)head * 128 * T * 2;
                v4u kr0, kr1, vr0, vr1;
#define SB_LOAD(kt_) do { const char* kb_ = kgb + (size_t)(kt_) * 64 * 1536 * 2; const char* vb_ = vgb + (size_t)(kt_) * 128; \
                          kr0 = *(const GAS v4u*)(kb_ + kofs); kr1 = *(const GAS v4u*)(kb_ + kofs + 16); vr0 = *(const GAS v4u*)(vb_ + vofs); vr1 = *(const GAS v4u*)(vb_ + vofs + 16); } while (0)
#define SB_STORE(buf_) do { LAS unsigned char* kd = lds + (buf_) * KBUF + kkey * KPITCH + kc * 16; *(LAS v4u*)kd = kr0; *(LAS v4u*)(kd + 16) = kr1; \
                          LAS unsigned char* vd = lds + VOFF + (buf_) * VBUF + vhd * VPITCH + vp * 32; *(LAS v2u*)vd = (v2u){vr0.x, vr0.y}; *(LAS v2u*)(vd + 8) = (v2u){vr0.z, vr0.w}; \
                          *(LAS v2u*)(vd + 16) = (v2u){vr1.x, vr1.y}; *(LAS v2u*)(vd + 24) = (v2u){vr1.z, vr1.w}; } while (0)
                int kt = 4 * qb + 3, cur = 0, it = 0;
                SB_LOAD(kt); SB_STORE(0); __syncthreads();
                for (;;) {
                    const bool more = kt > 0;
                    if (more) SB_LOAD(kt - 1);
                    const int k0 = kt * 64;
                    if (!mydone && k0 < q0 + 31) {
                        LAS const unsigned char* Kb = lds + cur * KBUF; LAS const unsigned char* Vb = lds + VOFF + cur * VBUF;
                        bf16x8 wf[2][2];
#pragma unroll
                        for (int b = 1; b >= 0; --b) {
                            f32x16 z;
#pragma unroll
                            for (int r = 0; r < 16; ++r) z[r] = 0.f;
#pragma unroll
                            for (int s = 0; s < 8; ++s) { const bf16x8 kf = *(LAS const bf16x8*)(Kb + (32 * b + l31) * KPITCH + (16 * s + 8 * hh) * 2);
                                z = __builtin_amdgcn_mfma_f32_32x32x16_bf16(kf, qf[s], z, 0, 0, 0); }
                            float sp[16];
                            const int lim = qi - k0 - 32 * b - 4 * hh;
#pragma unroll
                            for (int r = 0; r < 16; ++r) { const float zz = z[r];
                                const float v = fmaxf(zz, 0.f) + __builtin_amdgcn_logf(1.0f + __builtin_amdgcn_exp2f(-fabsf(zz))); sp[r] = (((r & 3) + 8 * (r >> 2)) < lim) ? v : 0.f; }
                            float Gs[4], Gp[4], Tt[4];
#pragma unroll
                            for (int i = 0; i < 4; ++i) { Gs[i] = (sp[4 * i] + sp[4 * i + 1]) + (sp[4 * i + 2] + sp[4 * i + 3]); Gp[i] = __shfl_xor(Gs[i], 32); Tt[i] = Gs[i] + Gp[i]; }
                            float X[4]; X[3] = 0.f; X[2] = Tt[3]; X[1] = X[2] + Tt[2]; X[0] = X[1] + Tt[1];
                            unsigned wp[8];
#pragma unroll
                            for (int i = 0; i < 4; ++i) {
                                const float newer = carry + X[i] + (hh == 0 ? Gp[i] : 0.f);
                                const float t3 = newer + sp[4 * i + 3], t2 = t3 + sp[4 * i + 2], t1 = t2 + sp[4 * i + 1], t0 = t1 + sp[4 * i];
                                const float tl[4] = {t0, t1, t2, t3}; float w[4];
#pragma unroll
                                for (int j = 0; j < 4; ++j) { const float e = __builtin_amdgcn_exp2f(z[4 * i + j] - tl[j]); w[j] = ((j + 8 * i) < lim) ? e : 0.f; }
                                wp[2 * i] = pk2(w[0], w[1]); wp[2 * i + 1] = pk2(w[2], w[3]);
                            }
                            carry += X[0] + Tt[0];
                            wf[b][0] = __builtin_bit_cast(bf16x8, (v4u){wp[0], wp[1], wp[2], wp[3]}); wf[b][1] = __builtin_bit_cast(bf16x8, (v4u){wp[4], wp[5], wp[6], wp[7]});
                        }
#pragma unroll
                        for (int b = 0; b < 2; ++b)
#pragma unroll
                            for (int s = 0; s < 2; ++s)
#pragma unroll
                                for (int c = 0; c < 4; ++c) { LAS const unsigned char* vpz = Vb + (32 * c + l31) * VPITCH + (32 * b + 16 * s + 4 * hh) * 2;
                                    const v2u va = *(LAS const v2u*)vpz, vb2 = *(LAS const v2u*)(vpz + 16);
                                    const bf16x8 vf = __builtin_bit_cast(bf16x8, (v4u){va.x, va.y, vb2.x, vb2.y});
                                    o[c] = __builtin_amdgcn_mfma_f32_32x32x16_bf16(vf, wf[b][s], o[c], 0, 0, 0); }
                        mydone = __all(carry > thr);
                    }
                    if (more) SB_STORE(cur ^ 1);
                    if (lane == 0) *(LAS unsigned*)(lds + FLAGOFF + ((it & 1) * 8 + wave) * 4) = mydone ? 1u : 0u;
                    __syncthreads();
                    if (!more) break;
                    { const v4u f0 = *(LAS const v4u*)(lds + FLAGOFF + (it & 1) * 32), f1 = *(LAS const v4u*)(lds + FLAGOFF + (it & 1) * 32 + 16);
                      if ((f0.x & f0.y & f0.z & f0.w & f1.x & f1.y & f1.z & f1.w) != 0u) break; }
                    --kt; cur ^= 1; ++it;
                }
#undef SB_LOAD
#undef SB_STORE
                bf16* op = OCAT + (size_t)qi * 4096 + head * 128 + 4 * hh;
#pragma unroll
                for (int c = 0; c < 4; ++c)
#pragma unroll
                    for (int i = 0; i < 4; ++i) *(GAS v2u*)(op + 32 * c + 8 * i) = (v2u){pk2(o[c][4 * i], o[c][4 * i + 1]), pk2(o[c][4 * i + 2], o[c][4 * i + 3])};
                __syncthreads();
            }
            if (bx >= NSCAN) { int nt4 = 4; asm volatile("" : "+s"(nt4)); pg8::SchedHeads S; S.G = GA; S.c = ca; S.nunits = 128; S.nt = nt4; S.A0 = (const char*)PM; S.B0 = (const char*)MVT; S.sA = 256 * 1024 * 2; S.hA = 512; S.hB = 256 * 1024 * 2;
              pg8::EpiBf16 E{OCAT, 4096, 3072, 256};
              pg8::gemm_phase(lds, 1024, 1024, S, E); }
        }
        if (BOTH(4)) GRID_BAR();
    }

    if (IN(6)) {
        PHASE_IDS();
        {
            const float* lng = args.in[I_RWLNG]; const float* lnb = args.in[I_RWLNB];
            const int l31 = lane & 31, lh = lane >> 5, sub = wave >> 2, mt = (wave >> 1) & 1, nt = wave & 1;
            LAS float* xch = (LAS float*)lds;
            for (int it0 = 2 * bx; it0 < 24 * 128; it0 += 2 * G) {
                const int unit = it0 + sub, item = ((unit % 24) << 7) + unit / 24, head = item >> 7, chunk = item & 127;
                const int tq = 32 * nt + l31; const size_t trow = (size_t)(chunk * 64 + tq);
                const bf16* ap = S0ALL + ((size_t)item * 64 + 32 * mt + l31) * 64 + 8 * lh;
                const bf16* bp = PHIT + ((size_t)item * 64 + tq) * 64 + 8 * lh;
                v4u af[4], bfv[4];
#pragma unroll
                for (int ks = 0; ks < 4; ++ks) { af[ks] = *(const GAS v4u*)(ap + 16 * ks); bfv[ks] = *(const GAS v4u*)(bp + 16 * ks); }
                f32x4 yl[4], vv4[4]; v2u gg[4];
                { const int vc = head * 64 + 32 * mt + 4 * lh; const bf16* yp = Y + trow * 1536 + vc; const bf16* gp = GB + trow * 1536 + vc;
                  const bf16* pc = P + trow * NINP + PRW + 3072 + vc; const float* mxp = args.in[I_RWMIX] + 3072 + vc;
#pragma unroll
                  for (int i = 0; i < 4; ++i) { { const v2u y2 = *(const GAS v2u*)(yp + 8 * i); yl[i] = (f32x4){bflo(y2.x), bfhi(y2.x), bflo(y2.y), bfhi(y2.y)}; } gg[i] = *(const GAS v2u*)(gp + 8 * i);
                      const v2u c2 = *(const GAS v2u*)(pc + 8 * i); v2u p2 = (v2u){0u, 0u}; if (trow > 0) p2 = *(const GAS v2u*)(pc - NINP + 8 * i); const f32x4 mx = *(const GAS f32x4*)(mxp + 8 * i);
                      const float cv4[4] = {bflo(c2.x), bfhi(c2.x), bflo(c2.y), bfhi(c2.y)}, pv4[4] = {bflo(p2.x), bfhi(p2.x), bflo(p2.y), bfhi(p2.y)};
#pragma unroll
                      for (int e = 0; e < 4; ++e) vv4[i][e] = cv4[e] + (pv4[e] - cv4[e]) * mx[e]; } }
                const float bon = BONUS[trow * 24 + head];
                f32x16 acc;
#pragma unroll
                for (int r = 0; r < 16; ++r) acc[r] = 0.f;
#pragma unroll
                for (int ks = 0; ks < 4; ++ks) {
                    acc = __builtin_amdgcn_mfma_f32_32x32x16_bf16(__builtin_bit_cast(bf16x8, af[ks]), __builtin_bit_cast(bf16x8, bfv[ks]), acc, 0, 0, 0); }
                float yv[16]; float s1 = 0.f, s2 = 0.f;
#pragma unroll
                for (int i = 0; i < 4; ++i)
#pragma unroll
                    for (int e = 0; e < 4; ++e) { const float y = acc[4 * i + e] + yl[i][e]; yv[4 * i + e] = y; s1 += y; s2 += y * y; }
                s1 += __shfl_xor(s1, 32); s2 += __shfl_xor(s2, 32);
                if (lh == 0) { xch[((sub * 2 + mt) * 64 + tq) * 2] = s1; xch[((sub * 2 + mt) * 64 + tq) * 2 + 1] = s2; }
                __syncthreads();
                { const float o1 = xch[((sub * 2 + (mt ^ 1)) * 64 + tq) * 2], o2 = xch[((sub * 2 + (mt ^ 1)) * 64 + tq) * 2 + 1]; s1 += o1; s2 += o2; }
                const float mu = s1 * (1.f / 64.f), var = fmaxf(s2 * (1.f / 64.f) - mu * mu, 0.f), rstd = 1.0f / sqrtf(var + GN_EPS);
                bf16* op = OCAT + trow * 4096 + 1536 + head * 64 + 32 * mt + 4 * lh;
#pragma unroll
                for (int i = 0; i < 4; ++i) { const int vb = head * 64 + 32 * mt + 8 * i + 4 * lh; const f32x4 gv = *(const GAS f32x4*)(lng + vb), bv = *(const GAS f32x4*)(lnb + vb);
                    const float g4[4] = {bflo(gg[i].x), bfhi(gg[i].x), bflo(gg[i].y), bfhi(gg[i].y)}; float o[4];
#pragma unroll
                    for (int e = 0; e < 4; ++e) o[e] = ((yv[4 * i + e] - mu) * rstd * gv[e] + bv[e] + bon * vv4[i][e]) * g4[e];
                    *(GAS v2u*)(op + 8 * i) = (v2u){pk2(o[0], o[1]), pk2(o[2], o[3])}; }
                __syncthreads();
            }
        }
        {
            LAS float* scr = (LAS float*)(lds + wave * 16384);
            for (int qi = gw; qi < Q2_ITEMS; qi += NGW) Q2_BODY;
        }
        if (BOTH(6)) GRID_BAR();
    }

    if (IN(7)) {
        PHASE_IDS();
        pg8::SchedMerge S; S.to.init(32, 16); S.G = G; S.c = bx; S.OC = (const char*)OCAT; S.WC = (const char*)WCAT_T;
        pg8::EpiMerge E{P, MERGED};
        pg8::gemm_phase(lds, 4096, 4096, S, E);
        if (BOTH(7)) GRID_BAR();
    }

    if (IN(8)) {
        PHASE_IDS();
        pg8::SchedPlain S; S.to.init(32, 16); S.G = G; S.c = bx; S.nt = 64; S.A0 = (const char*)MERGED; S.B0 = (const char*)WOUT_T; S.sA = (size_t)256 * 4096 * 2; S.sB = (size_t)256 * 4096 * 2;
        pg8::EpiResToBf16 E{args.in[I_X], H1};
        pg8::gemm_phase(lds, 4096, 4096, S, E);
        if (BOTH(8)) GRID_BAR();
    }

    if (IN(9)) {
        PHASE_IDS();
        rms_rows4096_b(H1, args.in[I_FFNG], XN, gw, NGW, T, lane);
        if (BOTH(9)) GRID_BAR();
    }

    if (IN(10)) {
        PHASE_IDS();
        pg8::SchedPlain S; S.to.init(32, 86); S.G = G; S.c = bx; S.nt = 64; S.A0 = (const char*)XN; S.B0 = (const char*)WGU_T; S.sA = (size_t)256 * 4096 * 2; S.sB = (size_t)256 * 4096 * 2;
        pg8::EpiSwiGLU E{ACT};
        pg8::gemm_phase(lds, 4096, 4096, S, E);
        if (BOTH(10)) GRID_BAR();
    }

    if (IN(11)) {
        PHASE_IDS();
        pg8::SchedPlain S; S.to.init(32, 16); S.G = G; S.c = bx; S.nt = 172; S.A0 = (const char*)ACT; S.B0 = (const char*)WD_T; S.sA = (size_t)256 * DFF * 2; S.sB = (size_t)256 * DFF * 2;
        pg8::EpiResFromBf16 E{H1, args.out};
        pg8::gemm_phase(lds, DFF, DFF, S, E);
    }
#undef IN
#undef BOTH
}

extern "C" void kernel_launch(void* const* d_in, const int* in_sizes, int n_in, void* d_out, int out_size, void* d_ws, size_t ws_size, hipStream_t stream) {
    static int grid = 0;
    if (grid == 0) {
        if (n_in != 29 || in_sizes[0] != T * D || out_size != T * D || ws_size < WS_END) {
            fprintf(stderr, "kernel_launch: unexpected problem (n_in %d, in0 %d, out %d, ws %zu, need %zu); nothing launched\n", n_in, n_in > 0 ? in_sizes[0] : -1, out_size, ws_size, (size_t)WS_END); grid = -1; return; }
        int dev = 0, cus = 0, per_cu = 0;
        if (hipGetDevice(&dev) != hipSuccess || hipDeviceGetAttribute(&cus, hipDeviceAttributeMultiprocessorCount, dev) != hipSuccess) { grid = -1; return; }
        if (hipFuncSetAttribute((const void*)hybrid_fwd, hipFuncAttributeMaxDynamicSharedMemorySize, LDS_BYTES) != hipSuccess) { fprintf(stderr, "kernel_launch: hipFuncSetAttribute failed\n"); grid = -1; return; }
        if (hipOccupancyMaxActiveBlocksPerMultiprocessor(&per_cu, (const void*)hybrid_fwd, NWAVES * 64, LDS_BYTES) != hipSuccess || per_cu < 1)
            fprintf(stderr, "kernel_launch: note: occupancy query reports %d workgroups per CU\n", per_cu);
        (void)hipGetLastError();
        grid = cus;
    }
    if (grid < 0) return;
    if (hipMemsetAsync((char*)d_ws + WS_CTL, 0, CTL_ZERO_BYTES, stream) != hipSuccess) return;
    Args a{};
    for (int i = 0; i < 29; ++i) a.in[i] = (const float*)d_in[i];
    a.out = (float*)d_out; a.ws = (unsigned char*)d_ws;
#if MK_PER_PHASE
    for (int p = 0; p < NPHASES; ++p) { a.ph_lo = p; a.ph_hi = p + 1; hipLaunchKernelGGL(hybrid_fwd, dim3(grid), dim3(NWAVES * 64), LDS_BYTES, stream, a); }
#else
    a.ph_lo = 0; a.ph_hi = NPHASES;
    hipLaunchKernelGGL(hybrid_fwd, dim3(grid), dim3(NWAVES * 64), LDS_BYTES, stream, a);
#endif
}
```
